# Optimizing an MI355X kernel written in HIP

```python
import math, functools
import jax, jax.numpy as jnp
from jax import lax
import numpy as np

D_MODEL = 1024
BATCH = 2
SEQ = 8192
DEPTH = 2

GRID_W = 64
CTX_LEN = 256
CHUNK = 128
Q_BLOCK = 128
RET_HEADS = 4
RET_DK = 32
RET_DV = 64
GLA_HEADS = 4
GLA_DK = 32
GLA_DV = 64
GLA_LOWRANK = 16
GLA_TAU = 16.0
DIFF_HEADS = 4
DIFF_DH = 64
ROPE_BASE = 10000.0
D_MIX = RET_HEADS * RET_DV + GLA_HEADS * GLA_DV + 2 * DIFF_HEADS * DIFF_DH
IN_WIDTHS = (RET_HEADS * RET_DK, RET_HEADS * RET_DK, RET_HEADS * RET_DV, RET_HEADS * RET_DV,
             GLA_HEADS * GLA_DK, GLA_HEADS * GLA_DK, GLA_HEADS * GLA_DV, GLA_HEADS * GLA_DV, GLA_LOWRANK,
             2 * DIFF_HEADS * DIFF_DH, 2 * DIFF_HEADS * DIFF_DH, 2 * DIFF_HEADS * DIFF_DH)
N_IN = 3088
N_EXPERTS = 64
TOP_K = 6
N_GROUPS = 8
TOPK_GROUPS = 4
D_EXPERT = 256
D_SHARED = 256
ROUTED_SCALE = 2.5
MOE_BLOCK = 128
EPS = 1e-6

kernel_name = 'hybrid_ret_gla_diffattn_moe_dit_block'


def rms_norm(x, g=None):
    xf = x.astype(jnp.float32)
    y = xf * lax.rsqrt(jnp.mean(xf * xf, axis=-1, keepdims=True) + EPS)
    if g is not None:
        y = y * g.astype(jnp.float32)
    return y.astype(x.dtype)


def modulate(x, shift, scale):
    return x * (1.0 + scale) + shift


def split_cols(p):
    offs, acc = [], 0
    for w in IN_WIDTHS[:-1]:
        acc += w
        offs.append(acc)
    return jnp.split(p, offs, axis=-1)


def split_heads(a, h):
    b, t, _ = a.shape
    return a.reshape(b, t, h, -1).transpose(0, 2, 1, 3)


def merge_heads(a):
    b, h, t, d = a.shape
    return a.transpose(0, 2, 1, 3).reshape(b, t, h * d)


def diff_heads(a):
    b, t, _ = a.shape
    return a.reshape(b, t, DIFF_HEADS, 2, DIFF_DH).transpose(0, 2, 3, 1, 4)


def rope_2d(x, row, col):
    d = x.shape[-1]
    half, quarter = d // 2, d // 4
    freqs = ROPE_BASE ** (-jnp.arange(quarter, dtype=jnp.float32) / quarter)

    def rot(xp, pos):
        ang = pos[:, None] * freqs[None, :]
        cos, sin = jnp.cos(ang).astype(x.dtype), jnp.sin(ang).astype(x.dtype)
        x1, x2 = xp[..., :quarter], xp[..., quarter:]
        return jnp.concatenate([x1 * cos - x2 * sin, x1 * sin + x2 * cos], axis=-1)

    return jnp.concatenate([rot(x[..., :half], row), rot(x[..., half:], col)], axis=-1)


def to_chunks(a):
    b, h, t, d = a.shape
    return jnp.moveaxis(a.reshape(b, h, t // CHUNK, CHUNK, d), 2, 0)


def from_chunks(a):
    n, b, h, c, d = a.shape
    return jnp.moveaxis(a, 0, 2).reshape(b, h, n * c, d)


def retention_scan(q, k, v, s0, log_g):
    f32 = jnp.float32
    q, k, v = q.astype(f32), k.astype(f32), v.astype(f32)
    idx = jnp.arange(CHUNK, dtype=f32)
    diff = idx[:, None] - idx[None, :]
    lower = diff >= 0
    dmat = jnp.where(lower, jnp.exp(jnp.where(lower, diff, 0.0)[None] * log_g[:, None, None]), 0.0)
    xi = jnp.exp((idx + 1.0)[None, :] * log_g[:, None])
    zeta = jnp.exp((CHUNK - 1.0 - idx)[None, :] * log_g[:, None])
    g_chunk = jnp.exp(CHUNK * log_g)

    def step(s, inp):
        qc, kc, vc = inp
        att = jnp.einsum('bhid,bhjd->bhij', qc, kc) * dmat
        o = jnp.einsum('bhij,bhje->bhie', att, vc) + jnp.einsum('bhid,bhde->bhie', qc, s) * xi[:, :, None]
        s = s * g_chunk[:, None, None] + jnp.einsum('bhjd,bhje->bhde', kc * zeta[:, :, None], vc)
        return s, o

    s, o = lax.scan(step, s0, (to_chunks(q), to_chunks(k), to_chunks(v)))
    return from_chunks(o), s


def gla_scan(q, k, v, log_a, s0):
    f32 = jnp.float32
    q, k, v, log_a = q.astype(f32), k.astype(f32), v.astype(f32), log_a.astype(f32)
    idx = jnp.arange(CHUNK)
    lower = (idx[:, None] >= idx[None, :])[:, :, None]

    def step(s, inp):
        qc, kc, vc, ac = inp
        b = jnp.cumsum(ac, axis=2)
        rel = b[:, :, :, None, :] - b[:, :, None, :, :]
        decay = jnp.where(lower, jnp.exp(jnp.where(lower, rel, 0.0)), 0.0)
        att = jnp.einsum('bhik,bhjk,bhijk->bhij', qc, kc, decay)
        o = jnp.einsum('bhij,bhje->bhie', att, vc) + jnp.einsum('bhik,bhke->bhie', qc * jnp.exp(b), s)
        b_last = b[:, :, -1:, :]
        s = s * jnp.swapaxes(jnp.exp(b_last), -1, -2) + jnp.einsum(
            'bhjk,bhje->bhke', kc * jnp.exp(b_last - b), vc)
        return s, o

    s, o = lax.scan(step, s0, (to_chunks(q), to_chunks(k), to_chunks(v), to_chunks(log_a)))
    return from_chunks(o), s


def bidirectional_scan(scan_f, scan_b, lat_f, lat_b, ctx_f, ctx_b, s0):
    flip = lambda arrs: tuple(a[:, :, ::-1] for a in arrs)
    o_cf, s_cf = scan_f(*ctx_f, s0)
    o_cb, s_cb = scan_b(*flip(ctx_b), s0)
    o_lf, _ = scan_f(*lat_f, s_cf)
    o_lb, _ = scan_b(*flip(lat_b), s_cb)
    return o_lf + o_lb[:, :, ::-1], o_cf + o_cb[:, :, ::-1]


def diff_attend(q, k, v, lam):
    s = jnp.einsum('bhmqd,bhmkd->bhmqk', q, k).astype(jnp.float32) * (DIFF_DH ** -0.5)
    a = jax.nn.softmax(s, axis=-1)
    w = a[:, :, 0] - lam * a[:, :, 1]
    return jnp.einsum('bhqk,bhke->bhqe', w.astype(v.dtype), v)


def token_mixers(h_lat, h_ctx, w_in, w_out, ret_logit, gla_w, gla_b, gla_g, diff_lam, diff_g,
                 row, col, lam_init, need_ctx):
    f32 = jnp.float32
    dt = h_lat.dtype
    bsz, seq, _ = h_lat.shape
    (rq_l, rk_l, rv_l, rg_l, gq_l, gk_l, gv_l, gr_l, glr_l, dq_l, dk_l, dv_l) = split_cols(h_lat @ w_in)
    (rq_c, rk_c, rv_c, rg_c, gq_c, gk_c, gv_c, gr_c, glr_c, dq_c, dk_c, dv_c) = split_cols(h_ctx @ w_in)
    rope = lambda a: rope_2d(a, row, col)

    log_g = jax.nn.log_sigmoid(ret_logit.astype(f32))
    r_lat = (rope(split_heads(rq_l, RET_HEADS)),
             rope(split_heads(rk_l, RET_HEADS)) * RET_DK ** -0.5,
             split_heads(rv_l, RET_HEADS))
    r_ctx = (split_heads(rq_c, RET_HEADS), split_heads(rk_c, RET_HEADS) * RET_DK ** -0.5,
             split_heads(rv_c, RET_HEADS))
    s0_r = jnp.zeros((bsz, RET_HEADS, RET_DK, RET_DV), f32)
    o_rl, o_rc = bidirectional_scan(functools.partial(retention_scan, log_g=log_g[0]),
                                    functools.partial(retention_scan, log_g=log_g[1]),
                                    r_lat, r_lat, r_ctx, r_ctx, s0_r)

    def log_alpha(lr, direction):
        z = (lr @ gla_w[direction] + gla_b[direction]).astype(f32)
        return split_heads(jax.nn.log_sigmoid(z) / GLA_TAU, GLA_HEADS)

    g_ql, g_kl, g_vl = (split_heads(gq_l, GLA_HEADS) * GLA_DK ** -0.5, split_heads(gk_l, GLA_HEADS),
                        split_heads(gv_l, GLA_HEADS))
    g_qc, g_kc, g_vc = (split_heads(gq_c, GLA_HEADS) * GLA_DK ** -0.5, split_heads(gk_c, GLA_HEADS),
                        split_heads(gv_c, GLA_HEADS))
    s0_g = jnp.zeros((bsz, GLA_HEADS, GLA_DK, GLA_DV), f32)
    o_gl, o_gc = bidirectional_scan(gla_scan, gla_scan,
                                    (g_ql, g_kl, g_vl, log_alpha(glr_l, 0)),
                                    (g_ql, g_kl, g_vl, log_alpha(glr_l, 1)),
                                    (g_qc, g_kc, g_vc, log_alpha(glr_c, 0)),
                                    (g_qc, g_kc, g_vc, log_alpha(glr_c, 1)), s0_g)

    lp = diff_lam.astype(f32)
    lam = jnp.exp(jnp.sum(lp[0] * lp[1])) - jnp.exp(jnp.sum(lp[2] * lp[3])) + lam_init
    dq_lh, dk_lh, dv_lh = rope(diff_heads(dq_l)), rope(diff_heads(dk_l)), split_heads(dv_l, DIFF_HEADS)
    dq_ch, dk_ch, dv_ch = diff_heads(dq_c), diff_heads(dk_c), split_heads(dv_c, DIFF_HEADS)
    k_all = jnp.concatenate([dk_ch, dk_lh], axis=3)
    v_all = jnp.concatenate([dv_ch, dv_lh], axis=2)
    n_qb = seq // Q_BLOCK
    q_blocks = jnp.moveaxis(dq_lh.reshape(bsz, DIFF_HEADS, 2, n_qb, Q_BLOCK, DIFF_DH), 3, 0)
    o_blocks = lax.map(lambda qb: diff_attend(qb, k_all, v_all, lam), q_blocks)
    o_dl = jnp.moveaxis(o_blocks, 0, 2).reshape(bsz, DIFF_HEADS, seq, 2 * DIFF_DH)

    def merge(o_r, g_r, o_g, g_g, o_d):
        ret = merge_heads(rms_norm(o_r)).astype(dt) * jax.nn.silu(g_r)
        gla = merge_heads(rms_norm(o_g, gla_g)).astype(dt) * jax.nn.silu(g_g)
        dif = merge_heads(rms_norm(o_d, diff_g) * (1.0 - lam_init)).astype(dt)
        return jnp.concatenate([ret, gla, dif], axis=-1) @ w_out

    m_lat = merge(o_rl, rg_l, o_gl, gr_l, o_dl)
    m_ctx = merge(o_rc, rg_c, o_gc, gr_c, diff_attend(dq_ch, dk_ch, dv_ch, lam)) if need_ctx else None
    return m_lat, m_ctx


def moe_ffn(t, w_router, router_bias, w_eg, w_eu, w_ed, w_sg, w_su, w_sd):
    n_tok, d = t.shape
    scores = jax.nn.sigmoid(t.astype(jnp.float32) @ w_router.astype(jnp.float32))
    sel = scores + router_bias.astype(jnp.float32)
    grp = sel.reshape(n_tok, N_GROUPS, N_EXPERTS // N_GROUPS)
    grp_score = lax.top_k(grp, 2)[0].sum(-1)
    _, g_idx = lax.top_k(grp_score, TOPK_GROUPS)
    g_mask = jax.nn.one_hot(g_idx, N_GROUPS, dtype=jnp.float32).sum(-2) > 0
    e_mask = jnp.repeat(g_mask, N_EXPERTS // N_GROUPS, axis=-1)
    _, e_idx = lax.top_k(jnp.where(e_mask, sel, -jnp.inf), TOP_K)
    w = jnp.take_along_axis(scores, e_idx, axis=-1)
    w = w / jnp.sum(w, axis=-1, keepdims=True) * ROUTED_SCALE

    n_pairs = n_tok * TOP_K
    flat_e = e_idx.reshape(-1)
    flat_tok = jnp.repeat(jnp.arange(n_tok, dtype=jnp.int32), TOP_K)
    order = jnp.argsort(flat_e, stable=True)
    s_e, s_tok, s_w = flat_e[order], flat_tok[order], w.reshape(-1)[order]
    counts = jnp.bincount(flat_e, length=N_EXPERTS)
    padded = (counts + MOE_BLOCK - 1) // MOE_BLOCK * MOE_BLOCK
    p_end = jnp.cumsum(padded)
    p_start = p_end - padded
    c_start = jnp.cumsum(counts) - counts
    dest = p_start[s_e] + jnp.arange(n_pairs, dtype=jnp.int32) - c_start[s_e]
    n_blocks = (n_pairs + N_EXPERTS * (MOE_BLOCK - 1) + MOE_BLOCK - 1) // MOE_BLOCK
    n_rows = n_blocks * MOE_BLOCK
    row_tok = jnp.full((n_rows,), n_tok, jnp.int32).at[dest].set(s_tok)
    row_w = jnp.zeros((n_rows,), jnp.float32).at[dest].set(s_w)
    block_e = jnp.minimum(jnp.searchsorted(p_end, jnp.arange(n_blocks) * MOE_BLOCK, side='right'),
                          N_EXPERTS - 1).astype(jnp.int32)
    t_pad = jnp.concatenate([t, jnp.zeros((1, d), t.dtype)], axis=0)

    def block_ffn(args):
        b, e = args
        rows = lax.dynamic_slice(row_tok, (b * MOE_BLOCK,), (MOE_BLOCK,))
        xb = t_pad[rows]
        hb = jax.nn.silu(xb @ w_eg[e]) * (xb @ w_eu[e])
        return hb @ w_ed[e]

    y = lax.map(block_ffn, (jnp.arange(n_blocks, dtype=jnp.int32), block_e)).reshape(n_rows, d)
    routed = jax.ops.segment_sum(y * row_w[:, None].astype(y.dtype), row_tok,
                                 num_segments=n_tok + 1)[:n_tok]
    shared = (jax.nn.silu(t @ w_sg) * (t @ w_su)) @ w_sd
    return shared + routed


def setup_inputs(seed: int = 0) -> dict:
    key = jax.random.key(seed)
    ks = jax.random.split(key, 32)
    f32 = jnp.float32
    L, D = DEPTH, D_MODEL
    nrm = lambda k, shape, s: jax.random.normal(k, shape, f32) * s
    gamma = 1.0 - 2.0 ** (-5.0 - jnp.arange(RET_HEADS, dtype=f32))
    ret_logit0 = jnp.log(gamma) - jnp.log1p(-gamma)
    return {
        'x': nrm(ks[0], (BATCH, SEQ, D), 1.0),
        'c': nrm(ks[1], (BATCH, D), 1.0),
        'ctx': nrm(ks[2], (BATCH, CTX_LEN, D), 1.0),
        'c_ctx': nrm(ks[3], (D,), 1.0),
        'w_mod': nrm(ks[4], (L, D, 6 * D), 0.5 * D ** -0.5),
        'b_mod': nrm(ks[5], (L, 6 * D), 0.01),
        'g_pre_mix': 1.0 + nrm(ks[6], (L, D), 0.05),
        'g_post_mix': 1.0 + nrm(ks[7], (L, D), 0.05),
        'g_pre_ffn': 1.0 + nrm(ks[8], (L, D), 0.05),
        'g_post_ffn': 1.0 + nrm(ks[9], (L, D), 0.05),
        'w_in': nrm(ks[10], (L, D, N_IN), D ** -0.5),
        'w_out': nrm(ks[11], (L, D_MIX, D), D_MIX ** -0.5),
        'ret_decay_logit': ret_logit0[None, None, :] + nrm(ks[12], (L, 2, RET_HEADS), 0.1),
        'gla_w_gate': nrm(ks[13], (L, 2, GLA_LOWRANK, GLA_HEADS * GLA_DK), GLA_LOWRANK ** -0.5),
        'gla_b_gate': nrm(ks[14], (L, 2, GLA_HEADS * GLA_DK), 0.1),
        'gla_norm_g': 1.0 + nrm(ks[15], (L, GLA_DV), 0.05),
        'diff_lambda': nrm(ks[16], (L, 4, DIFF_DH), 0.1),
        'diff_norm_g': 1.0 + nrm(ks[17], (L, 2 * DIFF_DH), 0.05),
        'w_router': nrm(ks[18], (L, D, N_EXPERTS), D ** -0.5),
        'router_bias': nrm(ks[19], (L, N_EXPERTS), 0.01),
        'w_exp_gate': nrm(ks[20], (L, N_EXPERTS, D, D_EXPERT), D ** -0.5),
        'w_exp_up': nrm(ks[21], (L, N_EXPERTS, D, D_EXPERT), D ** -0.5),
        'w_exp_down': nrm(ks[22], (L, N_EXPERTS, D_EXPERT, D), D_EXPERT ** -0.5),
        'w_sh_gate': nrm(ks[23], (L, D, D_SHARED), D ** -0.5),
        'w_sh_up': nrm(ks[24], (L, D, D_SHARED), D ** -0.5),
        'w_sh_down': nrm(ks[25], (L, D_SHARED, D), D_SHARED ** -0.5),
    }


def reference(x, c, ctx, c_ctx, w_mod, b_mod, g_pre_mix, g_post_mix, g_pre_ffn, g_post_ffn, w_in, w_out,
              ret_decay_logit, gla_w_gate, gla_b_gate, gla_norm_g, diff_lambda, diff_norm_g,
              w_router, router_bias, w_exp_gate, w_exp_up, w_exp_down, w_sh_gate, w_sh_up, w_sh_down):
    bsz, seq, d = x.shape
    rows = seq // GRID_W
    row = jnp.broadcast_to(jnp.arange(rows, dtype=jnp.float32)[:, None], (rows, GRID_W)).reshape(-1)
    col = jnp.broadcast_to(jnp.arange(GRID_W, dtype=jnp.float32)[None, :], (rows, GRID_W)).reshape(-1)
    cond_l = jax.nn.silu(c)
    cond_c = jax.nn.silu(c_ctx)
    h_ctx = ctx
    for layer in range(DEPTH):
        need_ctx = layer < DEPTH - 1
        lam_init = 0.8 - 0.6 * math.exp(-0.3 * layer)
        mod_l = (cond_l @ w_mod[layer] + b_mod[layer])[:, None, :]
        mod_c = cond_c @ w_mod[layer] + b_mod[layer]
        sh1_l, sc1_l, gt1_l, sh2_l, sc2_l, gt2_l = jnp.split(mod_l, 6, axis=-1)
        sh1_c, sc1_c, gt1_c, sh2_c, sc2_c, gt2_c = jnp.split(mod_c, 6, axis=-1)

        hl = modulate(rms_norm(x, g_pre_mix[layer]), sh1_l, sc1_l)
        hc = modulate(rms_norm(h_ctx, g_pre_mix[layer]), sh1_c, sc1_c)
        m_l, m_c = token_mixers(hl, hc, w_in[layer], w_out[layer], ret_decay_logit[layer],
                                gla_w_gate[layer], gla_b_gate[layer], gla_norm_g[layer],
                                diff_lambda[layer], diff_norm_g[layer], row, col, lam_init, need_ctx)
        x = x + gt1_l * rms_norm(m_l, g_post_mix[layer])
        hl2 = modulate(rms_norm(x, g_pre_ffn[layer]), sh2_l, sc2_l)
        if need_ctx:
            h_ctx = h_ctx + gt1_c * rms_norm(m_c, g_post_mix[layer])
            hc2 = modulate(rms_norm(h_ctx, g_pre_ffn[layer]), sh2_c, sc2_c)
            tokens = jnp.concatenate([hl2.reshape(-1, d), hc2.reshape(-1, d)], axis=0)
        else:
            tokens = hl2.reshape(-1, d)
        f = moe_ffn(tokens, w_router[layer], router_bias[layer], w_exp_gate[layer], w_exp_up[layer],
                    w_exp_down[layer], w_sh_gate[layer], w_sh_up[layer], w_sh_down[layer])
        x = x + gt2_l * rms_norm(f[:bsz * seq].reshape(bsz, seq, d), g_post_ffn[layer])
        if need_ctx:
            h_ctx = h_ctx + gt2_c * rms_norm(f[bsz * seq:].reshape(bsz, -1, d), g_post_ffn[layer])
    return x
```

```cpp
#include <hip/hip_runtime.h>
#include <cstdio>
#include <cstdint>

#ifndef MK_LAUNCHES
#define MK_LAUNCHES 1
#endif

namespace {
typedef unsigned short bf16;
typedef short bf16x8 __attribute__((ext_vector_type(8)));
typedef float f32x4 __attribute__((ext_vector_type(4)));
typedef float f32x16 __attribute__((ext_vector_type(16)));
typedef unsigned u32x4 __attribute__((ext_vector_type(4)));
typedef unsigned u32x2 __attribute__((ext_vector_type(2)));
#define LAS __attribute__((address_space(3)))

constexpr int D = 1024, BATCH = 2, SEQ = 8192, CTX = 256, POSB = SEQ + CTX  , R = BATCH * POSB  ;
constexpr int NIN = 3088, NP = 3072;
constexpr int NEXP = 64, DEXP = 256, CAP = R;
constexpr int NCH = POSB / 128;
constexpr float EPS = 1e-6f;
constexpr int NTHR = 512, NWAVE = 8;
constexpr int NPHASE = 21;
constexpr int HB_ROWS = 134912;

constexpr size_t MiB = 1u << 20;
constexpr size_t WS_CTL = 0;
constexpr size_t WS_MODS = 1 * MiB;
constexpr size_t WS_TAB8 = WS_MODS + 192 * 1024;
constexpr size_t WS_TAB16 = WS_TAB8 + 8192;
constexpr size_t WS_SCAL = WS_TAB16 + 16384;
constexpr size_t WS_HCTX = 2 * MiB;
constexpr size_t WS_ROWTOK = 4 * MiB;
constexpr size_t WS_PSLOT = 9 * MiB;
constexpr size_t WS_PW = 10 * MiB;
constexpr size_t WS_DEC = 11 * MiB;
constexpr size_t WS_WIN = 12 * MiB;
constexpr size_t WS_WOUT = 18 * MiB;
constexpr size_t WS_WGU = 20 * MiB;
constexpr size_t WS_WD = 85 * MiB;
constexpr size_t WS_HL = 118 * MiB;
constexpr size_t WS_HB = 151 * MiB;
constexpr size_t WS_X = 217 * MiB;
constexpr size_t WS_P = WS_X;
constexpr size_t WS_VT = 316 * MiB;
constexpr size_t WS_US = 333 * MiB;
constexpr size_t WS_CAT = 366 * MiB;
constexpr size_t WS_MO = 399 * MiB;
constexpr size_t WS_LA = 465 * MiB;
constexpr size_t WS_Y = WS_X;
constexpr size_t WS_END = 482 * MiB;
static_assert(WS_Y + (size_t)HB_ROWS * 2048 <= WS_END, "Y fits");
static_assert(WS_HB + (size_t)HB_ROWS * 512 <= WS_X, "HB fits");

constexpr int CW_BAR = 4096;
constexpr int CW_CNT = 16384;

constexpr int LDS_BYTES = 147456;
constexpr int LDS_MISC = 147456 - 256;

struct Params { const float* in[26]; float* out; unsigned char* ws; int ph_lo, ph_hi; };
typedef const __attribute__((address_space(4))) Params& PRef;

__device__ __forceinline__ unsigned f2bf(float f) { unsigned u = __builtin_bit_cast(unsigned, f); return (u + 0x7fffu + ((u >> 16) & 1u)) >> 16; }
__device__ __forceinline__ unsigned pk2(float lo, float hi) { return f2bf(lo) | (f2bf(hi) << 16); }
__device__ __forceinline__ float bf2f(unsigned short b) { return __builtin_bit_cast(float, (unsigned)b << 16); }
__device__ __forceinline__ float bflo(unsigned u) { return __builtin_bit_cast(float, u << 16); }
__device__ __forceinline__ float bfhi(unsigned u) { return __builtin_bit_cast(float, u & 0xffff0000u); }
__device__ __forceinline__ float wave_sum(float v) {
#pragma unroll
    for (int o = 1; o < 64; o <<= 1) v += __shfl_xor(v, o);
    return v;
}
__device__ __forceinline__ float wave_max(float v) {
#pragma unroll
    for (int o = 1; o < 64; o <<= 1) v = fmaxf(v, __shfl_xor(v, o));
    return v;
}
__device__ __forceinline__ float silu_f(float x) { return x / (1.f + __expf(-x)); }
__device__ __forceinline__ float logsig_f(float x) { return fminf(x, 0.f) - log1pf(__expf(-fabsf(x))); }
#define LDS_FENCE() asm volatile("s_waitcnt lgkmcnt(0)" ::: "memory")
__device__ __forceinline__ int tid_now() { int t = threadIdx.x; asm volatile("" : "+v"(t)); return t; }

#define XB_TMO      128
#define XB_XCNT(j)  (256  + 64 * (j))
#define XB_XSUB(j)  (1280 + 64 * (j))
#define XB_XGEN(j)  (2304 + 64 * (j))
#define XB_TOP      3328
#define XB_TOPGEN   3392
#define XCD_BAR_WORDS 3456
#define XB_SPIN_CAP (1u << 20)
__device__ __forceinline__ unsigned xb_ld(unsigned* p)              { return __hip_atomic_load(p, __ATOMIC_RELAXED, __HIP_MEMORY_SCOPE_AGENT); }
__device__ __forceinline__ unsigned xb_add(unsigned* p, unsigned v) { return __hip_atomic_fetch_add(p, v, __ATOMIC_RELAXED, __HIP_MEMORY_SCOPE_AGENT); }
__device__ __forceinline__ unsigned xb_xcc_id() { return (unsigned)__builtin_amdgcn_s_getreg((3 << 11) | 20) & 0xFu; }
#define XB_SPIN(cond, bar) do { unsigned _sp = 0; while (cond) { __builtin_amdgcn_s_sleep(1); \
    if ((++_sp & 255u) == 0u) { if (xb_ld(&(bar)[XB_TMO])) break; if (_sp > XB_SPIN_CAP) { atomicAdd(&(bar)[XB_TMO], 1u); break; } } } } while (0)
struct XcdBarrier { unsigned* bar; unsigned x; volatile unsigned* st; };
__device__ __forceinline__ XcdBarrier xcd_barrier_post(unsigned* bar, volatile unsigned* st) {
    XcdBarrier b; b.bar = bar; b.x = xb_xcc_id(); b.st = st;
    if (threadIdx.x == 0) (void)xb_add(&bar[XB_XCNT(b.x)], 1u);
    return b;
}
__device__ __forceinline__ void xcd_barrier_complete(unsigned* bar, unsigned x, unsigned& nloc, unsigned& nx) {
    const unsigned G = gridDim.x;
    unsigned sum, cnt, mine, sp = 0u;
    for (;;) {
        sum = 0u; cnt = 0u; mine = 0u;
#pragma unroll
        for (unsigned j = 0; j < 16; ++j) { const unsigned c = xb_ld(&bar[XB_XCNT(j)]); sum += c; cnt += (c > 0u) ? 1u : 0u; mine = (j == x) ? c : mine; }
        if (sum == G) break;
        __builtin_amdgcn_s_sleep(1);
        if ((++sp & 255u) == 0u) { if (xb_ld(&bar[XB_TMO])) break; if (sp > XB_SPIN_CAP) { atomicAdd(&bar[XB_TMO], 1u); break; } }
    }
    nloc = mine > 0u ? mine : 1u; nx = cnt > 0u ? cnt : 1u;
}
__device__ __forceinline__ void xcd_barrier(const XcdBarrier& b) {
    asm volatile("s_waitcnt vmcnt(0)" ::: "memory");
    __syncthreads();
    if (threadIdx.x == 0) {
        unsigned* bar = b.bar;
        __builtin_amdgcn_s_waitcnt(0);
        unsigned nloc = b.st[0], nx = b.st[1];
        if (nloc == 0u) { xcd_barrier_complete(bar, b.x, nloc, nx); b.st[0] = nloc; b.st[1] = nx; }
        const unsigned old = xb_add(&bar[XB_XSUB(b.x)], 1u);
        const unsigned gen = old / nloc;
        if (old + 1u == (gen + 1u) * nloc) {
            __builtin_amdgcn_fence(__ATOMIC_RELEASE, "agent");
            asm volatile("s_waitcnt vmcnt(0)" ::: "memory");
            const unsigned og = xb_add(&bar[XB_TOP], 1u);
            const unsigned tg = og / nx;
            if (og + 1u == (tg + 1u) * nx) xb_add(&bar[XB_TOPGEN], 1u);
            else XB_SPIN(xb_ld(&bar[XB_TOPGEN]) == tg, bar);
            __builtin_amdgcn_fence(__ATOMIC_ACQUIRE, "agent");
            xb_add(&bar[XB_XGEN(b.x)], 1u);
            asm volatile("s_waitcnt vmcnt(0)" ::: "memory");
        } else {
            XB_SPIN(xb_ld(&bar[XB_XGEN(b.x)]) == gen, bar);
            __builtin_amdgcn_fence(__ATOMIC_ACQUIRE, "agent");
            asm volatile("s_waitcnt vmcnt(0)" ::: "memory");
        }
    }
    __syncthreads();
}

__device__ __forceinline__ int row_b(int row) { return row >= POSB ? 1 : 0; }

__device__ __forceinline__ void transpose_item(const float* __restrict__ W, int ldw, int k0, int n0src, bf16* WT, int ldt, int drow0, int dstep, float* scr, int lane) {
#pragma unroll 8
    for (int i = 0; i < 32; ++i) { const int kk = 2 * i + (lane >> 5); scr[kk * 33 + (lane & 31)] = W[(size_t)(k0 + kk) * ldw + n0src + (lane & 31)]; }
    LDS_FENCE();
    const int c = lane & 7;
#pragma unroll
    for (int j = 0; j < 4; ++j) {
        const int n = (lane >> 3) + 8 * j; const float* s = scr + (8 * c) * 33 + n;
        u32x4 o; o.x = pk2(s[0 * 33], s[1 * 33]); o.y = pk2(s[2 * 33], s[3 * 33]); o.z = pk2(s[4 * 33], s[5 * 33]); o.w = pk2(s[6 * 33], s[7 * 33]);
        const int dr = drow0 + (n & 15) + (n >> 4) * dstep;
        *(u32x4*)(WT + (size_t)dr * ldt + k0 + 8 * c) = o;
    }
    LDS_FENCE();
}

constexpr int CV_IN = 16 * 96, CV_OUT = 16 * 32, CV_GU = 65 * 256, CV_D = 65 * 128, CV_TOTAL = CV_IN + CV_OUT + CV_GU + CV_D;

__device__ __forceinline__ void convert_weights(PRef p, int l, char* lds) {
    const int lane = tid_now() & 63, wave = tid_now() >> 6;
    float* scr = (float*)(lds + wave * 8704);
    const int gw = blockIdx.x * NWAVE + wave, NGW = gridDim.x * NWAVE;
    bf16* WIN = (bf16*)(p.ws + WS_WIN); bf16* WOUT = (bf16*)(p.ws + WS_WOUT); bf16* WGU = (bf16*)(p.ws + WS_WGU); bf16* WD = (bf16*)(p.ws + WS_WD);
    for (int it = gw; it < CV_TOTAL; it += NGW) {
        int r = it;
        if (r < CV_IN) { const int kb = r / 96, nb = r % 96, n0 = 32 * nb;
            transpose_item(p.in[10] + (size_t)l * D * NIN, NIN, 64 * kb, n0 + (n0 >= 1536 ? 16 : 0), WIN, D, n0, 16, scr, lane); continue; }
        r -= CV_IN;
        if (r < CV_OUT) { const int kb = r / 32, nb = r % 32;
            transpose_item(p.in[11] + (size_t)l * D * D, D, 64 * kb, 32 * nb, WOUT, D, 32 * nb, 16, scr, lane); continue; }
        r -= CV_OUT;
        if (r < CV_GU) { const int e = r >> 8, rem = r & 255, which = rem >> 7, it2 = rem & 127, kb = it2 >> 3, nb = it2 & 7, hc0 = 32 * nb;
            const float* src = (e < 64) ? (which ? p.in[21] : p.in[20]) + ((size_t)l * 64 + e) * D * DEXP : (which ? p.in[24] : p.in[23]) + (size_t)l * D * DEXP;
            const int drow0 = 256 * (hc0 >> 7) + 64 * ((hc0 >> 5) & 3) + 16 * which;
            transpose_item(src, DEXP, 64 * kb, hc0, WGU + (size_t)e * 512 * D, D, drow0, 32, scr, lane); continue; }
        r -= CV_GU;
        { const int e = r >> 7, it2 = r & 127, kb = it2 >> 5, nb = it2 & 31;
            const float* src = (e < 64) ? p.in[22] + ((size_t)l * 64 + e) * DEXP * D : p.in[25] + (size_t)l * DEXP * D;
            transpose_item(src, D, 64 * kb, 32 * nb, WD + (size_t)e * D * DEXP, DEXP, 32 * nb, 16, scr, lane); }
    }
}

__device__ __forceinline__ void sincos_exact(float ang, float& s, float& c) {
    const double x = (double)ang;
    const double k = rint(x * 0.15915494309189535);
    const double r = x - k * 6.283185307179586476925;
    const double r2 = r * r;
    double ts = r, ss = r, tc = 1.0, cs = 1.0;
#pragma unroll 1
    for (int n = 1; n <= 15; ++n) { ts *= -r2 / (double)((2 * n) * (2 * n + 1)); ss += ts; tc *= -r2 / (double)((2 * n - 1) * (2 * n)); cs += tc; }
    s = (float)ss; c = (float)cs;
}

__device__ __forceinline__ void phase_p0(PRef p, char* lds) {
    const int tid = tid_now();
    for (int item = blockIdx.x; item < 192; item += gridDim.x) {
        const int l = item / 96, n0 = (item % 96) * 64;
        float* cond = (float*)lds;
        float* red = (float*)(lds + 12288);
        for (int i = tid; i < 3 * D; i += NTHR) { const int r = i >> 10, k = i & 1023; const float v = (r < 2) ? p.in[1][r * D + k] : p.in[3][k]; cond[i] = silu_f(v); }
        __syncthreads();
        const int cg = tid & 15, ks = tid >> 4;
        const float* W = p.in[4] + (size_t)l * D * 6144 + n0 + 4 * cg;
        f32x4 a0 = {0, 0, 0, 0}, a1 = a0, a2 = a0;
#pragma unroll 8
        for (int kk = 0; kk < 32; ++kk) { const int k = ks * 32 + kk; const f32x4 w = *(const f32x4*)(W + (size_t)k * 6144);
            a0 += w * cond[k]; a1 += w * cond[D + k]; a2 += w * cond[2 * D + k]; }
#pragma unroll
        for (int i = 0; i < 4; ++i) { red[(ks * 3 + 0) * 64 + 4 * cg + i] = a0[i]; red[(ks * 3 + 1) * 64 + 4 * cg + i] = a1[i]; red[(ks * 3 + 2) * 64 + 4 * cg + i] = a2[i]; }
        __syncthreads();
        if (tid < 192) { const int r = tid >> 6, n = tid & 63; float s = 0.f;
            for (int q = 0; q < 32; ++q) s += red[(q * 3 + r) * 64 + n];
            ((float*)(p.ws + WS_MODS))[(l * 3 + r) * 6144 + n0 + n] = s + p.in[5][l * 6144 + n0 + n]; }
        __syncthreads();
    }
    if (blockIdx.x == gridDim.x - 1) {
        float* t8 = (float*)(p.ws + WS_TAB8); float* t16 = (float*)(p.ws + WS_TAB16);
        for (int i = tid; i < 128 * 8 + 128 * 16; i += NTHR) {
            int pos, fi, q; float* dst;
            if (i < 1024) { pos = i >> 3; fi = i & 7; q = 8; dst = t8 + 2 * i; } else { const int j = i - 1024; pos = j >> 4; fi = j & 15; q = 16; dst = t16 + 2 * j; }
            const float freq = (float)exp(-(double)fi / (double)q * 9.210340371976184);
            const float ang = (float)pos * freq; float s, c; sincos_exact(ang, s, c); dst[0] = c; dst[1] = s;
        }
        if (tid < 2) { const int l = tid; const float* lp = p.in[16] + l * 256; float s1 = 0.f, s2 = 0.f;
            for (int i = 0; i < 64; ++i) { s1 += lp[i] * lp[64 + i]; s2 += lp[128 + i] * lp[192 + i]; }
            const float lam_init = 0.8f - 0.6f * expf(-0.3f * (float)l);
            float* sc = (float*)(p.ws + WS_SCAL) + l * 16;
            sc[0] = expf(s1) - expf(s2) + lam_init; sc[1] = lam_init;
            for (int i = 0; i < 8; ++i) sc[2 + i] = logsig_f(p.in[12][l * 8 + i]); }
    }
    __syncthreads();
    convert_weights(p, 0, lds);
}

__device__ __forceinline__ const float* resid_row_ptr(PRef p, int l, int row) {
    const int b = row_b(row), pos = row - b * POSB;
    if (l == 0) return pos < CTX ? p.in[2] + ((size_t)b * CTX + pos) * D : p.in[0] + ((size_t)b * SEQ + pos - CTX) * D;
    return pos < CTX ? (const float*)(p.ws + WS_HCTX) + ((size_t)b * CTX + pos) * D : p.out + ((size_t)b * SEQ + pos - CTX) * D;
}
__device__ __forceinline__ float* resid_row_out(PRef p, int row) {
    const int b = row_b(row), pos = row - b * POSB;
    return pos < CTX ? (float*)(p.ws + WS_HCTX) + ((size_t)b * CTX + pos) * D : p.out + ((size_t)b * SEQ + pos - CTX) * D;
}

__device__ __forceinline__ void phase_a(PRef p, int l, char* lds) {
    const int tid = tid_now(), lane = tid & 63, wave = tid >> 6;
    float* wlr = (float*)lds;
    float* gw = (float*)(lds + 65536);
    float* gb = (float*)(lds + 65536 + 16384);
    for (int i = tid; i < D * 16; i += NTHR) wlr[i] = p.in[10][(size_t)l * D * NIN + (size_t)(i >> 4) * NIN + 1536 + (i & 15)];
    for (int i = tid; i < 4096; i += NTHR) gw[i] = p.in[13][l * 4096 + i];
    if (tid < 256) gb[tid] = p.in[14][l * 256 + tid];
    __syncthreads();
    const float* mods = (const float*)(p.ws + WS_MODS) + (size_t)l * 3 * 6144;
    const float* gpre = p.in[6] + l * D;
    bf16* HL = (bf16*)(p.ws + WS_HL); float* LA = (float*)(p.ws + WS_LA);
    for (int row = blockIdx.x * NWAVE + wave; row < R; row += gridDim.x * NWAVE) {
        const int b = row_b(row), pos = row - b * POSB, rt = pos < CTX ? 2 : b;
        const float* xr = resid_row_ptr(p, l, row);
        const float* sh = mods + rt * 6144; const float* sc = sh + D;
        f32x4 v[4]; float ss = 0.f;
#pragma unroll
        for (int j = 0; j < 4; ++j) { v[j] = *(const f32x4*)(xr + 4 * lane + 256 * j); ss += v[j].x * v[j].x + v[j].y * v[j].y + v[j].z * v[j].z + v[j].w * v[j].w; }
        const float rs = rsqrtf(wave_sum(ss) * (1.f / D) + EPS);
        float lr[16];
#pragma unroll
        for (int i = 0; i < 16; ++i) lr[i] = 0.f;
#pragma unroll 1
        for (int j = 0; j < 4; ++j) {
            const int k0 = 4 * lane + 256 * j;
            const f32x4 g = *(const f32x4*)(gpre + k0), s1 = *(const f32x4*)(sc + k0), s0 = *(const f32x4*)(sh + k0);
            const f32x4 vj = (j == 0) ? v[0] : (j == 1) ? v[1] : (j == 2) ? v[2] : v[3];
            f32x4 h = vj * rs * g * (s1 + 1.f) + s0;
            u32x2 o; o.x = pk2(h.x, h.y); o.y = pk2(h.z, h.w);
            *(u32x2*)(HL + (size_t)row * D + k0) = o;
#pragma unroll
            for (int i = 0; i < 4; ++i) {
                const float hv = h[i];
#pragma unroll
                for (int q = 0; q < 4; ++q) { const f32x4 w = *(const f32x4*)(wlr + (k0 + i) * 16 + 4 * q); lr[4 * q + 0] += hv * w.x; lr[4 * q + 1] += hv * w.y; lr[4 * q + 2] += hv * w.z; lr[4 * q + 3] += hv * w.w; }
            }
        }
#pragma unroll
        for (int i = 0; i < 16; ++i) lr[i] = wave_sum(lr[i]);
        const int dir = lane >> 5, c0 = (4 * lane) & 127;
        f32x4 z = *(const f32x4*)(gb + dir * 128 + c0);
#pragma unroll
        for (int i = 0; i < 16; ++i) { const f32x4 w = *(const f32x4*)(gw + (dir * 16 + i) * 128 + c0); z += w * lr[i]; }
        f32x4 la; la.x = logsig_f(z.x) * 0.0625f; la.y = logsig_f(z.y) * 0.0625f; la.z = logsig_f(z.z) * 0.0625f; la.w = logsig_f(z.w) * 0.0625f;
        *(f32x4*)(LA + (size_t)row * 256 + 4 * lane) = la;
    }
}

constexpr int G_BUF = 65536, G_BS = 32768, G_ROWSRC = 131072;
template <class Epi>
__device__ __forceinline__ void gemm_tile(char* lds, const bf16* __restrict__ A, const bf16* __restrict__ Bt, int K, const Epi& epi) {
    const int tid = tid_now(), lane = tid & 63, wid = __builtin_amdgcn_readfirstlane(tid >> 6), wr = wid >> 2, wc = wid & 3, fr = lane & 15, fq = lane >> 4;
    const int* rowsrc = (const int*)(lds + G_ROWSRC);
    unsigned ao[4], bo[4];
#pragma unroll
    for (int i = 0; i < 4; ++i) { const int r = wid * 32 + i * 8 + (lane >> 3), c = (lane & 7) ^ (r & 7);
        ao[i] = (unsigned)rowsrc[r] * (unsigned)K + c * 8; bo[i] = (unsigned)r * (unsigned)K + c * 8; }
    LAS unsigned char* l3 = (LAS unsigned char*)lds;
#define G_STAGE(buf, kt) do { _Pragma("unroll") for (int _i = 0; _i < 4; ++_i) { \
        __builtin_amdgcn_global_load_lds((const unsigned*)(A + ao[_i] + (kt) * 64), (LAS unsigned*)(l3 + (buf) * G_BUF + wid * 4096 + _i * 1024), 16, 0, 0); \
        __builtin_amdgcn_global_load_lds((const unsigned*)(Bt + bo[_i] + (kt) * 64), (LAS unsigned*)(l3 + (buf) * G_BUF + G_BS + wid * 4096 + _i * 1024), 16, 0, 0); } } while (0)
    G_STAGE(0, 0);
    f32x4 acc[8][4];
#pragma unroll
    for (int m = 0; m < 8; ++m)
#pragma unroll
        for (int n = 0; n < 4; ++n) acc[m][n] = (f32x4){0.f, 0.f, 0.f, 0.f};
    const int nkt = K >> 6;
    const int sw = fr & 7;
#pragma unroll 1
    for (int kt = 0; kt < nkt; ++kt) {
        asm volatile("s_waitcnt vmcnt(0)" ::: "memory");
        __syncthreads();
        if (kt + 1 < nkt) { if (kt & 1) G_STAGE(0, kt + 1); else G_STAGE(1, kt + 1); }
        const char* As = lds + (kt & 1) * G_BUF; const char* Bs = As + G_BS;
#pragma unroll
        for (int ks = 0; ks < 2; ++ks) {
            const int ch = ((ks * 4 + fq) ^ sw) << 4;
            bf16x8 bfr[4];
#pragma unroll
            for (int n = 0; n < 4; ++n) bfr[n] = *(const bf16x8*)(Bs + (wc * 64 + n * 16 + fr) * 128 + ch);
#pragma unroll
            for (int m = 0; m < 8; ++m) {
                const bf16x8 af = *(const bf16x8*)(As + (wr * 128 + m * 16 + fr) * 128 + ch);
#pragma unroll
                for (int n = 0; n < 4; ++n) acc[m][n] = __builtin_amdgcn_mfma_f32_16x16x32_bf16(bfr[n], af, acc[m][n], 0, 0, 0);
            }
        }
    }
#undef G_STAGE
    epi(acc, wr, wc, fr, fq);
    __syncthreads();
}

struct EpiInProj {
    bf16* P; const float* tab8; const float* tab16; int row0, pn;
    __device__ __forceinline__ void operator()(f32x4 (&acc)[8][4], int wr, int wc, int fr, int fq) const {
        const int cg = pn * 4 + wc, cb = cg * 64;
        const bool lat = ((row0 >> 8) % 33) != 0;
        int kind = 0;
        float scale = 1.f;
        if (cg < 4) { kind = 1; if (cg >= 2) scale = 0.17677669529663687f; }
        else if (cg >= 8 && cg < 12) kind = 3;
        else if (cg == 12 || cg == 13) scale = 0.17677669529663687f;
        else if (cg >= 20 && cg < 24) kind = 3;
        else if (cg >= 24 && cg < 40) { kind = 2; if (cg < 32) scale = 0.18033688011112042f; }
#pragma unroll
        for (int m = 0; m < 8; ++m) {
            const int row = row0 + wr * 128 + m * 16 + fr;
            const int pos = row >= POSB ? row - POSB : row, t = pos - CTX, prow = (t >> 6) & 127, pcol = t & 63;
            f32x4 v[4];
#pragma unroll
            for (int n = 0; n < 4; ++n) v[n] = acc[m][n];
            if (kind == 1) {
                if (lat) {
#pragma unroll
                    for (int n = 0; n < 4; ++n) {
                        const int pp = (n & 1) ? pcol : prow;
                        const float* tb = tab8 + (pp * 8 + 4 * (fq & 1)) * 2;
                        const f32x4 t0 = *(const f32x4*)tb, t1 = *(const f32x4*)(tb + 4);
                        const float cs[4] = {t0.x, t0.z, t1.x, t1.z}, sn[4] = {t0.y, t0.w, t1.y, t1.w};
#pragma unroll
                        for (int i = 0; i < 4; ++i) { const float me = v[n][i], other = __shfl_xor(me, 32);
                            v[n][i] = (fq < 2) ? me * cs[i] - other * sn[i] : other * sn[i] + me * cs[i]; }
                    }
                }
            } else if (kind == 2) {
                if (lat) {
#pragma unroll
                    for (int hpart = 0; hpart < 2; ++hpart) {
                        const int pp = hpart ? pcol : prow;
                        const float* tb = tab16 + (pp * 16 + 4 * fq) * 2;
                        const f32x4 t0 = *(const f32x4*)tb, t1 = *(const f32x4*)(tb + 4);
                        const float cs[4] = {t0.x, t0.z, t1.x, t1.z}, sn[4] = {t0.y, t0.w, t1.y, t1.w};
#pragma unroll
                        for (int i = 0; i < 4; ++i) { const float a0 = v[2 * hpart][i], a1 = v[2 * hpart + 1][i];
                            v[2 * hpart][i] = a0 * cs[i] - a1 * sn[i]; v[2 * hpart + 1][i] = a0 * sn[i] + a1 * cs[i]; }
                    }
                }
            } else if (kind == 3) {
#pragma unroll
                for (int n = 0; n < 4; ++n)
#pragma unroll
                    for (int i = 0; i < 4; ++i) v[n][i] = silu_f(v[n][i]);
            }
#pragma unroll
            for (int n = 0; n < 4; ++n) { u32x2 o; o.x = pk2(v[n].x * scale, v[n].y * scale); o.y = pk2(v[n].z * scale, v[n].w * scale);
                *(u32x2*)(P + (size_t)row * NP + cb + n * 16 + 4 * fq) = o; }
        }
    }
};
struct EpiF32 {
    float* O; int ldo, row0, col0;
    __device__ __forceinline__ void operator()(f32x4 (&acc)[8][4], int wr, int wc, int fr, int fq) const {
#pragma unroll
        for (int m = 0; m < 8; ++m)
#pragma unroll
            for (int n = 0; n < 4; ++n) *(f32x4*)(O + (size_t)(row0 + wr * 128 + m * 16 + fr) * ldo + col0 + wc * 64 + n * 16 + 4 * fq) = acc[m][n];
    }
};
struct EpiBf16 {
    bf16* O; int ldo, row0, col0;
    __device__ __forceinline__ void operator()(f32x4 (&acc)[8][4], int wr, int wc, int fr, int fq) const {
#pragma unroll
        for (int m = 0; m < 8; ++m)
#pragma unroll
            for (int n = 0; n < 4; ++n) { u32x2 o; o.x = pk2(acc[m][n].x, acc[m][n].y); o.y = pk2(acc[m][n].z, acc[m][n].w);
                *(u32x2*)(O + (size_t)(row0 + wr * 128 + m * 16 + fr) * ldo + col0 + wc * 64 + n * 16 + 4 * fq) = o; }
    }
};
struct EpiGateUp {
    bf16* H; int row0, nt;
    __device__ __forceinline__ void operator()(f32x4 (&acc)[8][4], int wr, int wc, int fr, int fq) const {
#pragma unroll
        for (int m = 0; m < 8; ++m)
#pragma unroll
            for (int pp = 0; pp < 2; ++pp) { const f32x4 g = acc[m][2 * pp], u = acc[m][2 * pp + 1];
                u32x2 o; o.x = pk2(silu_f(g.x) * u.x, silu_f(g.y) * u.y); o.y = pk2(silu_f(g.z) * u.z, silu_f(g.w) * u.w);
                *(u32x2*)(H + (size_t)(row0 + wr * 128 + m * 16 + fr) * DEXP + 128 * nt + 32 * wc + 16 * pp + 4 * fq) = o; }
    }
};

__device__ __forceinline__ void phase_b(PRef p, int l, char* lds) {
    int* rowsrc = (int*)(lds + G_ROWSRC);
    const bf16* HL = (const bf16*)(p.ws + WS_HL); const bf16* WIN = (const bf16*)(p.ws + WS_WIN);
    for (int u = blockIdx.x; u < 66 * 12; u += gridDim.x) {
        const int pm = u / 12, pn = u % 12;
        if (tid_now() < 256) rowsrc[tid_now()] = pm * 256 + tid_now();
        __syncthreads();
        EpiInProj E{(bf16*)(p.ws + WS_P), (const float*)(p.ws + WS_TAB8), (const float*)(p.ws + WS_TAB16), pm * 256, pn};
        gemm_tile(lds, HL, WIN + (size_t)pn * 256 * D, D, E);
    }
}

constexpr int L_BF = 0;
constexpr int L_BS = 16896;
constexpr int L_SEG = 33792;
constexpr int L_A = 36864;
constexpr int LO_QF = 36864;
constexpr int LO_KF = LO_QF + 10240;
constexpr int LO_QB = LO_KF + 10240;
constexpr int LO_KB = LO_QB + 10240;
constexpr int LO_QI = LO_KB + 10240;
constexpr int LO_ST = LO_QI + 18432;
constexpr int LO_VT = LO_ST + 9216;
constexpr int LO_W = 0;
constexpr int LO_SS = LO_VT + 17408;
static_assert(34816 <= L_A, "W overlay");
static_assert(LO_SS + 1024 <= LDS_MISC, "lin LDS");

struct LinCfg { int type; int qcol, kcol, vcol, gcol, ocol; };

__device__ __forceinline__ void lin_prefix(PRef p, int l, int type, int h, int r0, bool already, char* lds) {
    const int tid = tid_now();
    float* bf = (float*)(lds + L_BF); float* bs = (float*)(lds + L_BS); float* seg = (float*)(lds + L_SEG);
    if (type == 0) {
        const float* sc = (const float*)(p.ws + WS_SCAL) + l * 16;
        const float lgf = sc[2 + h], lgb = sc[6 + h];
        for (int i = tid; i < 128 * 32; i += NTHR) { const int j = i >> 5, kk = i & 31; bf[j * 33 + kk] = (float)(j + 1) * lgf; bs[j * 33 + kk] = (float)(128 - j) * lgb; }
        __syncthreads();
        return;
    }
    float* LA = (float*)(p.ws + WS_LA);
    if (already) {
        for (int i = tid; i < 128 * 32; i += NTHR) { const int j = i >> 5, kk = i & 31; const float* s = LA + (size_t)(r0 + j) * 256 + h * 32 + kk; bf[j * 33 + kk] = s[0]; bs[j * 33 + kk] = s[128]; }
        __syncthreads();
        return;
    }
    for (int i = tid; i < 128 * 32; i += NTHR) { const int j = i >> 5, kk = i & 31; const float* s = LA + (size_t)(r0 + j) * 256 + h * 32 + kk; bf[j * 33 + kk] = s[0]; bs[j * 33 + kk] = s[128]; }
    __syncthreads();
    const int chain = tid & 63, sg = tid >> 6, dir = chain >> 5, kk = chain & 31;
    float* arr = dir ? bs : bf;
    float tot = 0.f;
    for (int q = 0; q < 16; ++q) tot += arr[(sg * 16 + q) * 33 + kk];
    seg[chain * 8 + sg] = tot;
    __syncthreads();
    float off = 0.f;
    if (dir == 0) { for (int q = 0; q < sg; ++q) off += seg[chain * 8 + q];
        for (int q = 0; q < 16; ++q) { const int j = sg * 16 + q; off += arr[j * 33 + kk]; arr[j * 33 + kk] = off; } }
    else { for (int q = 7; q > sg; --q) off += seg[chain * 8 + q];
        for (int q = 15; q >= 0; --q) { const int j = sg * 16 + q; off += arr[j * 33 + kk]; arr[j * 33 + kk] = off; } }
    __syncthreads();
    for (int i = tid; i < 128 * 32; i += NTHR) { const int j = i >> 5, k2 = i & 31; float* s = LA + (size_t)(r0 + j) * 256 + h * 32 + k2; s[0] = bf[j * 33 + k2]; s[128] = bs[j * 33 + k2]; }
}

__device__ __forceinline__ LinCfg lin_cfg(int type, int h) {
    LinCfg c; c.type = type;
    if (type == 0) { c.qcol = h * 32; c.kcol = 128 + h * 32; c.vcol = 256 + h * 64; c.gcol = 512 + h * 64; c.ocol = h * 64; }
    else { c.qcol = 768 + h * 32; c.kcol = 896 + h * 32; c.vcol = 1024 + h * 64; c.gcol = 1280 + h * 64; c.ocol = 256 + h * 64; }
    return c;
}
__device__ __forceinline__ size_t us_index(int b, int h, int type, int dir, int c) { return ((((size_t)(b * 4 + h) * 2 + type) * 2 + dir) * NCH + c) * 2048; }

__device__ __forceinline__ void lin_u_item(PRef p, int l, int item, char* lds) {
    const int tid = tid_now();
    const int type = item & 1, h = (item >> 1) & 3, b = (item >> 3) & 1, c = item >> 4;
    const LinCfg cf = lin_cfg(type, h);
    const int r0 = b * POSB + c * 128;
    lin_prefix(p, l, type, h, r0, false, lds);
    const float* bf = (const float*)(lds + L_BF); const float* bs = (const float*)(lds + L_BS);
    float* kuf = (float*)(lds + L_A); float* kub = kuf + 128 * 33; float* vv = kub + 128 * 33;
    const bf16* P = (const bf16*)(p.ws + WS_P);
    for (int i = tid; i < 128 * 32; i += NTHR) { const int j = i >> 5, kk = i & 31;
        const float kv = bf2f(P[(size_t)(r0 + j) * NP + cf.kcol + kk]);
        kuf[j * 33 + kk] = kv * __expf(bf[127 * 33 + kk] - bf[j * 33 + kk]);
        kub[j * 33 + kk] = kv * __expf(bs[0 * 33 + kk] - bs[j * 33 + kk]); }
    for (int i = tid; i < 128 * 64; i += NTHR) { const int j = i >> 6, dv = i & 63; vv[j * 64 + dv] = bf2f(P[(size_t)(r0 + j) * NP + cf.vcol + dv]); }
    if (type == 1 && tid < 64) { const int dir = tid >> 5, kk = tid & 31;
        ((float*)(p.ws + WS_DEC))[(((size_t)(b * 4 + h) * 2 + dir) * NCH + c) * 32 + kk] = __expf(dir ? bs[kk] : bf[127 * 33 + kk]); }
    __syncthreads();
    const int dir = tid >> 8, kk = (tid >> 3) & 31, dvg = tid & 7;
    const float* ku = dir ? kub : kuf;
    float a[8];
#pragma unroll
    for (int i = 0; i < 8; ++i) a[i] = 0.f;
    for (int j = 0; j < 128; ++j) { const float kx = ku[j * 33 + kk]; const f32x4 v0 = *(const f32x4*)(vv + j * 64 + dvg * 8), v1 = *(const f32x4*)(vv + j * 64 + dvg * 8 + 4);
        a[0] += kx * v0.x; a[1] += kx * v0.y; a[2] += kx * v0.z; a[3] += kx * v0.w; a[4] += kx * v1.x; a[5] += kx * v1.y; a[6] += kx * v1.z; a[7] += kx * v1.w; }
    float* U = (float*)(p.ws + WS_US) + us_index(b, h, type, dir, c) + kk * 64 + dvg * 8;
    *(f32x4*)U = (f32x4){a[0], a[1], a[2], a[3]}; *(f32x4*)(U + 4) = (f32x4){a[4], a[5], a[6], a[7]};
    __syncthreads();
}

__device__ __forceinline__ void vt_item(PRef p, int item, char* lds) {
    const int tid = tid_now();
    const int g64 = item % 132, h = (item / 132) & 3, b = item / 528;
    const bf16* P = (const bf16*)(p.ws + WS_P); bf16* VT = (bf16*)(p.ws + WS_VT);
    bf16* t = (bf16*)lds;
#pragma unroll
    for (int i = 0; i < 2; ++i) { const int q = tid + 512 * i, j = q >> 4, ch = q & 15;
        const u32x4 v = *(const u32x4*)(P + (size_t)(b * POSB + g64 * 64 + j) * NP + 2560 + h * 128 + ch * 8);
        const int jp = (j & ~12) | ((j & 4) << 1) | ((j & 8) >> 1);
        const unsigned w[4] = {v.x, v.y, v.z, v.w};
#pragma unroll
        for (int e = 0; e < 4; ++e) { t[(ch * 8 + 2 * e) * 72 + jp] = (bf16)(w[e] & 0xffff); t[(ch * 8 + 2 * e + 1) * 72 + jp] = (bf16)(w[e] >> 16); } }
    __syncthreads();
#pragma unroll
    for (int i = 0; i < 2; ++i) { const int q = tid + 512 * i, dv = q >> 3, ch = q & 7;
        *(u32x4*)(VT + ((size_t)(b * 4 + h) * 128 + dv) * POSB + g64 * 64 + ch * 8) = *(const u32x4*)(t + dv * 72 + ch * 8); }
    __syncthreads();
}

__device__ __forceinline__ void phase_c(PRef p, int l, char* lds) {
    constexpr int NU = NCH * 16, NV = 2 * 4 * 132;
    for (int it = blockIdx.x; it < NU + NV; it += gridDim.x) {
        if (it < NV) vt_item(p, it, lds); else lin_u_item(p, l, it - NV, lds);
    }
}

__device__ __forceinline__ void phase_d(PRef p, int l) {
    const int gt = blockIdx.x * NTHR + tid_now();
    if (gt >= 32 * 2048) return;
    const int e = gt & 2047, chain = gt >> 11;
    const int dir = chain & 1, type = (chain >> 1) & 1, h = (chain >> 2) & 3, b = chain >> 4;
    float* U = (float*)(p.ws + WS_US) + (size_t)chain * NCH * 2048 + e;
    const float* DEC = (const float*)(p.ws + WS_DEC) + ((size_t)(b * 4 + h) * 2 + dir) * NCH * 32 + (e >> 6);
    const float* sc = (const float*)(p.ws + WS_SCAL) + l * 16;
    const float dret = __expf(128.f * sc[2 + dir * 4 + h]);
    float S = 0.f;
#pragma unroll 6
    for (int s = 0; s < NCH; ++s) {
        const int c = dir == 0 ? s : (s < 2 ? 1 - s : 67 - s);
        const float u = U[(size_t)c * 2048];
        const float d = type ? DEC[c * 32] : dret;
        U[(size_t)c * 2048] = S;
        S = d * S + u;
    }
}

__device__ __forceinline__ void lin_out_item(PRef p, int l, int item, char* lds) {
    const int tid = tid_now(), lane = tid & 63, wid = tid >> 6;
    const int type = item & 1, h = (item >> 1) & 3, b = (item >> 3) & 1, c = item >> 4;
    const LinCfg cf = lin_cfg(type, h);
    const int r0 = b * POSB + c * 128;
    lin_prefix(p, l, type, h, r0, true, lds);
    const float* bf = (const float*)(lds + L_BF); const float* bs = (const float*)(lds + L_BS);
    bf16* qf = (bf16*)(lds + LO_QF); bf16* kf = (bf16*)(lds + LO_KF); bf16* qb = (bf16*)(lds + LO_QB); bf16* kb = (bf16*)(lds + LO_KB);
    bf16* qi = (bf16*)(lds + LO_QI); bf16* st = (bf16*)(lds + LO_ST); bf16* vt = (bf16*)(lds + LO_VT); bf16* W = (bf16*)(lds + LO_W);
    float* ssq = (float*)(lds + LO_SS);
    const bf16* P = (const bf16*)(p.ws + WS_P);
    for (int i = tid; i < 128 * 32; i += NTHR) { const int j = i >> 5, kk = i & 31;
        const float qv = bf2f(P[(size_t)(r0 + j) * NP + cf.qcol + kk]), kv = bf2f(P[(size_t)(r0 + j) * NP + cf.kcol + kk]);
        const float f = bf[j * 33 + kk], fm = bf[63 * 33 + kk], s = bs[j * 33 + kk], sm = bs[64 * 33 + kk];
        qf[j * 40 + kk] = (bf16)f2bf(qv * __expf(f - fm)); kf[j * 40 + kk] = (bf16)f2bf(kv * __expf(fm - f));
        qb[j * 40 + kk] = (bf16)f2bf(qv * __expf(s - sm)); kb[j * 40 + kk] = (bf16)f2bf(kv * __expf(sm - s));
        qi[j * 72 + kk] = (bf16)f2bf(qv * __expf(f)); qi[j * 72 + 32 + kk] = (bf16)f2bf(qv * __expf(s)); }
    for (int i = tid; i < 128 * 64; i += NTHR) { const int j = i >> 6, dv = i & 63; vt[dv * 136 + j] = P[(size_t)(r0 + j) * NP + cf.vcol + dv]; }
    { const float* Sf = (const float*)(p.ws + WS_US) + us_index(b, h, type, 0, c); const float* Sb = (const float*)(p.ws + WS_US) + us_index(b, h, type, 1, c);
      for (int i = tid; i < 2048; i += NTHR) { const int kk = i >> 6, dv = i & 63; st[dv * 72 + kk] = (bf16)f2bf(Sf[i]); st[dv * 72 + 32 + kk] = (bf16)f2bf(Sb[i]); } }
    __syncthreads();
    const int li = lane & 31, hi = lane >> 5;
    {
        const int bi = wid >> 1;
#pragma unroll
        for (int jj = 0; jj < 2; ++jj) {
            const int bj = (wid & 1) * 2 + jj;
            f32x16 af = {0}, ab = {0};
#pragma unroll
            for (int s = 0; s < 2; ++s) {
                const bf16x8 kfa = *(const bf16x8*)(kf + (bj * 32 + li) * 40 + 16 * s + 8 * hi), qfb = *(const bf16x8*)(qf + (bi * 32 + li) * 40 + 16 * s + 8 * hi);
                const bf16x8 kba = *(const bf16x8*)(kb + (bj * 32 + li) * 40 + 16 * s + 8 * hi), qbb = *(const bf16x8*)(qb + (bi * 32 + li) * 40 + 16 * s + 8 * hi);
                af = __builtin_amdgcn_mfma_f32_32x32x16_bf16(kfa, qfb, af, 0, 0, 0);
                ab = __builtin_amdgcn_mfma_f32_32x32x16_bf16(kba, qbb, ab, 0, 0, 0);
            }
            const int i = bi * 32 + li;
#pragma unroll
            for (int a = 0; a < 4; ++a) {
                float w[4];
#pragma unroll
                for (int q = 0; q < 4; ++q) { const int j = bj * 32 + 8 * a + 4 * hi + q; w[q] = (i >= j ? af[4 * a + q] : 0.f) + (j >= i ? ab[4 * a + q] : 0.f); }
                u32x2 o; o.x = pk2(w[0], w[1]); o.y = pk2(w[2], w[3]);
                *(u32x2*)(W + i * 136 + bj * 32 + 8 * a + 4 * hi) = o;
            }
        }
    }
    __syncthreads();
    const int bi = wid >> 1, bd = wid & 1;
    f32x16 o = {0};
#pragma unroll
    for (int s = 0; s < 8; ++s) {
        const bf16x8 va = *(const bf16x8*)(vt + (bd * 32 + li) * 136 + 16 * s + 8 * hi), wb = *(const bf16x8*)(W + (bi * 32 + li) * 136 + 16 * s + 8 * hi);
        o = __builtin_amdgcn_mfma_f32_32x32x16_bf16(va, wb, o, 0, 0, 0);
    }
#pragma unroll
    for (int s = 0; s < 4; ++s) {
        const bf16x8 sa = *(const bf16x8*)(st + (bd * 32 + li) * 72 + 16 * s + 8 * hi), qq = *(const bf16x8*)(qi + (bi * 32 + li) * 72 + 16 * s + 8 * hi);
        o = __builtin_amdgcn_mfma_f32_32x32x16_bf16(sa, qq, o, 0, 0, 0);
    }
    float ss = 0.f;
#pragma unroll
    for (int r = 0; r < 16; ++r) ss += o[r] * o[r];
    ss += __shfl_xor(ss, 32);
    const int tok = bi * 32 + li;
    if (hi == 0) ssq[tok * 2 + bd] = ss;
    __syncthreads();
    const bool need = (l == 0) || (c >= 2);
    if (need) {
        const float rn = rsqrtf((ssq[tok * 2] + ssq[tok * 2 + 1]) * (1.f / 64.f) + EPS);
        bf16* CAT = (bf16*)(p.ws + WS_CAT);
        const float* gg = p.in[15] + l * 64;
#pragma unroll
        for (int a = 0; a < 4; ++a) {
            const int dv = bd * 32 + 8 * a + 4 * hi;
            const u32x2 gt = *(const u32x2*)(P + (size_t)(r0 + tok) * NP + cf.gcol + dv);
            f32x4 g4 = {1.f, 1.f, 1.f, 1.f};
            if (type == 1) g4 = *(const f32x4*)(gg + dv);
            u32x2 ov; ov.x = pk2(o[4 * a] * rn * g4.x * bflo(gt.x), o[4 * a + 1] * rn * g4.y * bfhi(gt.x));
            ov.y = pk2(o[4 * a + 2] * rn * g4.z * bflo(gt.y), o[4 * a + 3] * rn * g4.w * bfhi(gt.y));
            *(u32x2*)(CAT + (size_t)(r0 + tok) * D + cf.ocol + dv) = ov;
        }
    }
    __syncthreads();
}

constexpr int AT_K0 = 0, AT_K1 = 8192, AT_V = 16384, AT_X = 32768;
__device__ __forceinline__ void attn_unit(PRef p, int l, int b, int h, int qpos0, int nkeys, char* lds) {
    const int tid = tid_now(), lane = tid & 63, wid = tid >> 6, m = wid >> 2, qr = (wid & 3) * 32, qi = lane & 31, hi = lane >> 5;
    const bf16* P = (const bf16*)(p.ws + WS_P); const bf16* VT = (const bf16*)(p.ws + WS_VT);
    const size_t rowb = (size_t)b * POSB;
    bf16x8 qf[4];
    { const bf16* qp = P + (rowb + qpos0 + qr + qi) * NP + 1536 + h * 128 + m * 64 + 8 * hi;
#pragma unroll
      for (int s = 0; s < 4; ++s) qf[s] = *(const bf16x8*)(qp + 16 * s); }
    const int kkey = tid >> 3, kc = tid & 7;
    const bf16* gk0 = P + (rowb + kkey) * NP + 2048 + h * 128 + kc * 8;
    const int sk = kkey * 128 + ((kc ^ (kkey & 7)) << 4);
    const bf16* gv[2]; int sv[2];
#pragma unroll
    for (int i = 0; i < 2; ++i) { const int q = tid + 512 * i, dv = q >> 3, c = q & 7; gv[i] = VT + ((size_t)(b * 4 + h) * 128 + dv) * POSB + c * 8; sv[i] = dv * 128 + ((c ^ (dv & 7)) << 4); }
    u32x4 rk0, rk1, rv0, rv1;
    rk0 = *(const u32x4*)gk0; rk1 = *(const u32x4*)(gk0 + 64); rv0 = *(const u32x4*)gv[0]; rv1 = *(const u32x4*)gv[1];
    f32x16 oacc[4];
#pragma unroll
    for (int t = 0; t < 4; ++t) oacc[t] = (f32x16){0};
    float mrun = -1e30f, lrun = 0.f;
    const int nt = nkeys >> 6;
    const char* Kl = lds + (m ? AT_K1 : AT_K0); const char* Vl = lds + AT_V;
    for (int kt = 0; kt < nt; ++kt) {
        __syncthreads();
        *(u32x4*)(lds + AT_K0 + sk) = rk0; *(u32x4*)(lds + AT_K1 + sk) = rk1; *(u32x4*)(lds + AT_V + sv[0]) = rv0; *(u32x4*)(lds + AT_V + sv[1]) = rv1;
        __syncthreads();
        if (kt + 1 < nt) { const size_t ko = (size_t)(kt + 1) * 64 * NP; rk0 = *(const u32x4*)(gk0 + ko); rk1 = *(const u32x4*)(gk0 + ko + 64);
            rv0 = *(const u32x4*)(gv[0] + (kt + 1) * 64); rv1 = *(const u32x4*)(gv[1] + (kt + 1) * 64); }
        f32x16 sT[2];
#pragma unroll
        for (int kb = 0; kb < 2; ++kb) {
            sT[kb] = (f32x16){0};
            const int krow = kb * 32 + qi;
#pragma unroll
            for (int s = 0; s < 4; ++s) {
                const bf16x8 ka = *(const bf16x8*)(Kl + krow * 128 + (((2 * s + hi) ^ (krow & 7)) << 4));
                sT[kb] = __builtin_amdgcn_mfma_f32_32x32x16_bf16(ka, qf[s], sT[kb], 0, 0, 0);
            }
        }
        float mx = sT[0][0];
#pragma unroll
        for (int r = 1; r < 16; ++r) mx = fmaxf(mx, sT[0][r]);
#pragma unroll
        for (int r = 0; r < 16; ++r) mx = fmaxf(mx, sT[1][r]);
        mx = fmaxf(mx, __shfl_xor(mx, 32));
        const float mnew = fmaxf(mrun, mx);
        const float alpha = __builtin_amdgcn_exp2f(mrun - mnew);
        mrun = mnew;
        float ls = 0.f;
#pragma unroll
        for (int kb = 0; kb < 2; ++kb)
#pragma unroll
            for (int r = 0; r < 16; ++r) { const float pv = __builtin_amdgcn_exp2f(sT[kb][r] - mnew); sT[kb][r] = pv; ls += pv; }
        lrun = lrun * alpha + ls;
        if (__any(alpha != 1.f)) {
#pragma unroll
            for (int t = 0; t < 4; ++t)
#pragma unroll
                for (int r = 0; r < 16; ++r) oacc[t][r] *= alpha;
        }
        bf16x8 pf[2][2];
#pragma unroll
        for (int kb = 0; kb < 2; ++kb)
#pragma unroll
            for (int ks = 0; ks < 2; ++ks) {
                u32x4 w; w.x = pk2(sT[kb][8 * ks + 0], sT[kb][8 * ks + 1]); w.y = pk2(sT[kb][8 * ks + 2], sT[kb][8 * ks + 3]);
                w.z = pk2(sT[kb][8 * ks + 4], sT[kb][8 * ks + 5]); w.w = pk2(sT[kb][8 * ks + 6], sT[kb][8 * ks + 7]);
                pf[kb][ks] = __builtin_bit_cast(bf16x8, w);
            }
#pragma unroll
        for (int t = 0; t < 4; ++t) {
            const int vrow = 32 * t + qi;
#pragma unroll
            for (int kb = 0; kb < 2; ++kb)
#pragma unroll
                for (int ks = 0; ks < 2; ++ks) {
                    const bf16x8 va = *(const bf16x8*)(Vl + vrow * 128 + (((4 * kb + 2 * ks + hi) ^ (vrow & 7)) << 4));
                    oacc[t] = __builtin_amdgcn_mfma_f32_32x32x16_bf16(va, pf[kb][ks], oacc[t], 0, 0, 0);
                }
        }
    }
    const float ltot = lrun + __shfl_xor(lrun, 32);
    const float inv = 1.f / ltot;
    __syncthreads();
    float* X = (float*)(lds + AT_X) + (wid & 3) * 4096;
    if (m == 1) {
#pragma unroll
        for (int t = 0; t < 4; ++t)
#pragma unroll
            for (int r = 0; r < 16; ++r) X[(t * 16 + r) * 64 + lane] = oacc[t][r] * inv;
    }
    __syncthreads();
    if (m == 0) {
        const float* sc = (const float*)(p.ws + WS_SCAL) + l * 16;
        const float lam = sc[0], post = 1.f - sc[1];
        float ss = 0.f;
#pragma unroll
        for (int t = 0; t < 4; ++t)
#pragma unroll
            for (int r = 0; r < 16; ++r) { const float v = oacc[t][r] * inv - lam * X[(t * 16 + r) * 64 + lane]; oacc[t][r] = v; ss += v * v; }
        ss += __shfl_xor(ss, 32);
        const float rn = rsqrtf(ss * (1.f / 128.f) + EPS) * post;
        bf16* CAT = (bf16*)(p.ws + WS_CAT) + (rowb + qpos0 + qr + qi) * D + 512 + h * 128;
        const float* dg = p.in[17] + l * 128;
#pragma unroll
        for (int t = 0; t < 4; ++t)
#pragma unroll
            for (int a = 0; a < 4; ++a) {
                const int dv = 32 * t + 8 * a + 4 * hi;
                const f32x4 g4 = *(const f32x4*)(dg + dv);
                u32x2 ov; ov.x = pk2(oacc[t][4 * a] * rn * g4.x, oacc[t][4 * a + 1] * rn * g4.y); ov.y = pk2(oacc[t][4 * a + 2] * rn * g4.z, oacc[t][4 * a + 3] * rn * g4.w);
                *(u32x2*)(CAT + dv) = ov;
            }
    }
    __syncthreads();
}

__device__ __forceinline__ void phase_e(PRef p, int l, char* lds) {
    const int n_att = 512 + (l == 0 ? 16 : 0);
    const int n_lin = NCH * 16;
    for (int it = blockIdx.x; it < n_att + n_lin; it += gridDim.x) {
        if (it < 512) { const int bh = it & 7, qb = it >> 3; attn_unit(p, l, bh >> 2, bh & 3, CTX + qb * 128, POSB, lds); }
        else if (it < n_att) { const int u = it - 512, bh = u & 7, qb = u >> 3; attn_unit(p, l, bh >> 2, bh & 3, qb * 128, CTX, lds); }
        else { const int item = it - n_att; if (l == 0 || (item >> 4) >= 2) lin_out_item(p, l, item, lds); }
    }
}

__device__ __forceinline__ void phase_f(PRef p, int l, char* lds) {
    int* rowsrc = (int*)(lds + G_ROWSRC);
    const bf16* CAT = (const bf16*)(p.ws + WS_CAT); const bf16* WOUT = (const bf16*)(p.ws + WS_WOUT);
    const int ntm = (l == 0) ? 66 : 64;
    for (int u = blockIdx.x; u < ntm * 4; u += gridDim.x) {
        int pm = u >> 2; const int pn = u & 3;
        if (l != 0) pm = pm + 1 + (pm >= 32 ? 1 : 0);
        if (tid_now() < 256) rowsrc[tid_now()] = pm * 256 + tid_now();
        __syncthreads();
        EpiF32 E{(float*)(p.ws + WS_MO), D, pm * 256, pn * 256};
        gemm_tile(lds, CAT, WOUT + (size_t)pn * 256 * D, D, E);
    }
}

__device__ __forceinline__ int ffn_row(int l, int idx) {
    if (l == 0) return idx;
    const int b = idx >> 13, t = idx & 8191; return b * POSB + CTX + t;
}
__device__ __forceinline__ void phase_g(PRef p, int l, char* lds) {
    const int tid = tid_now(), lane = tid & 63, wave = tid >> 6;
    const int ntok = (l == 0) ? R : BATCH * SEQ;
    float* hrow = (float*)(lds + wave * 16384);
    const float* mods = (const float*)(p.ws + WS_MODS) + (size_t)l * 3 * 6144;
    const float* gpost = p.in[7] + l * D; const float* gpre = p.in[8] + l * D;
    const float* wr = p.in[18] + (size_t)l * D * NEXP; const float bias = p.in[19][l * NEXP + lane];
    const float* MO = (const float*)(p.ws + WS_MO); bf16* HL = (bf16*)(p.ws + WS_HL);
    unsigned* cnt = (unsigned*)(p.ws + WS_CTL) + CW_CNT + l * 64;
    int* rowtok = (int*)(p.ws + WS_ROWTOK); int* pslot = (int*)(p.ws + WS_PSLOT); float* pw = (float*)(p.ws + WS_PW);
    for (int g0 = (blockIdx.x * NWAVE + wave) * 4; g0 < ntok; g0 += gridDim.x * NWAVE * 4) {
#pragma unroll 1
        for (int rr = 0; rr < 4; ++rr) {
            const int row = ffn_row(l, g0 + rr);
            const int b = row_b(row), pos = row - b * POSB, rt = pos < CTX ? 2 : b;
            const float* md = mods + rt * 6144;
            const float* xr = resid_row_ptr(p, l, row); float* xo = resid_row_out(p, row);
            const float* mr = MO + (size_t)row * D;
            f32x4 mv[4], xv[4]; float ss = 0.f;
#pragma unroll
            for (int j = 0; j < 4; ++j) { mv[j] = *(const f32x4*)(mr + 4 * lane + 256 * j); xv[j] = *(const f32x4*)(xr + 4 * lane + 256 * j);
                ss += mv[j].x * mv[j].x + mv[j].y * mv[j].y + mv[j].z * mv[j].z + mv[j].w * mv[j].w; }
            const float r1 = rsqrtf(wave_sum(ss) * (1.f / D) + EPS);
            float ss2 = 0.f;
#pragma unroll
            for (int j = 0; j < 4; ++j) { const int k0 = 4 * lane + 256 * j;
                const f32x4 gp = *(const f32x4*)(gpost + k0), gt = *(const f32x4*)(md + 2 * D + k0);
                xv[j] = xv[j] + gt * (mv[j] * r1 * gp);
                *(f32x4*)(xo + k0) = xv[j];
                ss2 += xv[j].x * xv[j].x + xv[j].y * xv[j].y + xv[j].z * xv[j].z + xv[j].w * xv[j].w; }
            const float r2 = rsqrtf(wave_sum(ss2) * (1.f / D) + EPS);
#pragma unroll
            for (int j = 0; j < 4; ++j) { const int k0 = 4 * lane + 256 * j;
                const f32x4 g = *(const f32x4*)(gpre + k0), s1 = *(const f32x4*)(md + 4 * D + k0), s0 = *(const f32x4*)(md + 3 * D + k0);
                const f32x4 hv = xv[j] * r2 * g * (s1 + 1.f) + s0;
                u32x2 o; o.x = pk2(hv.x, hv.y); o.y = pk2(hv.z, hv.w);
                *(u32x2*)(HL + (size_t)row * D + k0) = o;
#pragma unroll
                for (int i = 0; i < 4; ++i) hrow[(k0 + i) * 4 + rr] = hv[i]; }
        }
        LDS_FENCE();
        float a0 = 0.f, a1 = 0.f, a2 = 0.f, a3 = 0.f;
#pragma unroll 8
        for (int k = 0; k < D; ++k) { const float w = wr[k * NEXP + lane]; const f32x4 hv = *(const f32x4*)(hrow + k * 4);
            a0 += hv.x * w; a1 += hv.y * w; a2 += hv.z * w; a3 += hv.w * w; }
        const float accs[4] = {a0, a1, a2, a3};
#pragma unroll 1
        for (int rr = 0; rr < 4; ++rr) {
            const int row = ffn_row(l, g0 + rr);
            const float score = 1.f / (1.f + __expf(-accs[rr]));
            const float sel = score + bias;
            const int grp = lane >> 3;
            float m1 = sel; m1 = fmaxf(m1, __shfl_xor(m1, 1)); m1 = fmaxf(m1, __shfl_xor(m1, 2)); m1 = fmaxf(m1, __shfl_xor(m1, 4));
            const unsigned long long bm = __ballot(sel == m1);
            const int first = __builtin_ctz((unsigned)((bm >> (8 * grp)) & 0xffull)) + 8 * grp;
            float m2 = (lane == first) ? -INFINITY : sel; m2 = fmaxf(m2, __shfl_xor(m2, 1)); m2 = fmaxf(m2, __shfl_xor(m2, 2)); m2 = fmaxf(m2, __shfl_xor(m2, 4));
            const float gs = m1 + m2;
            int rank = 0;
#pragma unroll
            for (int g2 = 0; g2 < 8; ++g2) { const float o = __shfl(gs, 8 * g2); rank += (o > gs || (o == gs && g2 < grp)) ? 1 : 0; }
            float mv = rank < 4 ? sel : -INFINITY;
            float wsum = 0.f; float myw = 0.f; int mye = 0;
#pragma unroll 1
            for (int k = 0; k < 6; ++k) {
                const float mx = wave_max(mv);
                const unsigned long long b2 = __ballot(mv == mx);
                const int e = __builtin_ctzll(b2);
                const float sce = __shfl(score, e);
                wsum += sce;
                if (lane == k) { myw = sce; mye = e; }
                if (lane == e) mv = -INFINITY;
            }
            if (lane < 6) {
                const unsigned rk = atomicAdd(cnt + mye, 1u);
                rowtok[mye * CAP + rk] = row;
                pslot[row * 8 + lane] = (mye << 16) | (int)rk;
                pw[row * 8 + lane] = myw / wsum * 2.5f;
            }
        }
    }
}

constexpr int M_TBL = 133120;
__device__ __forceinline__ void moe_table(PRef p, int l, char* lds) {
    int* tb = (int*)(lds + M_TBL);
    const unsigned* cnt = (const unsigned*)(p.ws + WS_CTL) + CW_CNT + l * 64;
    if (tid_now() == 0) {
        int acc = 0;
        for (int e = 0; e < 65; ++e) { const int c = e < 64 ? (int)__hip_atomic_load(cnt + e, __ATOMIC_RELAXED, __HIP_MEMORY_SCOPE_AGENT) : (l == 0 ? R : BATCH * SEQ);
            tb[e] = acc; tb[128 + e] = c; acc += (c + 255) >> 8; }
        tb[65] = acc;
    }
    __syncthreads();
}
__device__ __forceinline__ int moe_find(const int* tb, int tile) { int e = 0; while (e < 64 && tile >= tb[e + 1]) ++e; return e; }

__device__ __forceinline__ void phase_h(PRef p, int l, char* lds) {
    moe_table(p, l, lds);
    const int* tb = (const int*)(lds + M_TBL); int* rowsrc = (int*)(lds + G_ROWSRC);
    const int ntiles = tb[65];
    const bf16* HL = (const bf16*)(p.ws + WS_HL); const bf16* WGU = (const bf16*)(p.ws + WS_WGU);
    const int* rowtok = (const int*)(p.ws + WS_ROWTOK);
    for (int u = blockIdx.x; u < ntiles * 2; u += gridDim.x) {
        const int tile = u >> 1, nt = u & 1;
        const int e = moe_find(tb, tile), ti = tile - tb[e], cnt = tb[128 + e];
        if (tid_now() < 256) { const int idx = ti * 256 + tid_now(); int src = 0;
            if (idx < cnt) src = (e < 64) ? rowtok[e * CAP + idx] : ffn_row(l, idx);
            rowsrc[tid_now()] = src; }
        __syncthreads();
        EpiGateUp E{(bf16*)(p.ws + WS_HB), tile * 256, nt};
        gemm_tile(lds, HL, WGU + ((size_t)e * 512 + nt * 256) * D, D, E);
    }
}
__device__ __forceinline__ void phase_i(PRef p, int l, char* lds) {
    moe_table(p, l, lds);
    const int* tb = (const int*)(lds + M_TBL); int* rowsrc = (int*)(lds + G_ROWSRC);
    const int ntiles = tb[65];
    const bf16* HB = (const bf16*)(p.ws + WS_HB); const bf16* WD = (const bf16*)(p.ws + WS_WD);
    for (int u = blockIdx.x; u < ntiles * 4; u += gridDim.x) {
        const int tile = u >> 2, pn = u & 3;
        const int e = moe_find(tb, tile);
        if (tid_now() < 256) rowsrc[tid_now()] = tile * 256 + tid_now();
        __syncthreads();
        EpiBf16 E{(bf16*)(p.ws + WS_Y), D, tile * 256, pn * 256};
        gemm_tile(lds, HB, WD + ((size_t)e * D + pn * 256) * DEXP, DEXP, E);
    }
}
__device__ __forceinline__ void phase_j(PRef p, int l, char* lds) {
    moe_table(p, l, lds);
    const int* tb = (const int*)(lds + M_TBL);
    const int tid = tid_now(), lane = tid & 63, wave = tid >> 6;
    const int ntok = (l == 0) ? R : BATCH * SEQ;
    const float* mods = (const float*)(p.ws + WS_MODS) + (size_t)l * 3 * 6144;
    const float* gpost = p.in[9] + l * D;
    const bf16* Y = (const bf16*)(p.ws + WS_Y);
    const int* pslot = (const int*)(p.ws + WS_PSLOT); const float* pw = (const float*)(p.ws + WS_PW);
    for (int idx = blockIdx.x * NWAVE + wave; idx < ntok; idx += gridDim.x * NWAVE) {
        const int row = ffn_row(l, idx);
        const int b = row_b(row), pos = row - b * POSB, rt = pos < CTX ? 2 : b;
        const float* md = mods + rt * 6144;
        float* xo = resid_row_out(p, row);
        f32x4 f[4];
        { const bf16* yr = Y + ((size_t)tb[64] * 256 + idx) * D;
#pragma unroll
          for (int j = 0; j < 4; ++j) { const u32x2 v = *(const u32x2*)(yr + 4 * lane + 256 * j); f[j] = (f32x4){bflo(v.x), bfhi(v.x), bflo(v.y), bfhi(v.y)}; } }
#pragma unroll
        for (int k = 0; k < 6; ++k) {
            const int ps = pslot[row * 8 + k]; const float w = pw[row * 8 + k];
            const int e = ps >> 16, rk = ps & 0xffff;
            const bf16* yr = Y + ((size_t)tb[e] * 256 + rk) * D;
#pragma unroll
            for (int j = 0; j < 4; ++j) { const u32x2 v = *(const u32x2*)(yr + 4 * lane + 256 * j);
                f[j].x += w * bflo(v.x); f[j].y += w * bfhi(v.x); f[j].z += w * bflo(v.y); f[j].w += w * bfhi(v.y); }
        }
        float ss = 0.f;
#pragma unroll
        for (int j = 0; j < 4; ++j) ss += f[j].x * f[j].x + f[j].y * f[j].y + f[j].z * f[j].z + f[j].w * f[j].w;
        const float rn = rsqrtf(wave_sum(ss) * (1.f / D) + EPS);
#pragma unroll
        for (int j = 0; j < 4; ++j) { const int k0 = 4 * lane + 256 * j;
            const f32x4 gp = *(const f32x4*)(gpost + k0), gt = *(const f32x4*)(md + 5 * D + k0);
            const f32x4 xv = *(const f32x4*)(xo + k0);
            *(f32x4*)(xo + k0) = xv + gt * (f[j] * rn * gp); }
    }
    if (l == 0) { __syncthreads(); convert_weights(p, 1, lds); }
}

__global__ void __launch_bounds__(NTHR, 2) mk_fwd(Params p_arg) {
    extern __shared__ __attribute__((aligned(16))) unsigned char lds_raw[];
    char* lds = (char*)lds_raw;
    volatile unsigned* misc = (volatile unsigned*)(lds + LDS_MISC);
    if (threadIdx.x < 64) misc[threadIdx.x] = 0u;
    __syncthreads();
    XcdBarrier bar; bar.bar = (unsigned*)(p_arg.ws + WS_CTL) + CW_BAR; bar.x = 0; bar.st = misc;
    const int ph_lo = p_arg.ph_lo, ph_hi = p_arg.ph_hi;
    if (ph_hi - ph_lo > 1) bar = xcd_barrier_post((unsigned*)(p_arg.ws + WS_CTL) + CW_BAR, misc);
    for (int ph = ph_lo; ph < ph_hi; ++ph) {
        const __attribute__((address_space(4))) Params* pk = (const __attribute__((address_space(4))) Params*)__builtin_amdgcn_kernarg_segment_ptr();
        asm volatile("" : "+s"(pk) :: "memory");
        PRef p = *pk;
#ifndef ONLY_PHASE
#define ONLY_PHASE -1
#endif
#define PH_ON(k) (ONLY_PHASE < 0 || ((ONLY_PHASE >> (k)) & 1))
        if (ph == 0) { if (PH_ON(0)) phase_p0(p, lds); }
        else {
            const int l = (ph - 1) / 10, s = (ph - 1) % 10;
            switch (s) {
                case 0: if (PH_ON(1)) phase_a(p, l, lds); break;
                case 1: if (PH_ON(2)) phase_b(p, l, lds); break;
                case 2: if (PH_ON(3)) phase_c(p, l, lds); break;
                case 3: if (PH_ON(4)) phase_d(p, l); break;
                case 4: if (PH_ON(5)) phase_e(p, l, lds); break;
                case 5: if (PH_ON(6)) phase_f(p, l, lds); break;
                case 6: if (PH_ON(7)) phase_g(p, l, lds); break;
                case 7: if (PH_ON(8)) phase_h(p, l, lds); break;
                case 8: if (PH_ON(9)) phase_i(p, l, lds); break;
                default: if (PH_ON(10)) phase_j(p, l, lds); break;
            }
        }
        if (ph + 1 < ph_hi) xcd_barrier(bar);
    }
}
}

extern "C" void kernel_launch(void* const* d_in, const int* in_sizes, int n_in, void* d_out, int out_size, void* d_ws, size_t ws_size, hipStream_t stream) {
    static int grid = 0;
    if (grid == 0) {
        if (n_in != 26 || ws_size < WS_END) { fprintf(stderr, "kernel_launch: unexpected n_in %d / ws_size %zu\n", n_in, ws_size); grid = -1; return; }
        int dev = 0, cus = 0, per_cu = 0;
        (void)hipGetDevice(&dev); (void)hipDeviceGetAttribute(&cus, hipDeviceAttributeMultiprocessorCount, dev);
        (void)hipFuncSetAttribute((const void*)mk_fwd, hipFuncAttributeMaxDynamicSharedMemorySize, LDS_BYTES);
        (void)hipOccupancyMaxActiveBlocksPerMultiprocessor(&per_cu, (const void*)mk_fwd, NTHR, LDS_BYTES);
        (void)hipGetLastError();
        if (per_cu < 1) fprintf(stderr, "kernel_launch: occupancy query says %d blocks per CU\n", per_cu);
        grid = cus;
    }
    if (grid < 0) return;
    (void)hipMemsetAsync((char*)d_ws + WS_CTL, 0, 1 * MiB, stream);
    Params p{};
    for (int i = 0; i < 26; ++i) p.in[i] = (const float*)d_in[i];
    p.out = (float*)d_out; p.ws = (unsigned char*)d_ws;
#if MK_LAUNCHES == 1
    p.ph_lo = 0; p.ph_hi = NPHASE;
    hipLaunchKernelGGL(mk_fwd, dim3(grid), dim3(NTHR), LDS_BYTES, stream, p);
#else
    for (int ph = 0; ph < NPHASE; ++ph) { p.ph_lo = ph; p.ph_hi = ph + 1; hipLaunchKernelGGL(mk_fwd, dim3(grid), dim3(NTHR), LDS_BYTES, stream, p); }
#endif
}
```

```cpp
#include <hip/hip_runtime.h>
#include <cstdio>
#include <cstdint>

#ifndef MK_LAUNCHES
#define MK_LAUNCHES 1
#endif

namespace {
typedef unsigned short bf16;
typedef short bf16x8 __attribute__((ext_vector_type(8)));
typedef float f32x4 __attribute__((ext_vector_type(4)));
typedef float f32x16 __attribute__((ext_vector_type(16)));
typedef unsigned u32x4 __attribute__((ext_vector_type(4)));
typedef unsigned u32x2 __attribute__((ext_vector_type(2)));
#define LAS __attribute__((address_space(3)))

constexpr int D = 1024, BATCH = 2, SEQ = 8192, CTX = 256, POSB = SEQ + CTX  , R = BATCH * POSB  ;
constexpr int NIN = 3088, NP = 3072;
constexpr int NEXP = 64, DEXP = 256, CAP = R;
constexpr int NCH = POSB / 128;
constexpr float EPS = 1e-6f;
constexpr int NTHR = 512, NWAVE = 8;
constexpr int NPHASE = 21;
constexpr int HB_ROWS = 134912;

constexpr size_t MiB = 1u << 20;
constexpr size_t WS_CTL = 0;
constexpr size_t WS_MODS = 1 * MiB;
constexpr size_t WS_TAB8 = WS_MODS + 192 * 1024;
constexpr size_t WS_TAB16 = WS_TAB8 + 8192;
constexpr size_t WS_SCAL = WS_TAB16 + 16384;
constexpr size_t WS_WRH = WS_MODS + 256 * 1024;
constexpr size_t WS_WRL = WS_MODS + 384 * 1024;
constexpr size_t WS_WLR = WS_MODS + 512 * 1024;
constexpr size_t WS_GWP = WS_MODS + 576 * 1024;
constexpr size_t WS_HCTX = 2 * MiB;
constexpr size_t WS_ROWTOK = 4 * MiB;
constexpr size_t WS_PSLOT = 9 * MiB;
constexpr size_t WS_PW = 10 * MiB;
constexpr size_t WS_DEC = 11 * MiB;
constexpr size_t WS_WIN = 12 * MiB;
constexpr size_t WS_WOUT = 18 * MiB;
constexpr size_t WS_WGU = 20 * MiB;
constexpr size_t WS_WD = 85 * MiB;
constexpr size_t WS_HL = 118 * MiB;
constexpr size_t WS_HB = 151 * MiB;
constexpr size_t WS_X = 217 * MiB;
constexpr size_t WS_P = WS_X;
constexpr size_t WS_VT = 316 * MiB;
constexpr size_t WS_US = 333 * MiB;
constexpr size_t WS_CAT = 366 * MiB;
constexpr size_t WS_MO = 399 * MiB;
constexpr size_t WS_LA = 465 * MiB;
constexpr size_t WS_Y = WS_X;
constexpr size_t WS_END = 482 * MiB;
static_assert(WS_Y + (size_t)HB_ROWS * 2048 <= WS_END, "Y fits");
static_assert(WS_HB + (size_t)HB_ROWS * 512 <= WS_X, "HB fits");

constexpr int CW_BAR = 4096;
constexpr int CW_CNT = 16384;

constexpr int LDS_BYTES = 147456;
constexpr int LDS_MISC = 147456 - 256;

struct Params { const float* in[26]; float* out; unsigned char* ws; int ph_lo, ph_hi; };
typedef const __attribute__((address_space(4))) Params& PRef;

__device__ __forceinline__ unsigned f2bf(float f) { unsigned u = __builtin_bit_cast(unsigned, f); return (u + 0x7fffu + ((u >> 16) & 1u)) >> 16; }
__device__ __forceinline__ unsigned pk2(float lo, float hi) { return f2bf(lo) | (f2bf(hi) << 16); }
__device__ __forceinline__ float bf2f(unsigned short b) { return __builtin_bit_cast(float, (unsigned)b << 16); }
__device__ __forceinline__ float bflo(unsigned u) { return __builtin_bit_cast(float, u << 16); }
__device__ __forceinline__ float bfhi(unsigned u) { return __builtin_bit_cast(float, u & 0xffff0000u); }
__device__ __forceinline__ float wave_sum(float v) {
#pragma unroll
    for (int o = 1; o < 64; o <<= 1) v += __shfl_xor(v, o);
    return v;
}
__device__ __forceinline__ float wave_max(float v) {
#pragma unroll
    for (int o = 1; o < 64; o <<= 1) v = fmaxf(v, __shfl_xor(v, o));
    return v;
}
__device__ __forceinline__ float silu_f(float x) { return x / (1.f + __expf(-x)); }
__device__ __forceinline__ float logsig_f(float x) { return fminf(x, 0.f) - log1pf(__expf(-fabsf(x))); }
#define LDS_FENCE() asm volatile("s_waitcnt lgkmcnt(0)" ::: "memory")
__device__ __forceinline__ int tid_now() { int t = threadIdx.x; asm volatile("" : "+v"(t)); return t; }

#define XB_TMO      128
#define XB_XCNT(j)  (256  + 64 * (j))
#define XB_XSUB(j)  (1280 + 64 * (j))
#define XB_XGEN(j)  (2304 + 64 * (j))
#define XB_TOP      3328
#define XB_TOPGEN   3392
#define XCD_BAR_WORDS 3456
#define XB_SPIN_CAP (1u << 20)
__device__ __forceinline__ unsigned xb_ld(unsigned* p)              { return __hip_atomic_load(p, __ATOMIC_RELAXED, __HIP_MEMORY_SCOPE_AGENT); }
__device__ __forceinline__ unsigned xb_add(unsigned* p, unsigned v) { return __hip_atomic_fetch_add(p, v, __ATOMIC_RELAXED, __HIP_MEMORY_SCOPE_AGENT); }
__device__ __forceinline__ unsigned xb_xcc_id() { return (unsigned)__builtin_amdgcn_s_getreg((3 << 11) | 20) & 0xFu; }
#define XB_SPIN(cond, bar) do { unsigned _sp = 0; while (cond) { __builtin_amdgcn_s_sleep(1); \
    if ((++_sp & 255u) == 0u) { if (xb_ld(&(bar)[XB_TMO])) break; if (_sp > XB_SPIN_CAP) { atomicAdd(&(bar)[XB_TMO], 1u); break; } } } } while (0)
struct XcdBarrier { unsigned* bar; unsigned x; volatile unsigned* st; };
__device__ __forceinline__ XcdBarrier xcd_barrier_post(unsigned* bar, volatile unsigned* st) {
    XcdBarrier b; b.bar = bar; b.x = xb_xcc_id(); b.st = st;
    if (threadIdx.x == 0) (void)xb_add(&bar[XB_XCNT(b.x)], 1u);
    return b;
}
__device__ __forceinline__ void xcd_barrier_complete(unsigned* bar, unsigned x, unsigned& nloc, unsigned& nx) {
    const unsigned G = gridDim.x;
    unsigned sum, cnt, mine, sp = 0u;
    for (;;) {
        sum = 0u; cnt = 0u; mine = 0u;
#pragma unroll
        for (unsigned j = 0; j < 16; ++j) { const unsigned c = xb_ld(&bar[XB_XCNT(j)]); sum += c; cnt += (c > 0u) ? 1u : 0u; mine = (j == x) ? c : mine; }
        if (sum == G) break;
        __builtin_amdgcn_s_sleep(1);
        if ((++sp & 255u) == 0u) { if (xb_ld(&bar[XB_TMO])) break; if (sp > XB_SPIN_CAP) { atomicAdd(&bar[XB_TMO], 1u); break; } }
    }
    nloc = mine > 0u ? mine : 1u; nx = cnt > 0u ? cnt : 1u;
}
__device__ __forceinline__ void xcd_barrier(const XcdBarrier& b) {
    asm volatile("s_waitcnt vmcnt(0)" ::: "memory");
    __syncthreads();
    if (threadIdx.x == 0) {
        unsigned* bar = b.bar;
        __builtin_amdgcn_s_waitcnt(0);
        unsigned nloc = b.st[0], nx = b.st[1];
        if (nloc == 0u) { xcd_barrier_complete(bar, b.x, nloc, nx); b.st[0] = nloc; b.st[1] = nx; }
        const unsigned old = xb_add(&bar[XB_XSUB(b.x)], 1u);
        const unsigned gen = old / nloc;
        if (old + 1u == (gen + 1u) * nloc) {
            __builtin_amdgcn_fence(__ATOMIC_RELEASE, "agent");
            asm volatile("s_waitcnt vmcnt(0)" ::: "memory");
            const unsigned og = xb_add(&bar[XB_TOP], 1u);
            const unsigned tg = og / nx;
            if (og + 1u == (tg + 1u) * nx) xb_add(&bar[XB_TOPGEN], 1u);
            else XB_SPIN(xb_ld(&bar[XB_TOPGEN]) == tg, bar);
            __builtin_amdgcn_fence(__ATOMIC_ACQUIRE, "agent");
            xb_add(&bar[XB_XGEN(b.x)], 1u);
            asm volatile("s_waitcnt vmcnt(0)" ::: "memory");
        } else {
            XB_SPIN(xb_ld(&bar[XB_XGEN(b.x)]) == gen, bar);
            __builtin_amdgcn_fence(__ATOMIC_ACQUIRE, "agent");
            asm volatile("s_waitcnt vmcnt(0)" ::: "memory");
        }
    }
    __syncthreads();
}

__device__ __forceinline__ int row_b(int row) { return row >= POSB ? 1 : 0; }

__device__ __forceinline__ void transpose_item(const float* __restrict__ W, int ldw, int k0, int n0src, bf16* WT, int ldt, int drow0, int dstep, float* scr, int lane) {
    const int kr = lane >> 3, c4 = lane & 7;
    f32x4 v[8];
#pragma unroll
    for (int i = 0; i < 8; ++i) v[i] = *(const f32x4*)(W + (size_t)(k0 + 8 * i + kr) * ldw + n0src + 4 * c4);
#pragma unroll
    for (int i = 0; i < 8; ++i) { float* d = scr + (8 * i + kr) * 33 + 4 * c4; d[0] = v[i].x; d[1] = v[i].y; d[2] = v[i].z; d[3] = v[i].w; }
    LDS_FENCE();
    const int c = lane & 7;
#pragma unroll
    for (int j = 0; j < 4; ++j) {
        const int n = (lane >> 3) + 8 * j; const float* s = scr + (8 * c) * 33 + n;
        u32x4 o; o.x = pk2(s[0 * 33], s[1 * 33]); o.y = pk2(s[2 * 33], s[3 * 33]); o.z = pk2(s[4 * 33], s[5 * 33]); o.w = pk2(s[6 * 33], s[7 * 33]);
        const int dr = drow0 + (n & 15) + (n >> 4) * dstep;
        *(u32x4*)(WT + (size_t)dr * ldt + k0 + 8 * c) = o;
    }
    LDS_FENCE();
}

constexpr int CV_IN = 16 * 96, CV_OUT = 16 * 32, CV_GU = 65 * 256, CV_D = 65 * 128, CV_TOTAL = CV_IN + CV_OUT + CV_GU + CV_D;

__device__ __forceinline__ void convert_weights(PRef p, int l, char* lds) {
    const int lane = tid_now() & 63, wave = tid_now() >> 6;
    float* scr = (float*)(lds + wave * 8704);
    const int gw = blockIdx.x * NWAVE + wave, NGW = gridDim.x * NWAVE;
    bf16* WIN = (bf16*)(p.ws + WS_WIN); bf16* WOUT = (bf16*)(p.ws + WS_WOUT); bf16* WGU = (bf16*)(p.ws + WS_WGU); bf16* WD = (bf16*)(p.ws + WS_WD);
    { bf16* WRH = (bf16*)(p.ws + WS_WRH); bf16* WRL = (bf16*)(p.ws + WS_WRL); const float* wrt = p.in[18] + (size_t)l * D * NEXP;
      for (int i = gw * 64 + lane; i < D * NEXP; i += NGW * 64) { const int k = i >> 6, e = i & 63; const float w = wrt[i]; const unsigned h = f2bf(w);
          WRH[e * D + k] = (bf16)h; WRL[e * D + k] = (bf16)f2bf(w - __builtin_bit_cast(float, h << 16)); } }
    { bf16* WLR = (bf16*)(p.ws + WS_WLR); bf16* GWP = (bf16*)(p.ws + WS_GWP);
      for (int i = gw * 64 + lane; i < 32 * D; i += NGW * 64) { const int n = i >> 10, k = i & 1023;
          WLR[i] = (bf16)(n < 16 ? f2bf(p.in[10][(size_t)l * D * NIN + (size_t)k * NIN + 1536 + n]) : 0u); }
      for (int i = gw * 64 + lane; i < 256 * 16; i += NGW * 64) { const int c = i >> 4, pos = i & 15, n = (pos & 3) | ((pos & 4) << 1) | ((pos & 8) >> 1);
          GWP[i] = (bf16)f2bf(p.in[13][l * 4096 + ((c >> 7) * 16 + n) * 128 + (c & 127)]); } }
    for (int it = gw; it < CV_TOTAL; it += NGW) {
        int r = it;
        if (r < CV_IN) { const int kb = r / 96, nb = r % 96, n0 = 32 * nb;
            transpose_item(p.in[10] + (size_t)l * D * NIN, NIN, 64 * kb, n0 + (n0 >= 1536 ? 16 : 0), WIN, D, n0, 16, scr, lane); continue; }
        r -= CV_IN;
        if (r < CV_OUT) { const int kb = r / 32, nb = r % 32;
            transpose_item(p.in[11] + (size_t)l * D * D, D, 64 * kb, 32 * nb, WOUT, D, 32 * nb, 16, scr, lane); continue; }
        r -= CV_OUT;
        if (r < CV_GU) { const int e = r >> 8, rem = r & 255, which = rem >> 7, it2 = rem & 127, kb = it2 >> 3, nb = it2 & 7, hc0 = 32 * nb;
            const float* src = (e < 64) ? (which ? p.in[21] : p.in[20]) + ((size_t)l * 64 + e) * D * DEXP : (which ? p.in[24] : p.in[23]) + (size_t)l * D * DEXP;
            const int drow0 = 256 * (hc0 >> 7) + 64 * ((hc0 >> 5) & 3) + 16 * which;
            transpose_item(src, DEXP, 64 * kb, hc0, WGU + (size_t)e * 512 * D, D, drow0, 32, scr, lane); continue; }
        r -= CV_GU;
        { const int e = r >> 7, it2 = r & 127, kb = it2 >> 5, nb = it2 & 31;
            const float* src = (e < 64) ? p.in[22] + ((size_t)l * 64 + e) * DEXP * D : p.in[25] + (size_t)l * DEXP * D;
            transpose_item(src, D, 64 * kb, 32 * nb, WD + (size_t)e * D * DEXP, DEXP, 32 * nb, 16, scr, lane); }
    }
}

__device__ __forceinline__ void sincos_exact(float ang, float& s, float& c) {
    const double x = (double)ang;
    const double k = rint(x * 0.15915494309189535);
    const double r = x - k * 6.283185307179586476925;
    const double r2 = r * r;
    double ts = r, ss = r, tc = 1.0, cs = 1.0;
#pragma unroll 1
    for (int n = 1; n <= 15; ++n) { ts *= -r2 / (double)((2 * n) * (2 * n + 1)); ss += ts; tc *= -r2 / (double)((2 * n - 1) * (2 * n)); cs += tc; }
    s = (float)ss; c = (float)cs;
}

__device__ __forceinline__ void phase_p0(PRef p, char* lds) {
    const int tid = tid_now();
    for (int item = blockIdx.x; item < 192; item += gridDim.x) {
        const int l = item / 96, n0 = (item % 96) * 64;
        float* cond = (float*)lds;
        float* red = (float*)(lds + 12288);
        for (int i = tid; i < 3 * D; i += NTHR) { const int r = i >> 10, k = i & 1023; const float v = (r < 2) ? p.in[1][r * D + k] : p.in[3][k]; cond[i] = silu_f(v); }
        __syncthreads();
        const int cg = tid & 15, ks = tid >> 4;
        const float* W = p.in[4] + (size_t)l * D * 6144 + n0 + 4 * cg;
        f32x4 a0 = {0, 0, 0, 0}, a1 = a0, a2 = a0;
#pragma unroll 8
        for (int kk = 0; kk < 32; ++kk) { const int k = ks * 32 + kk; const f32x4 w = *(const f32x4*)(W + (size_t)k * 6144);
            a0 += w * cond[k]; a1 += w * cond[D + k]; a2 += w * cond[2 * D + k]; }
#pragma unroll
        for (int i = 0; i < 4; ++i) { red[(ks * 3 + 0) * 64 + 4 * cg + i] = a0[i]; red[(ks * 3 + 1) * 64 + 4 * cg + i] = a1[i]; red[(ks * 3 + 2) * 64 + 4 * cg + i] = a2[i]; }
        __syncthreads();
        if (tid < 192) { const int r = tid >> 6, n = tid & 63; float s = 0.f;
            for (int q = 0; q < 32; ++q) s += red[(q * 3 + r) * 64 + n];
            ((float*)(p.ws + WS_MODS))[(l * 3 + r) * 6144 + n0 + n] = s + p.in[5][l * 6144 + n0 + n]; }
        __syncthreads();
    }
    if (blockIdx.x == gridDim.x - 1) {
        float* t8 = (float*)(p.ws + WS_TAB8); float* t16 = (float*)(p.ws + WS_TAB16);
        for (int i = tid; i < 128 * 8 + 128 * 16; i += NTHR) {
            int pos, fi, q; float* dst;
            if (i < 1024) { pos = i >> 3; fi = i & 7; q = 8; dst = t8 + 2 * i; } else { const int j = i - 1024; pos = j >> 4; fi = j & 15; q = 16; dst = t16 + 2 * j; }
            const float freq = (float)exp(-(double)fi / (double)q * 9.210340371976184);
            const float ang = (float)pos * freq; float s, c; sincos_exact(ang, s, c); dst[0] = c; dst[1] = s;
        }
        if (tid < 2) { const int l = tid; const float* lp = p.in[16] + l * 256; float s1 = 0.f, s2 = 0.f;
            for (int i = 0; i < 64; ++i) { s1 += lp[i] * lp[64 + i]; s2 += lp[128 + i] * lp[192 + i]; }
            const float lam_init = 0.8f - 0.6f * expf(-0.3f * (float)l);
            float* sc = (float*)(p.ws + WS_SCAL) + l * 16;
            sc[0] = expf(s1) - expf(s2) + lam_init; sc[1] = lam_init;
            for (int i = 0; i < 8; ++i) sc[2 + i] = logsig_f(p.in[12][l * 8 + i]); }
    }
    __syncthreads();
    convert_weights(p, 0, lds);
}

__device__ __forceinline__ const float* resid_row_ptr(PRef p, int l, int row) {
    const int b = row_b(row), pos = row - b * POSB;
    if (l == 0) return pos < CTX ? p.in[2] + ((size_t)b * CTX + pos) * D : p.in[0] + ((size_t)b * SEQ + pos - CTX) * D;
    return pos < CTX ? (const float*)(p.ws + WS_HCTX) + ((size_t)b * CTX + pos) * D : p.out + ((size_t)b * SEQ + pos - CTX) * D;
}
__device__ __forceinline__ float* resid_row_out(PRef p, int row) {
    const int b = row_b(row), pos = row - b * POSB;
    return pos < CTX ? (float*)(p.ws + WS_HCTX) + ((size_t)b * CTX + pos) * D : p.out + ((size_t)b * SEQ + pos - CTX) * D;
}

__device__ __forceinline__ void phase_a(PRef p, int l, char* lds, const bool st) {
    const int tid = tid_now(), lane = tid & 63, wave = tid >> 6;
    const float* mods = (const float*)(p.ws + WS_MODS) + (size_t)l * 3 * 6144;
    const float* gpre = p.in[6] + l * D;
    bf16* HL = (bf16*)(p.ws + WS_HL);
    for (int row = blockIdx.x * NWAVE + wave; row < R; row += gridDim.x * NWAVE) {
        const int b = row_b(row), pos = row - b * POSB, rt = pos < CTX ? 2 : b;
        const float* xr = resid_row_ptr(p, l, row);
        const float* sh = mods + rt * 6144; const float* sc = sh + D;
        f32x4 v[4]; float ss = 0.f;
#pragma unroll
        for (int j = 0; j < 4; ++j) { v[j] = *(const f32x4*)(xr + 4 * lane + 256 * j); ss += v[j].x * v[j].x + v[j].y * v[j].y + v[j].z * v[j].z + v[j].w * v[j].w; }
        const float rs = rsqrtf(wave_sum(ss) * (1.f / D) + EPS);
#pragma unroll
        for (int j = 0; j < 4; ++j) {
            const int k0 = 4 * lane + 256 * j;
            const f32x4 g = *(const f32x4*)(gpre + k0), s1 = *(const f32x4*)(sc + k0), s0 = *(const f32x4*)(sh + k0);
            const f32x4 h = v[j] * rs * g * (s1 + 1.f) + s0;
            u32x2 o; o.x = pk2(h.x, h.y); o.y = pk2(h.z, h.w);
            if (st) *(u32x2*)(HL + (size_t)row * D + k0) = o;
        }
    }
}

__device__ __forceinline__ float logsig_fast(float x) { return fminf(x, 0.f) - __logf(1.f + __expf(-fabsf(x))); }
__device__ __forceinline__ void lr_tasks(PRef p, int l, int first_blk) {
    if ((int)blockIdx.x < first_blk) return;
    const int tid = tid_now(), lane = tid & 63, wave = tid >> 6, li = lane & 31, hi = lane >> 5;
    const bf16* HL = (const bf16*)(p.ws + WS_HL); float* LA = (float*)(p.ws + WS_LA);
    const bf16* WLR = (const bf16*)(p.ws + WS_WLR); const bf16* GWP = (const bf16*)(p.ws + WS_GWP);
    const float* gb = p.in[14] + l * 256;
    const int nw = ((int)gridDim.x - first_blk) * NWAVE;
    for (int task = ((int)blockIdx.x - first_blk) * NWAVE + wave; task < R / 32; task += nw) {
        const int r0 = task * 32;
        const bf16* ap = WLR + (size_t)li * D + 8 * hi; const bf16* bp = HL + (size_t)(r0 + li) * D + 8 * hi;
        f32x16 lrT = {0};
#pragma unroll 8
        for (int s = 0; s < 64; ++s) lrT = __builtin_amdgcn_mfma_f32_32x32x16_bf16(*(const bf16x8*)(ap + 16 * s), *(const bf16x8*)(bp + 16 * s), lrT, 0, 0, 0);
        u32x4 w; w.x = pk2(lrT[0], lrT[1]); w.y = pk2(lrT[2], lrT[3]); w.z = pk2(lrT[4], lrT[5]); w.w = pk2(lrT[6], lrT[7]);
        const bf16x8 lrb = __builtin_bit_cast(bf16x8, w);
        float* orow = LA + (size_t)(r0 + li) * 256;
#pragma unroll 2
        for (int t = 0; t < 8; ++t) {
            const bf16x8 ga = *(const bf16x8*)(GWP + (size_t)(32 * t + li) * 16 + 8 * hi);
            f32x16 z = {0};
            z = __builtin_amdgcn_mfma_f32_32x32x16_bf16(ga, lrb, z, 0, 0, 0);
#pragma unroll
            for (int a = 0; a < 4; ++a) { const int c = 32 * t + 8 * a + 4 * hi;
                const f32x4 bb = *(const f32x4*)(gb + c);
                f32x4 la; la.x = logsig_fast(z[4 * a] + bb.x) * 0.0625f; la.y = logsig_fast(z[4 * a + 1] + bb.y) * 0.0625f;
                la.z = logsig_fast(z[4 * a + 2] + bb.z) * 0.0625f; la.w = logsig_fast(z[4 * a + 3] + bb.w) * 0.0625f;
                *(f32x4*)(orow + c) = la; }
        }
    }
}

constexpr int G_BUF = 65536, G_BS = 32768, G_ROWSRC = 131072;
template <class Epi>
__device__ __forceinline__ void gemm_tile(char* lds, const bf16* __restrict__ A, const bf16* __restrict__ Bt, int K, const Epi& epi) {
    const int tid = tid_now(), lane = tid & 63, wid = __builtin_amdgcn_readfirstlane(tid >> 6), wr = wid >> 2, wc = wid & 3, fr = lane & 15, fq = lane >> 4;
    const int* rowsrc = (const int*)(lds + G_ROWSRC);
    unsigned ao[4], bo[4];
#pragma unroll
    for (int i = 0; i < 4; ++i) { const int r = wid * 32 + i * 8 + (lane >> 3), c = (lane & 7) ^ (r & 7);
        ao[i] = (unsigned)rowsrc[r] * (unsigned)K + c * 8; bo[i] = (unsigned)r * (unsigned)K + c * 8; }
    LAS unsigned char* l3 = (LAS unsigned char*)lds;
#define G_STAGE(buf, kt) do { _Pragma("unroll") for (int _i = 0; _i < 4; ++_i) { \
        __builtin_amdgcn_global_load_lds((const unsigned*)(A + ao[_i] + (kt) * 64), (LAS unsigned*)(l3 + (buf) * G_BUF + wid * 4096 + _i * 1024), 16, 0, 0); \
        __builtin_amdgcn_global_load_lds((const unsigned*)(Bt + bo[_i] + (kt) * 64), (LAS unsigned*)(l3 + (buf) * G_BUF + G_BS + wid * 4096 + _i * 1024), 16, 0, 0); } } while (0)
    G_STAGE(0, 0);
    f32x4 acc[8][4];
#pragma unroll
    for (int m = 0; m < 8; ++m)
#pragma unroll
        for (int n = 0; n < 4; ++n) acc[m][n] = (f32x4){0.f, 0.f, 0.f, 0.f};
    const int nkt = K >> 6;
    const int sw = fr & 7;
#pragma unroll 1
    for (int kt = 0; kt < nkt; ++kt) {
        asm volatile("s_waitcnt vmcnt(0)" ::: "memory");
        __syncthreads();
        if (kt + 1 < nkt) { if (kt & 1) G_STAGE(0, kt + 1); else G_STAGE(1, kt + 1); }
        const char* As = lds + (kt & 1) * G_BUF; const char* Bs = As + G_BS;
#pragma unroll
        for (int ks = 0; ks < 2; ++ks) {
            const int ch = ((ks * 4 + fq) ^ sw) << 4;
            bf16x8 bfr[4];
#pragma unroll
            for (int n = 0; n < 4; ++n) bfr[n] = *(const bf16x8*)(Bs + (wc * 64 + n * 16 + fr) * 128 + ch);
#pragma unroll
            for (int m = 0; m < 8; ++m) {
                const bf16x8 af = *(const bf16x8*)(As + (wr * 128 + m * 16 + fr) * 128 + ch);
#pragma unroll
                for (int n = 0; n < 4; ++n) acc[m][n] = __builtin_amdgcn_mfma_f32_16x16x32_bf16(bfr[n], af, acc[m][n], 0, 0, 0);
            }
        }
    }
#undef G_STAGE
    epi(acc, wr, wc, fr, fq);
    __syncthreads();
}

struct EpiInProj {
    bf16* P; const float* tab8; const float* tab16; int row0, pn;
    __device__ __forceinline__ void operator()(f32x4 (&acc)[8][4], int wr, int wc, int fr, int fq) const {
        const int cg = pn * 4 + wc, cb = cg * 64;
        const bool lat = ((row0 >> 8) % 33) != 0;
        int kind = 0;
        float scale = 1.f;
        if (cg < 4) { kind = 1; if (cg >= 2) scale = 0.17677669529663687f; }
        else if (cg >= 8 && cg < 12) kind = 3;
        else if (cg == 12 || cg == 13) scale = 0.17677669529663687f;
        else if (cg >= 20 && cg < 24) kind = 3;
        else if (cg >= 24 && cg < 40) { kind = 2; if (cg < 32) scale = 0.18033688011112042f; }
#pragma unroll
        for (int m = 0; m < 8; ++m) {
            const int row = row0 + wr * 128 + m * 16 + fr;
            const int pos = row >= POSB ? row - POSB : row, t = pos - CTX, prow = (t >> 6) & 127, pcol = t & 63;
            f32x4 v[4];
#pragma unroll
            for (int n = 0; n < 4; ++n) v[n] = acc[m][n];
            if (kind == 1) {
                if (lat) {
#pragma unroll
                    for (int n = 0; n < 4; ++n) {
                        const int pp = (n & 1) ? pcol : prow;
                        const float* tb = tab8 + (pp * 8 + 4 * (fq & 1)) * 2;
                        const f32x4 t0 = *(const f32x4*)tb, t1 = *(const f32x4*)(tb + 4);
                        const float cs[4] = {t0.x, t0.z, t1.x, t1.z}, sn[4] = {t0.y, t0.w, t1.y, t1.w};
#pragma unroll
                        for (int i = 0; i < 4; ++i) { const float me = v[n][i], other = __shfl_xor(me, 32);
                            v[n][i] = (fq < 2) ? me * cs[i] - other * sn[i] : other * sn[i] + me * cs[i]; }
                    }
                }
            } else if (kind == 2) {
                if (lat) {
#pragma unroll
                    for (int hpart = 0; hpart < 2; ++hpart) {
                        const int pp = hpart ? pcol : prow;
                        const float* tb = tab16 + (pp * 16 + 4 * fq) * 2;
                        const f32x4 t0 = *(const f32x4*)tb, t1 = *(const f32x4*)(tb + 4);
                        const float cs[4] = {t0.x, t0.z, t1.x, t1.z}, sn[4] = {t0.y, t0.w, t1.y, t1.w};
#pragma unroll
                        for (int i = 0; i < 4; ++i) { const float a0 = v[2 * hpart][i], a1 = v[2 * hpart + 1][i];
                            v[2 * hpart][i] = a0 * cs[i] - a1 * sn[i]; v[2 * hpart + 1][i] = a0 * sn[i] + a1 * cs[i]; }
                    }
                }
            } else if (kind == 3) {
#pragma unroll
                for (int n = 0; n < 4; ++n)
#pragma unroll
                    for (int i = 0; i < 4; ++i) v[n][i] = silu_f(v[n][i]);
            }
#pragma unroll
            for (int n = 0; n < 4; ++n) { u32x2 o; o.x = pk2(v[n].x * scale, v[n].y * scale); o.y = pk2(v[n].z * scale, v[n].w * scale);
                *(u32x2*)(P + (size_t)row * NP + cb + n * 16 + 4 * fq) = o; }
        }
    }
};
struct EpiF32 {
    float* O; int ldo, row0, col0;
    __device__ __forceinline__ void operator()(f32x4 (&acc)[8][4], int wr, int wc, int fr, int fq) const {
#pragma unroll
        for (int m = 0; m < 8; ++m)
#pragma unroll
            for (int n = 0; n < 4; ++n) *(f32x4*)(O + (size_t)(row0 + wr * 128 + m * 16 + fr) * ldo + col0 + wc * 64 + n * 16 + 4 * fq) = acc[m][n];
    }
};
struct EpiBf16 {
    bf16* O; int ldo, row0, col0;
    __device__ __forceinline__ void operator()(f32x4 (&acc)[8][4], int wr, int wc, int fr, int fq) const {
#pragma unroll
        for (int m = 0; m < 8; ++m)
#pragma unroll
            for (int n = 0; n < 4; ++n) { u32x2 o; o.x = pk2(acc[m][n].x, acc[m][n].y); o.y = pk2(acc[m][n].z, acc[m][n].w);
                *(u32x2*)(O + (size_t)(row0 + wr * 128 + m * 16 + fr) * ldo + col0 + wc * 64 + n * 16 + 4 * fq) = o; }
    }
};
struct EpiGateUp {
    bf16* H; int row0, nt;
    __device__ __forceinline__ void operator()(f32x4 (&acc)[8][4], int wr, int wc, int fr, int fq) const {
#pragma unroll
        for (int m = 0; m < 8; ++m)
#pragma unroll
            for (int pp = 0; pp < 2; ++pp) { const f32x4 g = acc[m][2 * pp], u = acc[m][2 * pp + 1];
                u32x2 o; o.x = pk2(silu_f(g.x) * u.x, silu_f(g.y) * u.y); o.y = pk2(silu_f(g.z) * u.z, silu_f(g.w) * u.w);
                *(u32x2*)(H + (size_t)(row0 + wr * 128 + m * 16 + fr) * DEXP + 128 * nt + 32 * wc + 16 * pp + 4 * fq) = o; }
    }
};

__device__ __forceinline__ void phase_b(PRef p, int l, char* lds) {
    int* rowsrc = (int*)(lds + G_ROWSRC);
    const bf16* HL = (const bf16*)(p.ws + WS_HL); const bf16* WIN = (const bf16*)(p.ws + WS_WIN);
    for (int u = blockIdx.x; u < 66 * 12; u += gridDim.x) {
        const int pm = u / 12, pn = u % 12;
        if (tid_now() < 256) rowsrc[tid_now()] = pm * 256 + tid_now();
        __syncthreads();
        EpiInProj E{(bf16*)(p.ws + WS_P), (const float*)(p.ws + WS_TAB8), (const float*)(p.ws + WS_TAB16), pm * 256, pn};
        gemm_tile(lds, HL, WIN + (size_t)pn * 256 * D, D, E);
    }
    lr_tasks(p, l, (66 * 12) % (int)gridDim.x);
}

constexpr int L_BF = 0;
constexpr int L_BS = 16896;
constexpr int L_SEG = 33792;
constexpr int L_A = 36864;
constexpr int LO_QF = 36864;
constexpr int LO_KF = LO_QF + 10240;
constexpr int LO_QB = LO_KF + 10240;
constexpr int LO_KB = LO_QB + 10240;
constexpr int LO_QI = LO_KB + 10240;
constexpr int LO_ST = LO_QI + 18432;
constexpr int LO_VT = LO_ST + 9216;
constexpr int LO_W = 0;
constexpr int LO_SS = LO_VT + 17408;
static_assert(34816 <= L_A, "W overlay");
static_assert(LO_SS + 1024 <= LDS_MISC, "lin LDS");

struct LinCfg { int type; int qcol, kcol, vcol, gcol, ocol; };

__device__ __forceinline__ void lin_prefix(PRef p, int l, int type, int h, int r0, bool already, char* lds, const bool st = true) {
    const int tid = tid_now();
    float* bf = (float*)(lds + L_BF); float* bs = (float*)(lds + L_BS); float* seg = (float*)(lds + L_SEG);
    if (type == 0) {
        const float* sc = (const float*)(p.ws + WS_SCAL) + l * 16;
        const float lgf = sc[2 + h], lgb = sc[6 + h];
        for (int i = tid; i < 128 * 32; i += NTHR) { const int j = i >> 5, kk = i & 31; bf[j * 33 + kk] = (float)(j + 1) * lgf; bs[j * 33 + kk] = (float)(128 - j) * lgb; }
        __syncthreads();
        return;
    }
    float* LA = (float*)(p.ws + WS_LA);
    if (already) {
        for (int i = tid; i < 128 * 32; i += NTHR) { const int j = i >> 5, kk = i & 31; const float* s = LA + (size_t)(r0 + j) * 256 + h * 32 + kk; bf[j * 33 + kk] = s[0]; bs[j * 33 + kk] = s[128]; }
        __syncthreads();
        return;
    }
    for (int i = tid; i < 128 * 32; i += NTHR) { const int j = i >> 5, kk = i & 31; const float* s = LA + (size_t)(r0 + j) * 256 + h * 32 + kk; bf[j * 33 + kk] = s[0]; bs[j * 33 + kk] = s[128]; }
    __syncthreads();
    const int chain = tid & 63, sg = tid >> 6, dir = chain >> 5, kk = chain & 31;
    float* arr = dir ? bs : bf;
    float tot = 0.f;
    for (int q = 0; q < 16; ++q) tot += arr[(sg * 16 + q) * 33 + kk];
    seg[chain * 8 + sg] = tot;
    __syncthreads();
    float off = 0.f;
    if (dir == 0) { for (int q = 0; q < sg; ++q) off += seg[chain * 8 + q];
        for (int q = 0; q < 16; ++q) { const int j = sg * 16 + q; off += arr[j * 33 + kk]; arr[j * 33 + kk] = off; } }
    else { for (int q = 7; q > sg; --q) off += seg[chain * 8 + q];
        for (int q = 15; q >= 0; --q) { const int j = sg * 16 + q; off += arr[j * 33 + kk]; arr[j * 33 + kk] = off; } }
    __syncthreads();
    if (st) for (int i = tid; i < 128 * 32; i += NTHR) { const int j = i >> 5, k2 = i & 31; float* s = LA + (size_t)(r0 + j) * 256 + h * 32 + k2; s[0] = bf[j * 33 + k2]; s[128] = bs[j * 33 + k2]; }
}

__device__ __forceinline__ LinCfg lin_cfg(int type, int h) {
    LinCfg c; c.type = type;
    if (type == 0) { c.qcol = h * 32; c.kcol = 128 + h * 32; c.vcol = 256 + h * 64; c.gcol = 512 + h * 64; c.ocol = h * 64; }
    else { c.qcol = 768 + h * 32; c.kcol = 896 + h * 32; c.vcol = 1024 + h * 64; c.gcol = 1280 + h * 64; c.ocol = 256 + h * 64; }
    return c;
}
__device__ __forceinline__ size_t us_index(int b, int h, int type, int dir, int c) { return ((((size_t)(b * 4 + h) * 2 + type) * 2 + dir) * NCH + c) * 2048; }

__device__ __forceinline__ void lin_u_item(PRef p, int l, int item, char* lds, const bool st) {
    const int tid = tid_now();
    const int type = item & 1, h = (item >> 1) & 3, b = (item >> 3) & 1, c = item >> 4;
    const LinCfg cf = lin_cfg(type, h);
    const int r0 = b * POSB + c * 128;
    lin_prefix(p, l, type, h, r0, false, lds, st);
    const float* bf = (const float*)(lds + L_BF); const float* bs = (const float*)(lds + L_BS);
    float* kuf = (float*)(lds + L_A); float* kub = kuf + 128 * 33; float* vv = kub + 128 * 33;
    const bf16* P = (const bf16*)(p.ws + WS_P);
    { const int j = tid >> 2, c = tid & 3;
      const u32x4 kv4 = *(const u32x4*)(P + (size_t)(r0 + j) * NP + cf.kcol + 8 * c);
      const unsigned kw[4] = {kv4.x, kv4.y, kv4.z, kv4.w};
#pragma unroll
      for (int e = 0; e < 8; ++e) { const int kk = 8 * c + e; const float kv = (e & 1) ? bfhi(kw[e >> 1]) : bflo(kw[e >> 1]);
          kuf[j * 33 + kk] = kv * __expf(bf[127 * 33 + kk] - bf[j * 33 + kk]);
          kub[j * 33 + kk] = kv * __expf(bs[0 * 33 + kk] - bs[j * 33 + kk]); } }
#pragma unroll
    for (int i = 0; i < 2; ++i) { const int q = tid + 512 * i, j = q >> 3, c = q & 7;
        const u32x4 v4 = *(const u32x4*)(P + (size_t)(r0 + j) * NP + cf.vcol + 8 * c);
        *(f32x4*)(vv + j * 64 + 8 * c) = (f32x4){bflo(v4.x), bfhi(v4.x), bflo(v4.y), bfhi(v4.y)};
        *(f32x4*)(vv + j * 64 + 8 * c + 4) = (f32x4){bflo(v4.z), bfhi(v4.z), bflo(v4.w), bfhi(v4.w)}; }
    if (st && type == 1 && tid < 64) { const int dir = tid >> 5, kk = tid & 31;
        ((float*)(p.ws + WS_DEC))[(((size_t)(b * 4 + h) * 2 + dir) * NCH + c) * 32 + kk] = __expf(dir ? bs[kk] : bf[127 * 33 + kk]); }
    __syncthreads();
    const int dir = tid >> 8, kk = (tid >> 3) & 31, dvg = tid & 7;
    const float* ku = dir ? kub : kuf;
    float a[8];
#pragma unroll
    for (int i = 0; i < 8; ++i) a[i] = 0.f;
    for (int j = 0; j < 128; ++j) { const float kx = ku[j * 33 + kk]; const f32x4 v0 = *(const f32x4*)(vv + j * 64 + dvg * 8), v1 = *(const f32x4*)(vv + j * 64 + dvg * 8 + 4);
        a[0] += kx * v0.x; a[1] += kx * v0.y; a[2] += kx * v0.z; a[3] += kx * v0.w; a[4] += kx * v1.x; a[5] += kx * v1.y; a[6] += kx * v1.z; a[7] += kx * v1.w; }
    float* U = (float*)(p.ws + WS_US) + us_index(b, h, type, dir, c) + kk * 64 + dvg * 8;
    if (st) { *(f32x4*)U = (f32x4){a[0], a[1], a[2], a[3]}; *(f32x4*)(U + 4) = (f32x4){a[4], a[5], a[6], a[7]}; }
    __syncthreads();
}

__device__ __forceinline__ void vt_item(PRef p, int item, char* lds, const bool st) {
    const int tid = tid_now();
    const int g64 = item % 132, h = (item / 132) & 3, b = item / 528;
    const bf16* P = (const bf16*)(p.ws + WS_P); bf16* VT = (bf16*)(p.ws + WS_VT);
    bf16* t = (bf16*)lds;
#pragma unroll
    for (int i = 0; i < 2; ++i) { const int q = tid + 512 * i, j = q >> 4, ch = q & 15;
        const u32x4 v = *(const u32x4*)(P + (size_t)(b * POSB + g64 * 64 + j) * NP + 2560 + h * 128 + ch * 8);
        const int jp = (j & ~12) | ((j & 4) << 1) | ((j & 8) >> 1);
        const unsigned w[4] = {v.x, v.y, v.z, v.w};
#pragma unroll
        for (int e = 0; e < 4; ++e) { t[(ch * 8 + 2 * e) * 72 + jp] = (bf16)(w[e] & 0xffff); t[(ch * 8 + 2 * e + 1) * 72 + jp] = (bf16)(w[e] >> 16); } }
    __syncthreads();
#pragma unroll
    for (int i = 0; i < 2; ++i) { const int q = tid + 512 * i, dv = q >> 3, ch = q & 7;
        if (st) *(u32x4*)(VT + ((size_t)(b * 4 + h) * 128 + dv) * POSB + g64 * 64 + ch * 8) = *(const u32x4*)(t + dv * 72 + ch * 8); }
    __syncthreads();
}

__device__ __forceinline__ void phase_c(PRef p, int l, char* lds, const bool st) {
    constexpr int NU = NCH * 16, NV = 2 * 4 * 132;
    for (int it = blockIdx.x; it < NU + NV; it += gridDim.x) {
        if (it < NV) vt_item(p, it, lds, st); else lin_u_item(p, l, it - NV, lds, st);
    }
}

__device__ __forceinline__ void phase_d(PRef p, int l, const bool st) {
    const int gt = blockIdx.x * NTHR + tid_now();
    if (gt >= 32 * 2048) return;
    const int e = gt & 2047, chain = gt >> 11;
    const int dir = chain & 1, type = (chain >> 1) & 1, h = (chain >> 2) & 3, b = chain >> 4;
    float* U = (float*)(p.ws + WS_US) + (size_t)chain * NCH * 2048 + e;
    const float* DEC = (const float*)(p.ws + WS_DEC) + ((size_t)(b * 4 + h) * 2 + dir) * NCH * 32 + (e >> 6);
    const float* sc = (const float*)(p.ws + WS_SCAL) + l * 16;
    const float dret = __expf(128.f * sc[2 + dir * 4 + h]);
    float S = 0.f;
#pragma unroll 1
    for (int s0 = 0; s0 < NCH; s0 += 22) {
        float u[22], dd[22];
#pragma unroll
        for (int q = 0; q < 22; ++q) { const int s = s0 + q, c = dir == 0 ? s : (s < 2 ? 1 - s : 67 - s); u[q] = U[(size_t)c * 2048]; dd[q] = type ? DEC[c * 32] : dret; }
#pragma unroll
        for (int q = 0; q < 22; ++q) { const int s = s0 + q, c = dir == 0 ? s : (s < 2 ? 1 - s : 67 - s); if (st) U[(size_t)c * 2048] = S; S = dd[q] * S + u[q]; }
        if (!st && S == 12345.678f) U[0] = S;
    }
}

__device__ __forceinline__ void lin_out_item(PRef p, int l, int item, char* lds) {
    const int tid = tid_now(), lane = tid & 63, wid = tid >> 6;
    const int type = item & 1, h = (item >> 1) & 3, b = (item >> 3) & 1, c = item >> 4;
    const LinCfg cf = lin_cfg(type, h);
    const int r0 = b * POSB + c * 128;
    lin_prefix(p, l, type, h, r0, true, lds);
    const float* bf = (const float*)(lds + L_BF); const float* bs = (const float*)(lds + L_BS);
    bf16* qf = (bf16*)(lds + LO_QF); bf16* kf = (bf16*)(lds + LO_KF); bf16* qb = (bf16*)(lds + LO_QB); bf16* kb = (bf16*)(lds + LO_KB);
    bf16* qi = (bf16*)(lds + LO_QI); bf16* st = (bf16*)(lds + LO_ST); bf16* vt = (bf16*)(lds + LO_VT); bf16* W = (bf16*)(lds + LO_W);
    float* ssq = (float*)(lds + LO_SS);
    const bf16* P = (const bf16*)(p.ws + WS_P);
    { const int j = tid >> 2, c = tid & 3;
      const u32x4 q4 = *(const u32x4*)(P + (size_t)(r0 + j) * NP + cf.qcol + 8 * c), k4 = *(const u32x4*)(P + (size_t)(r0 + j) * NP + cf.kcol + 8 * c);
      const unsigned qw[4] = {q4.x, q4.y, q4.z, q4.w}, kw[4] = {k4.x, k4.y, k4.z, k4.w};
      unsigned oqf[4], okf[4], oqb[4], okb[4], oqi[4], oqj[4];
#pragma unroll
      for (int e2 = 0; e2 < 4; ++e2) {
          float vqf[2], vkf[2], vqb[2], vkb[2], vqi[2], vqj[2];
#pragma unroll
          for (int z = 0; z < 2; ++z) { const int kk = 8 * c + 2 * e2 + z;
              const float qv = z ? bfhi(qw[e2]) : bflo(qw[e2]), kv = z ? bfhi(kw[e2]) : bflo(kw[e2]);
              const float f = bf[j * 33 + kk], fm = bf[63 * 33 + kk], sx = bs[j * 33 + kk], sm = bs[64 * 33 + kk];
              vqf[z] = qv * __expf(f - fm); vkf[z] = kv * __expf(fm - f); vqb[z] = qv * __expf(sx - sm); vkb[z] = kv * __expf(sm - sx);
              vqi[z] = qv * __expf(f); vqj[z] = qv * __expf(sx); }
          oqf[e2] = pk2(vqf[0], vqf[1]); okf[e2] = pk2(vkf[0], vkf[1]); oqb[e2] = pk2(vqb[0], vqb[1]); okb[e2] = pk2(vkb[0], vkb[1]);
          oqi[e2] = pk2(vqi[0], vqi[1]); oqj[e2] = pk2(vqj[0], vqj[1]); }
      *(u32x4*)(qf + j * 40 + 8 * c) = (u32x4){oqf[0], oqf[1], oqf[2], oqf[3]}; *(u32x4*)(kf + j * 40 + 8 * c) = (u32x4){okf[0], okf[1], okf[2], okf[3]};
      *(u32x4*)(qb + j * 40 + 8 * c) = (u32x4){oqb[0], oqb[1], oqb[2], oqb[3]}; *(u32x4*)(kb + j * 40 + 8 * c) = (u32x4){okb[0], okb[1], okb[2], okb[3]};
      *(u32x4*)(qi + j * 72 + 8 * c) = (u32x4){oqi[0], oqi[1], oqi[2], oqi[3]}; *(u32x4*)(qi + j * 72 + 32 + 8 * c) = (u32x4){oqj[0], oqj[1], oqj[2], oqj[3]}; }
#pragma unroll
    for (int i = 0; i < 2; ++i) { const int q = tid + 512 * i, j = q >> 3, c = q & 7;
        const u32x4 v4 = *(const u32x4*)(P + (size_t)(r0 + j) * NP + cf.vcol + 8 * c);
        const unsigned vw[4] = {v4.x, v4.y, v4.z, v4.w};
#pragma unroll
        for (int e = 0; e < 4; ++e) { vt[(8 * c + 2 * e) * 136 + j] = (bf16)(vw[e] & 0xffff); vt[(8 * c + 2 * e + 1) * 136 + j] = (bf16)(vw[e] >> 16); } }
    { const float* Sf = (const float*)(p.ws + WS_US) + us_index(b, h, type, 0, c); const float* Sb = (const float*)(p.ws + WS_US) + us_index(b, h, type, 1, c);
      const f32x4 sf4 = *(const f32x4*)(Sf + 4 * tid), sb4 = *(const f32x4*)(Sb + 4 * tid);
      const int kk = (4 * tid) >> 6, dv = (4 * tid) & 63;
#pragma unroll
      for (int e = 0; e < 4; ++e) { st[(dv + e) * 72 + kk] = (bf16)f2bf(sf4[e]); st[(dv + e) * 72 + 32 + kk] = (bf16)f2bf(sb4[e]); } }
    __syncthreads();
    const int li = lane & 31, hi = lane >> 5;
    {
        const int bi = wid >> 1;
#pragma unroll
        for (int jj = 0; jj < 2; ++jj) {
            const int bj = (wid & 1) * 2 + jj;
            f32x16 af = {0}, ab = {0};
#pragma unroll
            for (int s = 0; s < 2; ++s) {
                const bf16x8 kfa = *(const bf16x8*)(kf + (bj * 32 + li) * 40 + 16 * s + 8 * hi), qfb = *(const bf16x8*)(qf + (bi * 32 + li) * 40 + 16 * s + 8 * hi);
                const bf16x8 kba = *(const bf16x8*)(kb + (bj * 32 + li) * 40 + 16 * s + 8 * hi), qbb = *(const bf16x8*)(qb + (bi * 32 + li) * 40 + 16 * s + 8 * hi);
                af = __builtin_amdgcn_mfma_f32_32x32x16_bf16(kfa, qfb, af, 0, 0, 0);
                ab = __builtin_amdgcn_mfma_f32_32x32x16_bf16(kba, qbb, ab, 0, 0, 0);
            }
            const int i = bi * 32 + li;
#pragma unroll
            for (int a = 0; a < 4; ++a) {
                float w[4];
#pragma unroll
                for (int q = 0; q < 4; ++q) { const int j = bj * 32 + 8 * a + 4 * hi + q; w[q] = (i >= j ? af[4 * a + q] : 0.f) + (j >= i ? ab[4 * a + q] : 0.f); }
                u32x2 o; o.x = pk2(w[0], w[1]); o.y = pk2(w[2], w[3]);
                *(u32x2*)(W + i * 136 + bj * 32 + 8 * a + 4 * hi) = o;
            }
        }
    }
    __syncthreads();
    const int bi = wid >> 1, bd = wid & 1;
    f32x16 o = {0};
#pragma unroll
    for (int s = 0; s < 8; ++s) {
        const bf16x8 va = *(const bf16x8*)(vt + (bd * 32 + li) * 136 + 16 * s + 8 * hi), wb = *(const bf16x8*)(W + (bi * 32 + li) * 136 + 16 * s + 8 * hi);
        o = __builtin_amdgcn_mfma_f32_32x32x16_bf16(va, wb, o, 0, 0, 0);
    }
#pragma unroll
    for (int s = 0; s < 4; ++s) {
        const bf16x8 sa = *(const bf16x8*)(st + (bd * 32 + li) * 72 + 16 * s + 8 * hi), qq = *(const bf16x8*)(qi + (bi * 32 + li) * 72 + 16 * s + 8 * hi);
        o = __builtin_amdgcn_mfma_f32_32x32x16_bf16(sa, qq, o, 0, 0, 0);
    }
    float ss = 0.f;
#pragma unroll
    for (int r = 0; r < 16; ++r) ss += o[r] * o[r];
    ss += __shfl_xor(ss, 32);
    const int tok = bi * 32 + li;
    if (hi == 0) ssq[tok * 2 + bd] = ss;
    __syncthreads();
    const bool need = (l == 0) || (c >= 2);
    if (need) {
        const float rn = rsqrtf((ssq[tok * 2] + ssq[tok * 2 + 1]) * (1.f / 64.f) + EPS);
        bf16* CAT = (bf16*)(p.ws + WS_CAT);
        const float* gg = p.in[15] + l * 64;
#pragma unroll
        for (int a = 0; a < 4; ++a) {
            const int dv = bd * 32 + 8 * a + 4 * hi;
            const u32x2 gt = *(const u32x2*)(P + (size_t)(r0 + tok) * NP + cf.gcol + dv);
            f32x4 g4 = {1.f, 1.f, 1.f, 1.f};
            if (type == 1) g4 = *(const f32x4*)(gg + dv);
            u32x2 ov; ov.x = pk2(o[4 * a] * rn * g4.x * bflo(gt.x), o[4 * a + 1] * rn * g4.y * bfhi(gt.x));
            ov.y = pk2(o[4 * a + 2] * rn * g4.z * bflo(gt.y), o[4 * a + 3] * rn * g4.w * bfhi(gt.y));
            *(u32x2*)(CAT + (size_t)(r0 + tok) * D + cf.ocol + dv) = ov;
        }
    }
    __syncthreads();
}

constexpr int AT_K0 = 0, AT_K1 = 8192, AT_V = 16384, AT_X = 32768;
__device__ __forceinline__ void attn_unit(PRef p, int l, int b, int h, int qpos0, int nkeys, char* lds) {
    const int tid = tid_now(), lane = tid & 63, wid = tid >> 6, m = wid >> 2, qr = (wid & 3) * 32, qi = lane & 31, hi = lane >> 5;
    const bf16* P = (const bf16*)(p.ws + WS_P); const bf16* VT = (const bf16*)(p.ws + WS_VT);
    const size_t rowb = (size_t)b * POSB;
    bf16x8 qf[4];
    { const bf16* qp = P + (rowb + qpos0 + qr + qi) * NP + 1536 + h * 128 + m * 64 + 8 * hi;
#pragma unroll
      for (int s = 0; s < 4; ++s) qf[s] = *(const bf16x8*)(qp + 16 * s); }
    const int kkey = tid >> 3, kc = tid & 7;
    const bf16* gk0 = P + (rowb + kkey) * NP + 2048 + h * 128 + kc * 8;
    const int sk = kkey * 128 + ((kc ^ (kkey & 7)) << 4);
    const bf16* gv[2]; int sv[2];
#pragma unroll
    for (int i = 0; i < 2; ++i) { const int q = tid + 512 * i, dv = q >> 3, c = q & 7; gv[i] = VT + ((size_t)(b * 4 + h) * 128 + dv) * POSB + c * 8; sv[i] = dv * 128 + ((c ^ (dv & 7)) << 4); }
    u32x4 rk0, rk1, rv0, rv1;
    rk0 = *(const u32x4*)gk0; rk1 = *(const u32x4*)(gk0 + 64); rv0 = *(const u32x4*)gv[0]; rv1 = *(const u32x4*)gv[1];
    f32x16 oacc[4];
#pragma unroll
    for (int t = 0; t < 4; ++t) oacc[t] = (f32x16){0};
    float mrun = -1e30f, lrun = 0.f;
    const int nt = nkeys >> 6;
    const char* Kl = lds + (m ? AT_K1 : AT_K0); const char* Vl = lds + AT_V;
    for (int kt = 0; kt < nt; ++kt) {
        __syncthreads();
        *(u32x4*)(lds + AT_K0 + sk) = rk0; *(u32x4*)(lds + AT_K1 + sk) = rk1; *(u32x4*)(lds + AT_V + sv[0]) = rv0; *(u32x4*)(lds + AT_V + sv[1]) = rv1;
        __syncthreads();
        if (kt + 1 < nt) { const size_t ko = (size_t)(kt + 1) * 64 * NP; rk0 = *(const u32x4*)(gk0 + ko); rk1 = *(const u32x4*)(gk0 + ko + 64);
            rv0 = *(const u32x4*)(gv[0] + (kt + 1) * 64); rv1 = *(const u32x4*)(gv[1] + (kt + 1) * 64); }
        f32x16 sT[2];
#pragma unroll
        for (int kb = 0; kb < 2; ++kb) {
            sT[kb] = (f32x16){0};
            const int krow = kb * 32 + qi;
#pragma unroll
            for (int s = 0; s < 4; ++s) {
                const bf16x8 ka = *(const bf16x8*)(Kl + krow * 128 + (((2 * s + hi) ^ (krow & 7)) << 4));
                sT[kb] = __builtin_amdgcn_mfma_f32_32x32x16_bf16(ka, qf[s], sT[kb], 0, 0, 0);
            }
        }
        float mx = sT[0][0];
#pragma unroll
        for (int r = 1; r < 16; ++r) mx = fmaxf(mx, sT[0][r]);
#pragma unroll
        for (int r = 0; r < 16; ++r) mx = fmaxf(mx, sT[1][r]);
        mx = fmaxf(mx, __shfl_xor(mx, 32));
        const float mnew = fmaxf(mrun, mx);
        const float alpha = __builtin_amdgcn_exp2f(mrun - mnew);
        mrun = mnew;
        float ls = 0.f;
#pragma unroll
        for (int kb = 0; kb < 2; ++kb)
#pragma unroll
            for (int r = 0; r < 16; ++r) { const float pv = __builtin_amdgcn_exp2f(sT[kb][r] - mnew); sT[kb][r] = pv; ls += pv; }
        lrun = lrun * alpha + ls;
        if (__any(alpha != 1.f)) {
#pragma unroll
            for (int t = 0; t < 4; ++t)
#pragma unroll
                for (int r = 0; r < 16; ++r) oacc[t][r] *= alpha;
        }
        bf16x8 pf[2][2];
#pragma unroll
        for (int kb = 0; kb < 2; ++kb)
#pragma unroll
            for (int ks = 0; ks < 2; ++ks) {
                u32x4 w; w.x = pk2(sT[kb][8 * ks + 0], sT[kb][8 * ks + 1]); w.y = pk2(sT[kb][8 * ks + 2], sT[kb][8 * ks + 3]);
                w.z = pk2(sT[kb][8 * ks + 4], sT[kb][8 * ks + 5]); w.w = pk2(sT[kb][8 * ks + 6], sT[kb][8 * ks + 7]);
                pf[kb][ks] = __builtin_bit_cast(bf16x8, w);
            }
#pragma unroll
        for (int t = 0; t < 4; ++t) {
            const int vrow = 32 * t + qi;
#pragma unroll
            for (int kb = 0; kb < 2; ++kb)
#pragma unroll
                for (int ks = 0; ks < 2; ++ks) {
                    const bf16x8 va = *(const bf16x8*)(Vl + vrow * 128 + (((4 * kb + 2 * ks + hi) ^ (vrow & 7)) << 4));
                    oacc[t] = __builtin_amdgcn_mfma_f32_32x32x16_bf16(va, pf[kb][ks], oacc[t], 0, 0, 0);
                }
        }
    }
    const float ltot = lrun + __shfl_xor(lrun, 32);
    const float inv = 1.f / ltot;
    __syncthreads();
    float* X = (float*)(lds + AT_X) + (wid & 3) * 4096;
    if (m == 1) {
#pragma unroll
        for (int t = 0; t < 4; ++t)
#pragma unroll
            for (int r = 0; r < 16; ++r) X[(t * 16 + r) * 64 + lane] = oacc[t][r] * inv;
    }
    __syncthreads();
    if (m == 0) {
        const float* sc = (const float*)(p.ws + WS_SCAL) + l * 16;
        const float lam = sc[0], post = 1.f - sc[1];
        float ss = 0.f;
#pragma unroll
        for (int t = 0; t < 4; ++t)
#pragma unroll
            for (int r = 0; r < 16; ++r) { const float v = oacc[t][r] * inv - lam * X[(t * 16 + r) * 64 + lane]; oacc[t][r] = v; ss += v * v; }
        ss += __shfl_xor(ss, 32);
        const float rn = rsqrtf(ss * (1.f / 128.f) + EPS) * post;
        bf16* CAT = (bf16*)(p.ws + WS_CAT) + (rowb + qpos0 + qr + qi) * D + 512 + h * 128;
        const float* dg = p.in[17] + l * 128;
#pragma unroll
        for (int t = 0; t < 4; ++t)
#pragma unroll
            for (int a = 0; a < 4; ++a) {
                const int dv = 32 * t + 8 * a + 4 * hi;
                const f32x4 g4 = *(const f32x4*)(dg + dv);
                u32x2 ov; ov.x = pk2(oacc[t][4 * a] * rn * g4.x, oacc[t][4 * a + 1] * rn * g4.y); ov.y = pk2(oacc[t][4 * a + 2] * rn * g4.z, oacc[t][4 * a + 3] * rn * g4.w);
                *(u32x2*)(CAT + dv) = ov;
            }
    }
    __syncthreads();
}

__device__ __forceinline__ void phase_e(PRef p, int l, char* lds) {
    const int n_att = 512 + (l == 0 ? 16 : 0);
    const int n_lin = NCH * 16;
    for (int it = blockIdx.x; it < n_att + n_lin; it += gridDim.x) {
        if (it < 512) { const int bh = it & 7, qb = it >> 3; attn_unit(p, l, bh >> 2, bh & 3, CTX + qb * 128, POSB, lds); }
        else if (it < n_att) { const int u = it - 512, bh = u & 7, qb = u >> 3; attn_unit(p, l, bh >> 2, bh & 3, qb * 128, CTX, lds); }
        else { const int item = it - n_att; if (l == 0 || (item >> 4) >= 2) lin_out_item(p, l, item, lds); }
    }
}

__device__ __forceinline__ void phase_f(PRef p, int l, char* lds) {
    int* rowsrc = (int*)(lds + G_ROWSRC);
    const bf16* CAT = (const bf16*)(p.ws + WS_CAT); const bf16* WOUT = (const bf16*)(p.ws + WS_WOUT);
    const int ntm = (l == 0) ? 66 : 64;
    for (int u = blockIdx.x; u < ntm * 4; u += gridDim.x) {
        int pm = u >> 2; const int pn = u & 3;
        if (l != 0) pm = pm + 1 + (pm >= 32 ? 1 : 0);
        if (tid_now() < 256) rowsrc[tid_now()] = pm * 256 + tid_now();
        __syncthreads();
        EpiF32 E{(float*)(p.ws + WS_MO), D, pm * 256, pn * 256};
        gemm_tile(lds, CAT, WOUT + (size_t)pn * 256 * D, D, E);
    }
}

__device__ __forceinline__ int ffn_row(int l, int idx) {
    if (l == 0) return idx;
    const int b = idx >> 13, t = idx & 8191; return b * POSB + CTX + t;
}
constexpr int GR_STRIDE = 2064, GR_HI = 0, GR_LO = 32 * GR_STRIDE, GR_LG = 64 * GR_STRIDE;
static_assert(GR_LG + 8192 <= LDS_MISC, "router LDS");
__device__ __forceinline__ void phase_g(PRef p, int l, char* lds, const bool st) {
    const int tid = tid_now(), lane = tid & 63, wave = __builtin_amdgcn_readfirstlane(tid >> 6);
    const int ntok = (l == 0) ? R : BATCH * SEQ;
    const float* mods = (const float*)(p.ws + WS_MODS) + (size_t)l * 3 * 6144;
    const float* gpost = p.in[7] + l * D; const float* gpre = p.in[8] + l * D;
    const float bias = p.in[19][l * NEXP + lane];
    const float* MO = (const float*)(p.ws + WS_MO); bf16* HL = (bf16*)(p.ws + WS_HL);
    const bf16* WRH = (const bf16*)(p.ws + WS_WRH); const bf16* WRL = (const bf16*)(p.ws + WS_WRL);
    float* LG = (float*)(lds + GR_LG);
    unsigned* cnt = (unsigned*)(p.ws + WS_CTL) + CW_CNT + l * 64;
    int* rowtok = (int*)(p.ws + WS_ROWTOK); int* pslot = (int*)(p.ws + WS_PSLOT); float* pw = (float*)(p.ws + WS_PW);
    for (int g0 = blockIdx.x * 32; g0 < ntok; g0 += gridDim.x * 32) {
#pragma unroll 1
        for (int rr = 0; rr < 4; ++rr) {
            const int lr = 4 * wave + rr;
            const int row = ffn_row(l, g0 + lr);
            const int b = row_b(row), pos = row - b * POSB, rt = pos < CTX ? 2 : b;
            const float* md = mods + rt * 6144;
            const float* xr = resid_row_ptr(p, l, row); float* xo = resid_row_out(p, row);
            const float* mr = MO + (size_t)row * D;
            f32x4 mv[4], xv[4]; float ss = 0.f;
#pragma unroll
            for (int j = 0; j < 4; ++j) { mv[j] = *(const f32x4*)(mr + 4 * lane + 256 * j); xv[j] = *(const f32x4*)(xr + 4 * lane + 256 * j);
                ss += mv[j].x * mv[j].x + mv[j].y * mv[j].y + mv[j].z * mv[j].z + mv[j].w * mv[j].w; }
            const float r1 = rsqrtf(wave_sum(ss) * (1.f / D) + EPS);
            float ss2 = 0.f;
#pragma unroll
            for (int j = 0; j < 4; ++j) { const int k0 = 4 * lane + 256 * j;
                const f32x4 gp = *(const f32x4*)(gpost + k0), gt = *(const f32x4*)(md + 2 * D + k0);
                xv[j] = xv[j] + gt * (mv[j] * r1 * gp);
                if (st) *(f32x4*)(xo + k0) = xv[j];
                ss2 += xv[j].x * xv[j].x + xv[j].y * xv[j].y + xv[j].z * xv[j].z + xv[j].w * xv[j].w; }
            const float r2 = rsqrtf(wave_sum(ss2) * (1.f / D) + EPS);
#pragma unroll
            for (int j = 0; j < 4; ++j) { const int k0 = 4 * lane + 256 * j;
                const f32x4 g = *(const f32x4*)(gpre + k0), s1 = *(const f32x4*)(md + 4 * D + k0), s0 = *(const f32x4*)(md + 3 * D + k0);
                const f32x4 hv = xv[j] * r2 * g * (s1 + 1.f) + s0;
                unsigned hb[4], lb[4];
#pragma unroll
                for (int i = 0; i < 4; ++i) { hb[i] = f2bf(hv[i]); lb[i] = f2bf(hv[i] - __builtin_bit_cast(float, hb[i] << 16)); }
                u32x2 oh; oh.x = hb[0] | (hb[1] << 16); oh.y = hb[2] | (hb[3] << 16);
                u32x2 ol; ol.x = lb[0] | (lb[1] << 16); ol.y = lb[2] | (lb[3] << 16);
                if (st) *(u32x2*)(HL + (size_t)row * D + k0) = oh;
                *(u32x2*)(lds + GR_HI + lr * GR_STRIDE + 2 * k0) = oh;
                *(u32x2*)(lds + GR_LO + lr * GR_STRIDE + 2 * k0) = ol; }
        }
        __syncthreads();
        {
            const int et = wave & 3, tt = wave >> 2, fr = lane & 15, fq = lane >> 4;
            const bf16* wh = WRH + (size_t)(et * 16 + fr) * D + 8 * fq; const bf16* wl = WRL + (size_t)(et * 16 + fr) * D + 8 * fq;
            const char* hh = lds + GR_HI + (tt * 16 + fr) * GR_STRIDE + 16 * fq; const char* hl2 = lds + GR_LO + (tt * 16 + fr) * GR_STRIDE + 16 * fq;
            f32x4 acc = {0.f, 0.f, 0.f, 0.f};
#pragma unroll 8
            for (int s = 0; s < 32; ++s) {
                const bf16x8 whi = *(const bf16x8*)(wh + 32 * s), wlo = *(const bf16x8*)(wl + 32 * s);
                const bf16x8 hhi = *(const bf16x8*)(hh + 64 * s), hlo = *(const bf16x8*)(hl2 + 64 * s);
                acc = __builtin_amdgcn_mfma_f32_16x16x32_bf16(whi, hhi, acc, 0, 0, 0);
                acc = __builtin_amdgcn_mfma_f32_16x16x32_bf16(whi, hlo, acc, 0, 0, 0);
                acc = __builtin_amdgcn_mfma_f32_16x16x32_bf16(wlo, hhi, acc, 0, 0, 0);
            }
            *(f32x4*)(LG + (tt * 16 + fr) * 64 + et * 16 + 4 * fq) = acc;
        }
        __syncthreads();
#pragma unroll 1
        for (int rr = 0; rr < 4; ++rr) {
            const int lr = 4 * wave + rr;
            const int row = ffn_row(l, g0 + lr);
            const float score = 1.f / (1.f + __expf(-LG[lr * 64 + lane]));
            const float sel = score + bias;
            const int grp = lane >> 3;
            float m1 = sel; m1 = fmaxf(m1, __shfl_xor(m1, 1)); m1 = fmaxf(m1, __shfl_xor(m1, 2)); m1 = fmaxf(m1, __shfl_xor(m1, 4));
            const unsigned long long bm = __ballot(sel == m1);
            const int first = __builtin_ctz((unsigned)((bm >> (8 * grp)) & 0xffull)) + 8 * grp;
            float m2 = (lane == first) ? -INFINITY : sel; m2 = fmaxf(m2, __shfl_xor(m2, 1)); m2 = fmaxf(m2, __shfl_xor(m2, 2)); m2 = fmaxf(m2, __shfl_xor(m2, 4));
            const float gs = m1 + m2;
            int rank = 0;
#pragma unroll
            for (int g2 = 0; g2 < 8; ++g2) { const float o = __shfl(gs, 8 * g2); rank += (o > gs || (o == gs && g2 < grp)) ? 1 : 0; }
            float mv = rank < 4 ? sel : -INFINITY;
            float wsum = 0.f; float myw = 0.f; int mye = 0;
#pragma unroll 1
            for (int k = 0; k < 6; ++k) {
                const float mx = wave_max(mv);
                const unsigned long long b2 = __ballot(mv == mx);
                const int e = __builtin_ctzll(b2);
                const float sce = __shfl(score, e);
                wsum += sce;
                if (lane == k) { myw = sce; mye = e; }
                if (lane == e) mv = -INFINITY;
            }
            if (st && lane < 6) {
                const unsigned rk = atomicAdd(cnt + mye, 1u);
                rowtok[mye * CAP + rk] = row;
                pslot[row * 8 + lane] = (mye << 16) | (int)rk;
                pw[row * 8 + lane] = myw / wsum * 2.5f;
            }
        }
    }
}

constexpr int M_TBL = 133120;
__device__ __forceinline__ void moe_table(PRef p, int l, char* lds) {
    int* tb = (int*)(lds + M_TBL);
    const unsigned* cnt = (const unsigned*)(p.ws + WS_CTL) + CW_CNT + l * 64;
    if (tid_now() == 0) {
        int acc = 0;
        for (int e = 0; e < 65; ++e) { const int c = e < 64 ? (int)__hip_atomic_load(cnt + e, __ATOMIC_RELAXED, __HIP_MEMORY_SCOPE_AGENT) : (l == 0 ? R : BATCH * SEQ);
            tb[e] = acc; tb[128 + e] = c; acc += (c + 255) >> 8; }
        tb[65] = acc;
    }
    __syncthreads();
}
__device__ __forceinline__ int moe_find(const int* tb, int tile) { int e = 0; while (e < 64 && tile >= tb[e + 1]) ++e; return e; }

__device__ __forceinline__ void phase_h(PRef p, int l, char* lds) {
    moe_table(p, l, lds);
    const int* tb = (const int*)(lds + M_TBL); int* rowsrc = (int*)(lds + G_ROWSRC);
    const int ntiles = tb[65];
    const bf16* HL = (const bf16*)(p.ws + WS_HL); const bf16* WGU = (const bf16*)(p.ws + WS_WGU);
    const int* rowtok = (const int*)(p.ws + WS_ROWTOK);
    for (int u = blockIdx.x; u < ntiles * 2; u += gridDim.x) {
        const int tile = u >> 1, nt = u & 1;
        const int e = moe_find(tb, tile), ti = tile - tb[e], cnt = tb[128 + e];
        if (tid_now() < 256) { const int idx = ti * 256 + tid_now(); int src = 0;
            if (idx < cnt) src = (e < 64) ? rowtok[e * CAP + idx] : ffn_row(l, idx);
            rowsrc[tid_now()] = src; }
        __syncthreads();
        EpiGateUp E{(bf16*)(p.ws + WS_HB), tile * 256, nt};
        gemm_tile(lds, HL, WGU + ((size_t)e * 512 + nt * 256) * D, D, E);
    }
}
__device__ __forceinline__ void phase_i(PRef p, int l, char* lds) {
    moe_table(p, l, lds);
    const int* tb = (const int*)(lds + M_TBL); int* rowsrc = (int*)(lds + G_ROWSRC);
    const int ntiles = tb[65];
    const bf16* HB = (const bf16*)(p.ws + WS_HB); const bf16* WD = (const bf16*)(p.ws + WS_WD);
    for (int u = blockIdx.x; u < ntiles * 4; u += gridDim.x) {
        const int tile = u >> 2, pn = u & 3;
        const int e = moe_find(tb, tile);
        if (tid_now() < 256) rowsrc[tid_now()] = tile * 256 + tid_now();
        __syncthreads();
        EpiBf16 E{(bf16*)(p.ws + WS_Y), D, tile * 256, pn * 256};
        gemm_tile(lds, HB, WD + ((size_t)e * D + pn * 256) * DEXP, DEXP, E);
    }
}
__device__ __forceinline__ void phase_j(PRef p, int l, char* lds, const bool st) {
    moe_table(p, l, lds);
    const int* tb = (const int*)(lds + M_TBL);
    const int tid = tid_now(), lane = tid & 63, wave = tid >> 6;
    const int ntok = (l == 0) ? R : BATCH * SEQ;
    const float* mods = (const float*)(p.ws + WS_MODS) + (size_t)l * 3 * 6144;
    const float* gpost = p.in[9] + l * D;
    const bf16* Y = (const bf16*)(p.ws + WS_Y);
    const int* pslot = (const int*)(p.ws + WS_PSLOT); const float* pw = (const float*)(p.ws + WS_PW);
    for (int idx = blockIdx.x * NWAVE + wave; idx < ntok; idx += gridDim.x * NWAVE) {
        const int row = ffn_row(l, idx);
        const int b = row_b(row), pos = row - b * POSB, rt = pos < CTX ? 2 : b;
        const float* md = mods + rt * 6144;
        float* xo = resid_row_out(p, row);
        f32x4 f[4];
        { const bf16* yr = Y + ((size_t)tb[64] * 256 + idx) * D;
#pragma unroll
          for (int j = 0; j < 4; ++j) { const u32x2 v = *(const u32x2*)(yr + 4 * lane + 256 * j); f[j] = (f32x4){bflo(v.x), bfhi(v.x), bflo(v.y), bfhi(v.y)}; } }
#pragma unroll
        for (int k = 0; k < 6; ++k) {
            const int ps = pslot[row * 8 + k]; const float w = pw[row * 8 + k];
            const int e = ps >> 16, rk = ps & 0xffff;
            const bf16* yr = Y + ((size_t)tb[e] * 256 + rk) * D;
#pragma unroll
            for (int j = 0; j < 4; ++j) { const u32x2 v = *(const u32x2*)(yr + 4 * lane + 256 * j);
                f[j].x += w * bflo(v.x); f[j].y += w * bfhi(v.x); f[j].z += w * bflo(v.y); f[j].w += w * bfhi(v.y); }
        }
        float ss = 0.f;
#pragma unroll
        for (int j = 0; j < 4; ++j) ss += f[j].x * f[j].x + f[j].y * f[j].y + f[j].z * f[j].z + f[j].w * f[j].w;
        const float rn = rsqrtf(wave_sum(ss) * (1.f / D) + EPS);
#pragma unroll
        for (int j = 0; j < 4; ++j) { const int k0 = 4 * lane + 256 * j;
            const f32x4 gp = *(const f32x4*)(gpost + k0), gt = *(const f32x4*)(md + 5 * D + k0);
            const f32x4 xv = *(const f32x4*)(xo + k0);
            f[j] = xv + gt * (f[j] * rn * gp);
            if (st) *(f32x4*)(xo + k0) = f[j]; }
        if (l == 0) {
            float s2 = 0.f;
#pragma unroll
            for (int j = 0; j < 4; ++j) s2 += f[j].x * f[j].x + f[j].y * f[j].y + f[j].z * f[j].z + f[j].w * f[j].w;
            const float rs = rsqrtf(wave_sum(s2) * (1.f / D) + EPS);
            const float* md1 = md + 3 * 6144; const float* gpre1 = p.in[6] + D;
            bf16* HL = (bf16*)(p.ws + WS_HL);
#pragma unroll
            for (int j = 0; j < 4; ++j) { const int k0 = 4 * lane + 256 * j;
                const f32x4 g = *(const f32x4*)(gpre1 + k0), s1 = *(const f32x4*)(md1 + D + k0), s0 = *(const f32x4*)(md1 + k0);
                const f32x4 h = f[j] * rs * g * (s1 + 1.f) + s0;
                u32x2 o; o.x = pk2(h.x, h.y); o.y = pk2(h.z, h.w);
                if (st) *(u32x2*)(HL + (size_t)row * D + k0) = o; }
        }
    }
    if (st && l == 0) { __syncthreads(); convert_weights(p, 1, lds); }
}

__global__ void __launch_bounds__(NTHR, 2) mk_fwd(Params p_arg) {
    extern __shared__ __attribute__((aligned(16))) unsigned char lds_raw[];
    char* lds = (char*)lds_raw;
    volatile unsigned* misc = (volatile unsigned*)(lds + LDS_MISC);
    if (threadIdx.x < 64) misc[threadIdx.x] = 0u;
    __syncthreads();
    XcdBarrier bar; bar.bar = (unsigned*)(p_arg.ws + WS_CTL) + CW_BAR; bar.x = 0; bar.st = misc;
    const int ph_lo = p_arg.ph_lo, ph_hi = p_arg.ph_hi;
    if (ph_hi - ph_lo > 1) bar = xcd_barrier_post((unsigned*)(p_arg.ws + WS_CTL) + CW_BAR, misc);
    for (int ph = ph_lo; ph < ph_hi; ++ph) {
        const __attribute__((address_space(4))) Params* pk = (const __attribute__((address_space(4))) Params*)__builtin_amdgcn_kernarg_segment_ptr();
        asm volatile("" : "+s"(pk) :: "memory");
        PRef p = *pk;
#ifndef ONLY_PHASE
#define ONLY_PHASE -1
#endif
#define PH_ON(k) (ONLY_PHASE < 0 || ((ONLY_PHASE >> (k)) & 1))
#ifndef DBL_MASK
#define DBL_MASK 0
#endif
        if (ph == 0) { if ((DBL_MASK >> 10) & 1) { phase_p0(p, lds); __syncthreads(); } if (PH_ON(0)) phase_p0(p, lds); }
        else {
            const int l = (ph - 1) / 10, s = (ph - 1) % 10;
            if (l == 1 && s == 0) continue;
            if ((DBL_MASK >> s) & 1) {
                const bool dry = p.ph_hi < 0;
                switch (s) {
                    case 0: phase_a(p, l, lds, dry); break;
                    case 2: phase_c(p, l, lds, dry); break;
                    case 3: phase_d(p, l, dry); break;
                    case 6: phase_g(p, l, lds, dry); break;
                    case 9: phase_j(p, l, lds, dry); break;
                    case 1: phase_b(p, l, lds); break;
                    case 4: phase_e(p, l, lds); break;
                    case 5: phase_f(p, l, lds); break;
                    case 7: phase_h(p, l, lds); break;
                    case 8: phase_i(p, l, lds); break;
                    default: break;
                }
                __syncthreads();
            }
            switch (s) {
                case 0: if (PH_ON(1)) phase_a(p, l, lds, true); break;
                case 1: if (PH_ON(2)) phase_b(p, l, lds); break;
                case 2: if (PH_ON(3)) phase_c(p, l, lds, true); break;
                case 3: if (PH_ON(4)) phase_d(p, l, true); break;
                case 4: if (PH_ON(5)) phase_e(p, l, lds); break;
                case 5: if (PH_ON(6)) phase_f(p, l, lds); break;
                case 6: if (PH_ON(7)) phase_g(p, l, lds, true); break;
                case 7: if (PH_ON(8)) phase_h(p, l, lds); break;
                case 8: if (PH_ON(9)) phase_i(p, l, lds); break;
                default: if (PH_ON(10)) phase_j(p, l, lds, true); break;
            }
        }
#ifndef XTRA_BAR
#define XTRA_BAR 0
#endif
        if (ph + 1 < ph_hi) { xcd_barrier(bar); for (int xb = 0; xb < XTRA_BAR; ++xb) xcd_barrier(bar); }
    }
}
}

extern "C" void kernel_launch(void* const* d_in, const int* in_sizes, int n_in, void* d_out, int out_size, void* d_ws, size_t ws_size, hipStream_t stream) {
    static int grid = 0;
    if (grid == 0) {
        if (n_in != 26 || ws_size < WS_END) { fprintf(stderr, "kernel_launch: unexpected n_in %d / ws_size %zu\n", n_in, ws_size); grid = -1; return; }
        int dev = 0, cus = 0, per_cu = 0;
        (void)hipGetDevice(&dev); (void)hipDeviceGetAttribute(&cus, hipDeviceAttributeMultiprocessorCount, dev);
        (void)hipFuncSetAttribute((const void*)mk_fwd, hipFuncAttributeMaxDynamicSharedMemorySize, LDS_BYTES);
        (void)hipOccupancyMaxActiveBlocksPerMultiprocessor(&per_cu, (const void*)mk_fwd, NTHR, LDS_BYTES);
        (void)hipGetLastError();
        if (per_cu < 1) fprintf(stderr, "kernel_launch: occupancy query says %d blocks per CU\n", per_cu);
        grid = cus;
    }
    if (grid < 0) return;
    (void)hipMemsetAsync((char*)d_ws + WS_CTL, 0, 1 * MiB, stream);
    Params p{};
    for (int i = 0; i < 26; ++i) p.in[i] = (const float*)d_in[i];
    p.out = (float*)d_out; p.ws = (unsigned char*)d_ws;
#if MK_LAUNCHES == 1
    p.ph_lo = 0; p.ph_hi = NPHASE;
    hipLaunchKernelGGL(mk_fwd, dim3(grid), dim3(NTHR), LDS_BYTES, stream, p);
#else
    for (int ph = 0; ph < NPHASE; ++ph) { p.ph_lo = ph; p.ph_hi = ph + 1; hipLaunchKernelGGL(mk_fwd, dim3(grid), dim3(NTHR), LDS_BYTES, stream, p); }
#endif
}
```

```cpp
#include <hip/hip_runtime.h>
#include <cstdio>
#include <cstdint>

#ifndef MK_LAUNCHES
#define MK_LAUNCHES 1
#endif

namespace {
typedef unsigned short bf16;
typedef short bf16x8 __attribute__((ext_vector_type(8)));
typedef float f32x4 __attribute__((ext_vector_type(4)));
typedef float f32x16 __attribute__((ext_vector_type(16)));
typedef unsigned u32x4 __attribute__((ext_vector_type(4)));
typedef unsigned u32x2 __attribute__((ext_vector_type(2)));
#define LAS __attribute__((address_space(3)))

constexpr int D = 1024, BATCH = 2, SEQ = 8192, CTX = 256, POSB = SEQ + CTX  , R = BATCH * POSB  ;
constexpr int NIN = 3088, NP = 3072;
constexpr int NEXP = 64, DEXP = 256, CAP = R;
constexpr int NCH = POSB / 128;
constexpr float EPS = 1e-6f;
constexpr int NTHR = 512, NWAVE = 8;
constexpr int NPHASE = 21;
constexpr int HB_ROWS = 134912;

constexpr size_t MiB = 1u << 20;
constexpr size_t WS_CTL = 0;
constexpr size_t WS_MODS = 1 * MiB;
constexpr size_t WS_TAB8 = WS_MODS + 192 * 1024;
constexpr size_t WS_TAB16 = WS_TAB8 + 8192;
constexpr size_t WS_SCAL = WS_TAB16 + 16384;
constexpr size_t WS_WRH = WS_MODS + 256 * 1024;
constexpr size_t WS_WRL = WS_MODS + 384 * 1024;
constexpr size_t WS_WLR = WS_MODS + 512 * 1024;
constexpr size_t WS_GWP = WS_MODS + 576 * 1024;
constexpr size_t WS_HCTX = 2 * MiB;
constexpr size_t WS_ROWTOK = 4 * MiB;
constexpr size_t WS_PSLOT = 9 * MiB;
constexpr size_t WS_PW = 10 * MiB;
constexpr size_t WS_DEC = 11 * MiB;
constexpr size_t WS_WIN = 12 * MiB;
constexpr size_t WS_WOUT = 18 * MiB;
constexpr size_t WS_WGU = 20 * MiB;
constexpr size_t WS_WD = 85 * MiB;
constexpr size_t WS_HL = 118 * MiB;
constexpr size_t WS_HB = 151 * MiB;
constexpr size_t WS_X = 217 * MiB;
constexpr size_t WS_P = WS_X;
constexpr size_t WS_VT = 316 * MiB;
constexpr size_t WS_US = 333 * MiB;
constexpr size_t WS_CAT = 366 * MiB;
constexpr size_t WS_MO = 399 * MiB;
constexpr size_t WS_LA = 465 * MiB;
constexpr size_t WS_Y = WS_X;
constexpr size_t WS_END = 482 * MiB;
static_assert(WS_Y + (size_t)HB_ROWS * 2048 <= WS_END, "Y fits");
static_assert(WS_HB + (size_t)HB_ROWS * 512 <= WS_X, "HB fits");

constexpr int CW_BAR = 4096;
constexpr int CW_CNT = 16384;
constexpr int CW_KMAX = 32768;

constexpr int LDS_BYTES = 147456;
constexpr int LDS_MISC = 147456 - 256;

struct Params { const float* in[26]; float* out; unsigned char* ws; int ph_lo, ph_hi; };
typedef const __attribute__((address_space(4))) Params& PRef;

__device__ __forceinline__ unsigned f2bf(float f) { unsigned u = __builtin_bit_cast(unsigned, f); return (u + 0x7fffu + ((u >> 16) & 1u)) >> 16; }
typedef float f32x2_t __attribute__((ext_vector_type(2)));
typedef __bf16 bf16x2_t __attribute__((ext_vector_type(2)));
__device__ __forceinline__ unsigned pk2(float lo, float hi) { f32x2_t v = {lo, hi}; bf16x2_t b = __builtin_convertvector(v, bf16x2_t); return __builtin_bit_cast(unsigned, b); }
__device__ __forceinline__ float bf2f(unsigned short b) { return __builtin_bit_cast(float, (unsigned)b << 16); }
__device__ __forceinline__ float bflo(unsigned u) { return __builtin_bit_cast(float, u << 16); }
__device__ __forceinline__ float bfhi(unsigned u) { return __builtin_bit_cast(float, u & 0xffff0000u); }
__device__ __forceinline__ float wave_sum(float v) {
#pragma unroll
    for (int o = 1; o < 64; o <<= 1) v += __shfl_xor(v, o);
    return v;
}
__device__ __forceinline__ float wave_max(float v) {
#pragma unroll
    for (int o = 1; o < 64; o <<= 1) v = fmaxf(v, __shfl_xor(v, o));
    return v;
}
__device__ __forceinline__ float silu_f(float x) { return x / (1.f + __expf(-x)); }
__device__ __forceinline__ float logsig_f(float x) { return fminf(x, 0.f) - log1pf(__expf(-fabsf(x))); }
#define LDS_FENCE() asm volatile("s_waitcnt lgkmcnt(0)" ::: "memory")
#ifndef PROBE_SUB
#define PROBE_SUB 0
#endif

__device__ __forceinline__ int tid_now() { int t = threadIdx.x; asm volatile("" : "+v"(t)); return t; }

#define XB_TMO      128
#define XB_XCNT(j)  (256  + 64 * (j))
#define XB_XSUB(j)  (1280 + 64 * (j))
#define XB_XGEN(j)  (2304 + 64 * (j))
#define XB_TOP      3328
#define XB_TOPGEN   3392
#define XCD_BAR_WORDS 3456
#define XB_SPIN_CAP (1u << 20)
__device__ __forceinline__ unsigned xb_ld(unsigned* p)              { return __hip_atomic_load(p, __ATOMIC_RELAXED, __HIP_MEMORY_SCOPE_AGENT); }
__device__ __forceinline__ unsigned xb_add(unsigned* p, unsigned v) { return __hip_atomic_fetch_add(p, v, __ATOMIC_RELAXED, __HIP_MEMORY_SCOPE_AGENT); }
__device__ __forceinline__ unsigned xb_xcc_id() { return (unsigned)__builtin_amdgcn_s_getreg((3 << 11) | 20) & 0xFu; }
#define XB_SPIN(cond, bar) do { unsigned _sp = 0; while (cond) { __builtin_amdgcn_s_sleep(1); \
    if ((++_sp & 255u) == 0u) { if (xb_ld(&(bar)[XB_TMO])) break; if (_sp > XB_SPIN_CAP) { atomicAdd(&(bar)[XB_TMO], 1u); break; } } } } while (0)
struct XcdBarrier { unsigned* bar; unsigned x; volatile unsigned* st; };
__device__ __forceinline__ XcdBarrier xcd_barrier_post(unsigned* bar, volatile unsigned* st) {
    XcdBarrier b; b.bar = bar; b.x = xb_xcc_id(); b.st = st;
    if (threadIdx.x == 0) (void)xb_add(&bar[XB_XCNT(b.x)], 1u);
    return b;
}
__device__ __forceinline__ void xcd_barrier_complete(unsigned* bar, unsigned x, unsigned& nloc, unsigned& nx) {
    const unsigned G = gridDim.x;
    unsigned sum, cnt, mine, sp = 0u;
    for (;;) {
        sum = 0u; cnt = 0u; mine = 0u;
#pragma unroll
        for (unsigned j = 0; j < 16; ++j) { const unsigned c = xb_ld(&bar[XB_XCNT(j)]); sum += c; cnt += (c > 0u) ? 1u : 0u; mine = (j == x) ? c : mine; }
        if (sum == G) break;
        __builtin_amdgcn_s_sleep(1);
        if ((++sp & 255u) == 0u) { if (xb_ld(&bar[XB_TMO])) break; if (sp > XB_SPIN_CAP) { atomicAdd(&bar[XB_TMO], 1u); break; } }
    }
    nloc = mine > 0u ? mine : 1u; nx = cnt > 0u ? cnt : 1u;
}
__device__ __forceinline__ void xcd_barrier(const XcdBarrier& b) {
    asm volatile("s_waitcnt vmcnt(0)" ::: "memory");
    __syncthreads();
    if (threadIdx.x == 0) {
        unsigned* bar = b.bar;
        __builtin_amdgcn_s_waitcnt(0);
        unsigned nloc = b.st[0], nx = b.st[1];
        if (nloc == 0u) { xcd_barrier_complete(bar, b.x, nloc, nx); b.st[0] = nloc; b.st[1] = nx; }
        const unsigned old = xb_add(&bar[XB_XSUB(b.x)], 1u);
        const unsigned gen = old / nloc;
        if (old + 1u == (gen + 1u) * nloc) {
            __builtin_amdgcn_fence(__ATOMIC_RELEASE, "agent");
            asm volatile("s_waitcnt vmcnt(0)" ::: "memory");
            const unsigned og = xb_add(&bar[XB_TOP], 1u);
            const unsigned tg = og / nx;
            if (og + 1u == (tg + 1u) * nx) xb_add(&bar[XB_TOPGEN], 1u);
            else XB_SPIN(xb_ld(&bar[XB_TOPGEN]) == tg, bar);
            __builtin_amdgcn_fence(__ATOMIC_ACQUIRE, "agent");
            xb_add(&bar[XB_XGEN(b.x)], 1u);
            asm volatile("s_waitcnt vmcnt(0)" ::: "memory");
        } else {
            XB_SPIN(xb_ld(&bar[XB_XGEN(b.x)]) == gen, bar);
            __builtin_amdgcn_fence(__ATOMIC_ACQUIRE, "agent");
            asm volatile("s_waitcnt vmcnt(0)" ::: "memory");
        }
    }
    __syncthreads();
}

__device__ __forceinline__ int row_b(int row) { return row >= POSB ? 1 : 0; }

struct CvItem { const float* src; bf16* dst; int ldw, ldt, k0, drow0, dstep; };
__device__ __forceinline__ void cv_load(const CvItem& d, f32x4 (&v)[8], int lane) {
    const int kr = lane >> 3, c4 = lane & 7;
#pragma unroll
    for (int i = 0; i < 8; ++i) v[i] = __builtin_nontemporal_load((const f32x4*)(d.src + (size_t)(d.k0 + 8 * i + kr) * d.ldw + 4 * c4));
}
__device__ __forceinline__ void cv_finish(const CvItem& d, const f32x4 (&v)[8], float* scr, int lane) {
    const int kr = lane >> 3, c4 = lane & 7;
#pragma unroll
    for (int i = 0; i < 8; ++i) { float* q = scr + (8 * i + kr) * 33 + 4 * c4; q[0] = v[i].x; q[1] = v[i].y; q[2] = v[i].z; q[3] = v[i].w; }
    LDS_FENCE();
    const int c = lane & 7;
#pragma unroll
    for (int j = 0; j < 4; ++j) {
        const int n = (lane >> 3) + 8 * j; const float* s = scr + (8 * c) * 33 + n;
        u32x4 o; o.x = pk2(s[0 * 33], s[1 * 33]); o.y = pk2(s[2 * 33], s[3 * 33]); o.z = pk2(s[4 * 33], s[5 * 33]); o.w = pk2(s[6 * 33], s[7 * 33]);
        const int dr = d.drow0 + (n & 15) + (n >> 4) * d.dstep;
        __builtin_nontemporal_store(o, (u32x4*)(d.dst + (size_t)dr * d.ldt + d.k0 + 8 * c));
    }
    LDS_FENCE();
}

constexpr int CV_IN = 16 * 96, CV_OUT = 16 * 32, CV_GU = 65 * 256, CV_D = 65 * 128, CV_TOTAL = CV_IN + CV_OUT + CV_GU + CV_D;

__device__ __forceinline__ CvItem cv_decode(PRef p, int l, int it) {
    bf16* WIN = (bf16*)(p.ws + WS_WIN); bf16* WOUT = (bf16*)(p.ws + WS_WOUT); bf16* WGU = (bf16*)(p.ws + WS_WGU); bf16* WD = (bf16*)(p.ws + WS_WD);
    CvItem d; int r = it;
    if (r < CV_IN) { const int kb = r / 96, nb = r % 96, n0 = 32 * nb;
        d.src = p.in[10] + (size_t)l * D * NIN + n0 + (n0 >= 1536 ? 16 : 0); d.ldw = NIN; d.k0 = 64 * kb; d.dst = WIN; d.ldt = D; d.drow0 = n0; d.dstep = 16; return d; }
    r -= CV_IN;
    if (r < CV_OUT) { const int kb = r / 32, nb = r % 32;
        d.src = p.in[11] + (size_t)l * D * D + 32 * nb; d.ldw = D; d.k0 = 64 * kb; d.dst = WOUT; d.ldt = D; d.drow0 = 32 * nb; d.dstep = 16; return d; }
    r -= CV_OUT;
    if (r < CV_GU) { const int e = r >> 8, rem = r & 255, which = rem >> 7, it2 = rem & 127, kb = it2 >> 3, nb = it2 & 7, hc0 = 32 * nb;
        d.src = ((e < 64) ? (which ? p.in[21] : p.in[20]) + ((size_t)l * 64 + e) * D * DEXP : (which ? p.in[24] : p.in[23]) + (size_t)l * D * DEXP) + hc0;
        d.ldw = DEXP; d.k0 = 64 * kb; d.dst = WGU + (size_t)e * 512 * D; d.ldt = D;
        d.drow0 = 256 * (hc0 >> 7) + 128 * ((hc0 >> 6) & 1) + 32 * ((hc0 >> 4) & 3) + 16 * which; d.dstep = 32; return d; }
    r -= CV_GU;
    { const int e = r >> 7, it2 = r & 127, kb = it2 >> 5, nb = it2 & 31;
        d.src = ((e < 64) ? p.in[22] + ((size_t)l * 64 + e) * DEXP * D : p.in[25] + (size_t)l * DEXP * D) + 32 * nb;
        d.ldw = D; d.k0 = 64 * kb; d.dst = WD + (size_t)e * D * DEXP; d.ldt = DEXP; d.drow0 = 32 * nb; d.dstep = 16; return d; }
}

__device__ __forceinline__ void convert_weights(PRef p, int l, char* lds) {
    const int lane = tid_now() & 63, wave = tid_now() >> 6;
    float* scr = (float*)(lds + wave * 8704);
    const int gw = blockIdx.x * NWAVE + wave, NGW = gridDim.x * NWAVE;
    { bf16* WRH = (bf16*)(p.ws + WS_WRH); bf16* WRL = (bf16*)(p.ws + WS_WRL); const float* wrt = p.in[18] + (size_t)l * D * NEXP;
      for (int i = gw * 64 + lane; i < D * NEXP; i += NGW * 64) { const int k = i >> 6, e = i & 63; const float w = wrt[i]; const unsigned h = f2bf(w);
          WRH[e * D + k] = (bf16)h; WRL[e * D + k] = (bf16)f2bf(w - __builtin_bit_cast(float, h << 16)); } }
    { bf16* WLR = (bf16*)(p.ws + WS_WLR); bf16* GWP = (bf16*)(p.ws + WS_GWP);
      for (int i = gw * 64 + lane; i < 32 * D; i += NGW * 64) { const int n = i >> 10, k = i & 1023;
          WLR[i] = (bf16)(n < 16 ? f2bf(p.in[10][(size_t)l * D * NIN + (size_t)k * NIN + 1536 + n]) : 0u); }
      for (int i = gw * 64 + lane; i < 256 * 16; i += NGW * 64) { const int c = i >> 4, pos = i & 15, n = (pos & 3) | ((pos & 4) << 1) | ((pos & 8) >> 1);
          GWP[i] = (bf16)f2bf(p.in[13][l * 4096 + ((c >> 7) * 16 + n) * 128 + (c & 127)]); } }
    f32x4 va[8], vb[8];
    int it = gw;
    if (it >= CV_TOTAL) return;
    CvItem da = cv_decode(p, l, it), db = da;
    cv_load(da, va, lane);
#pragma unroll 1
    for (;;) {
        const int it1 = it + NGW; const bool more1 = it1 < CV_TOTAL;
        if (more1) { db = cv_decode(p, l, it1); cv_load(db, vb, lane); }
        cv_finish(da, va, scr, lane);
        if (!more1) break;
        const int it2 = it1 + NGW; const bool more2 = it2 < CV_TOTAL;
        if (more2) { da = cv_decode(p, l, it2); cv_load(da, va, lane); }
        cv_finish(db, vb, scr, lane);
        if (!more2) break;
        it = it2;
    }
}

__device__ __forceinline__ void sincos_exact(float ang, float& s, float& c) {
    const double x = (double)ang;
    const double k = rint(x * 0.15915494309189535);
    const double r = x - k * 6.283185307179586476925;
    const double r2 = r * r;
    double ts = r, ss = r, tc = 1.0, cs = 1.0;
#pragma unroll 1
    for (int n = 1; n <= 15; ++n) { ts *= -r2 / (double)((2 * n) * (2 * n + 1)); ss += ts; tc *= -r2 / (double)((2 * n - 1) * (2 * n)); cs += tc; }
    s = (float)ss; c = (float)cs;
}

__device__ __forceinline__ void phase_p0(PRef p, char* lds) {
    const int tid = tid_now();
    {
        float* cond = (float*)lds;
        float* red = (float*)(lds + 12288);
        for (int i = tid; i < 3 * D; i += NTHR) { const int r = i >> 10, k = i & 1023; const float v = (r < 2) ? p.in[1][r * D + k] : p.in[3][k]; cond[i] = silu_f(v); }
        __syncthreads();
        for (int item = blockIdx.x; item < 384; item += gridDim.x) {
            const int l = item / 192, n0 = (item % 192) * 32;
            const int cg = tid & 7, ks = tid >> 3;
            const float* W = p.in[4] + (size_t)l * D * 6144 + n0 + 4 * cg + (size_t)(ks * 16) * 6144;
            f32x4 w[16];
#pragma unroll
            for (int kk = 0; kk < 16; ++kk) w[kk] = *(const f32x4*)(W + (size_t)kk * 6144);
            f32x4 a0 = {0, 0, 0, 0}, a1 = a0, a2 = a0;
#pragma unroll
            for (int kk = 0; kk < 16; ++kk) { const int k = ks * 16 + kk; a0 += w[kk] * cond[k]; a1 += w[kk] * cond[D + k]; a2 += w[kk] * cond[2 * D + k]; }
#pragma unroll
            for (int i = 0; i < 4; ++i) { red[(ks * 3 + 0) * 32 + 4 * cg + i] = a0[i]; red[(ks * 3 + 1) * 32 + 4 * cg + i] = a1[i]; red[(ks * 3 + 2) * 32 + 4 * cg + i] = a2[i]; }
            __syncthreads();
            if (tid < 96) { const int r = tid >> 5, n = tid & 31; float sm = 0.f;
                for (int q = 0; q < 64; ++q) sm += red[(q * 3 + r) * 32 + n];
                ((float*)(p.ws + WS_MODS))[(l * 3 + r) * 6144 + n0 + n] = sm + p.in[5][l * 6144 + n0 + n]; }
            __syncthreads();
        }
    }
    if (blockIdx.x == gridDim.x - 1) {
        float* t8 = (float*)(p.ws + WS_TAB8); float* t16 = (float*)(p.ws + WS_TAB16);
        for (int i = tid; i < 128 * 8 + 128 * 16; i += NTHR) {
            int pos, fi, q; float* dst;
            if (i < 1024) { pos = i >> 3; fi = i & 7; q = 8; dst = t8 + 2 * i; } else { const int j = i - 1024; pos = j >> 4; fi = j & 15; q = 16; dst = t16 + 2 * j; }
            const float freq = (float)exp(-(double)fi / (double)q * 9.210340371976184);
            const float ang = (float)pos * freq; float s, c; sincos_exact(ang, s, c); dst[0] = c; dst[1] = s;
        }
        if (tid < 2) { const int l = tid; const float* lp = p.in[16] + l * 256; float s1 = 0.f, s2 = 0.f;
            for (int i = 0; i < 64; ++i) { s1 += lp[i] * lp[64 + i]; s2 += lp[128 + i] * lp[192 + i]; }
            const float lam_init = 0.8f - 0.6f * expf(-0.3f * (float)l);
            float* sc = (float*)(p.ws + WS_SCAL) + l * 16;
            sc[0] = expf(s1) - expf(s2) + lam_init; sc[1] = lam_init;
            for (int i = 0; i < 8; ++i) sc[2 + i] = logsig_f(p.in[12][l * 8 + i]); }
    }
    __syncthreads();
    convert_weights(p, 0, lds);
}

__device__ __forceinline__ const float* resid_row_ptr(PRef p, int l, int row) {
    const int b = row_b(row), pos = row - b * POSB;
    if (l == 0) return pos < CTX ? p.in[2] + ((size_t)b * CTX + pos) * D : p.in[0] + ((size_t)b * SEQ + pos - CTX) * D;
    return pos < CTX ? (const float*)(p.ws + WS_HCTX) + ((size_t)b * CTX + pos) * D : p.out + ((size_t)b * SEQ + pos - CTX) * D;
}
__device__ __forceinline__ float* resid_row_out(PRef p, int row) {
    const int b = row_b(row), pos = row - b * POSB;
    return pos < CTX ? (float*)(p.ws + WS_HCTX) + ((size_t)b * CTX + pos) * D : p.out + ((size_t)b * SEQ + pos - CTX) * D;
}

__device__ __forceinline__ void phase_a(PRef p, int l, char* lds, const bool st) {
    const int tid = tid_now(), lane = tid & 63, wave = tid >> 6;
    const float* mods = (const float*)(p.ws + WS_MODS) + (size_t)l * 3 * 6144;
    const float* gpre = p.in[6] + l * D;
    bf16* HL = (bf16*)(p.ws + WS_HL);
    for (int row = blockIdx.x * NWAVE + wave; row < R; row += gridDim.x * NWAVE) {
        const int b = row_b(row), pos = row - b * POSB, rt = pos < CTX ? 2 : b;
        const float* xr = resid_row_ptr(p, l, row);
        const float* sh = mods + rt * 6144; const float* sc = sh + D;
        f32x4 v[4]; float ss = 0.f;
#pragma unroll
        for (int j = 0; j < 4; ++j) { v[j] = *(const f32x4*)(xr + 4 * lane + 256 * j); ss += v[j].x * v[j].x + v[j].y * v[j].y + v[j].z * v[j].z + v[j].w * v[j].w; }
        const float rs = rsqrtf(wave_sum(ss) * (1.f / D) + EPS);
#pragma unroll
        for (int j = 0; j < 4; ++j) {
            const int k0 = 4 * lane + 256 * j;
            const f32x4 g = *(const f32x4*)(gpre + k0), s1 = *(const f32x4*)(sc + k0), s0 = *(const f32x4*)(sh + k0);
            const f32x4 h = v[j] * rs * g * (s1 + 1.f) + s0;
            u32x2 o; o.x = pk2(h.x, h.y); o.y = pk2(h.z, h.w);
            if (st) *(u32x2*)(HL + (size_t)row * D + k0) = o;
        }
    }
}

__device__ __forceinline__ float logsig_fast(float x) { return fminf(x, 0.f) - __logf(1.f + __expf(-fabsf(x))); }
__device__ __forceinline__ void lr_tasks(PRef p, int l, int first_blk) {
    if ((int)blockIdx.x < first_blk) return;
    const int tid = tid_now(), lane = tid & 63, wave = tid >> 6, li = lane & 31, hi = lane >> 5;
    const bf16* HL = (const bf16*)(p.ws + WS_HL); float* LA = (float*)(p.ws + WS_LA);
    const bf16* WLR = (const bf16*)(p.ws + WS_WLR); const bf16* GWP = (const bf16*)(p.ws + WS_GWP);
    const float* gb = p.in[14] + l * 256;
    const int nw = ((int)gridDim.x - first_blk) * NWAVE;
    for (int task = ((int)blockIdx.x - first_blk) * NWAVE + wave; task < R / 32; task += nw) {
        const int r0 = task * 32;
        const bf16* ap = WLR + (size_t)li * D + 8 * hi; const bf16* bp = HL + (size_t)(r0 + li) * D + 8 * hi;
        f32x16 lrT = {0};
#pragma unroll 8
        for (int s = 0; s < 64; ++s) lrT = __builtin_amdgcn_mfma_f32_32x32x16_bf16(*(const bf16x8*)(ap + 16 * s), *(const bf16x8*)(bp + 16 * s), lrT, 0, 0, 0);
        u32x4 w; w.x = pk2(lrT[0], lrT[1]); w.y = pk2(lrT[2], lrT[3]); w.z = pk2(lrT[4], lrT[5]); w.w = pk2(lrT[6], lrT[7]);
        const bf16x8 lrb = __builtin_bit_cast(bf16x8, w);
        float* orow = LA + (size_t)(r0 + li) * 256;
#pragma unroll 2
        for (int t = 0; t < 8; ++t) {
            const bf16x8 ga = *(const bf16x8*)(GWP + (size_t)(32 * t + li) * 16 + 8 * hi);
            f32x16 z = {0};
            z = __builtin_amdgcn_mfma_f32_32x32x16_bf16(ga, lrb, z, 0, 0, 0);
#pragma unroll
            for (int a = 0; a < 4; ++a) { const int c = 32 * t + 8 * a + 4 * hi;
                const f32x4 bb = *(const f32x4*)(gb + c);
                f32x4 la; la.x = logsig_fast(z[4 * a] + bb.x) * 0.0625f; la.y = logsig_fast(z[4 * a + 1] + bb.y) * 0.0625f;
                la.z = logsig_fast(z[4 * a + 2] + bb.z) * 0.0625f; la.w = logsig_fast(z[4 * a + 3] + bb.w) * 0.0625f;
                *(f32x4*)(orow + c) = la; }
        }
    }
}

namespace pg8 {
constexpr int BM = 256, BK = 64, HALF = 128, HTB = HALF * BK * 2;
__device__ __forceinline__ int lds_byte(int r, int c) { const int st = (r >> 4) * 2 + (c >> 5), rr = r & 15, cc = c & 31, ob = rr * 64 + cc * 2; return st * 1024 + (ob ^ (((ob >> 9) & 1) << 5)); }
__device__ __forceinline__ void stage_rc(int b, int& R, int& C) { const int st = b / 1024, sb = b % 1024, swz = sb ^ (((sb >> 9) & 1) << 5); R = (st >> 1) * 16 + swz / 64; C = (st & 1) * 32 + (swz % 64) / 2; }
struct Unit { int pm, pn, e, ti; };
typedef f32x4 Acc[2][2][4][2];

template <class Epi, class Sched, bool GATHER>
__device__ __forceinline__ void gemm_phase(LAS unsigned char* lds, const bf16* A, const bf16* Bt, const int K, const Sched& S, const Epi& E) {
    const int tid = tid_now(), wid = __builtin_amdgcn_readfirstlane(tid >> 6), lane = tid & 63, wr = wid >> 2, wc = wid & 3, fr = lane & 15, fq = lane >> 4;
    const int nt = K / BK;
    unsigned voffB[2]; int Rst[2], Cst[2];
#pragma unroll
    for (int i = 0; i < 2; ++i) { int Rr, Cc; stage_rc(tid * 16 + i * 8192, Rr, Cc); Rst[i] = Rr; Cst[i] = Cc; voffB[i] = (unsigned)(Rr * K + Cc) * 2u; }
    const size_t kstep = (size_t)(BK * 2), hstep = (size_t)HALF * K * 2, tstep = 2 * hstep;
    const unsigned ldsw = (unsigned)wid * 1024u;
    const int aoff = lds_byte(wr * 64 + fr, fq * 8), boff = lds_byte(wc * 32 + fr, fq * 8);
#define PG8_SA(b, h) (((b) * 2 + (h)) * HTB)
#define PG8_SB(b, h) ((4 + (b) * 2 + (h)) * HTB)
#define PG8_STAGE(bufoff, gbase, voff) do { _Pragma("unroll") for (int _i = 0; _i < 2; ++_i) \
        __builtin_amdgcn_global_load_lds((const unsigned*)((const char*)(gbase) + (voff)[_i]), (LAS unsigned*)(lds + (bufoff) + ldsw + _i * 8192), 16, 0, 0); } while (0)
#define PG8_LDA(dst, b, h) do { _Pragma("unroll") for (int m = 0; m < 4; ++m) _Pragma("unroll") for (int k = 0; k < 2; ++k) dst[m][k] = *(const LAS bf16x8*)(lds + PG8_SA(b, h) + aoff + m * 2048 + k * 1024); } while (0)
#define PG8_LDB(dst, b, h) do { _Pragma("unroll") for (int n = 0; n < 2; ++n) _Pragma("unroll") for (int k = 0; k < 2; ++k) dst[n][k] = *(const LAS bf16x8*)(lds + PG8_SB(b, h) + boff + n * 2048 + k * 1024); } while (0)
#define PG8_MMA(ai, bj, At, Bt_) do { __builtin_amdgcn_s_setprio(1); _Pragma("unroll") for (int m = 0; m < 4; ++m) _Pragma("unroll") for (int n = 0; n < 2; ++n) _Pragma("unroll") for (int k = 0; k < 2; ++k) \
        acc[ai][bj][m][n] = __builtin_amdgcn_mfma_f32_16x16x32_bf16(Bt_[n][k], At[m][k], acc[ai][bj][m][n], 0, 0, 0); __builtin_amdgcn_s_setprio(0); } while (0)
#define PG8_WAIT_V(n) asm volatile("s_waitcnt vmcnt(" #n ")" ::: "memory")
#define PG8_WAIT_L(n) asm volatile("s_waitcnt lgkmcnt(" #n ")" ::: "memory")
#define PG8_BAR __builtin_amdgcn_s_barrier()
#define PG8_SCHED __builtin_amdgcn_sched_barrier(0)
#define PG8_VA(dst, u) do { _Pragma("unroll") for (int _h = 0; _h < 2; ++_h) _Pragma("unroll") for (int _i = 0; _i < 2; ++_i) \
        dst[_h][_i] = GATHER ? (unsigned)(S.src_row(u, _h * HALF + Rst[_i]) * K + Cst[_i]) * 2u : (unsigned)((_h * HALF + Rst[_i]) * K + Cst[_i]) * 2u; } while (0)
    Unit cur, nxt; int ui = 0;
    if (!S.next(0, cur)) return;
    Acc acc;
#pragma unroll
    for (int a = 0; a < 2; ++a)
#pragma unroll
        for (int b = 0; b < 2; ++b)
#pragma unroll
            for (int m = 0; m < 4; ++m)
#pragma unroll
                for (int n = 0; n < 2; ++n) acc[a][b][m][n] = (f32x4){0.f, 0.f, 0.f, 0.f};
    bf16x8 At[4][2], B0[2][2], B1[2][2];
    unsigned vAc[2][2], vAn[2][2];
    PG8_VA(vAc, cur);
    const char* cA = (const char*)A + (GATHER ? (size_t)0 : (size_t)cur.pm * tstep); const char* cB = (const char*)Bt + (size_t)cur.pn * tstep;
    PG8_STAGE(PG8_SB(0, 0), cB, voffB); PG8_STAGE(PG8_SB(0, 1), cB + hstep, voffB); PG8_STAGE(PG8_SA(0, 0), cA, vAc[0]); PG8_STAGE(PG8_SA(0, 1), cA, vAc[1]);
    if (wr == 1) PG8_BAR;
    PG8_WAIT_V(2); PG8_BAR;
    PG8_STAGE(PG8_SB(1, 0), cB + kstep, voffB); PG8_STAGE(PG8_SA(1, 0), cA + kstep, vAc[0]); PG8_STAGE(PG8_SB(1, 1), cB + hstep + kstep, voffB);
    PG8_WAIT_V(6); PG8_BAR;
    for (;;) {
        const bool has_next = S.next(ui + 1, nxt);
        const char* nA = has_next ? (const char*)A + (GATHER ? (size_t)0 : (size_t)nxt.pm * tstep) : cA; const char* nB = has_next ? (const char*)Bt + (size_t)nxt.pn * tstep : cB;
        if (GATHER) { if (has_next) PG8_VA(vAn, nxt); else { vAn[0][0] = vAc[0][0]; vAn[0][1] = vAc[0][1]; vAn[1][0] = vAc[1][0]; vAn[1][1] = vAc[1][1]; } }
#pragma unroll 1
        for (int t = 0; t < nt; t += 2) {
            const bool last = (t == nt - 2);
            const char* a1 = cA + (size_t)(t + 1) * kstep;
            const char* a2 = last ? nA : cA + (size_t)(t + 2) * kstep; const char* b2 = last ? nB : cB + (size_t)(t + 2) * kstep;
            const char* a3 = a2 + kstep; const char* b3 = b2 + kstep;
            PG8_LDB(B0, 0, 0); PG8_LDB(B1, 0, 1); PG8_SCHED; PG8_LDA(At, 0, 0); PG8_STAGE(PG8_SA(1, 1), a1, vAc[1]);
            if (GATHER && last) { vAc[0][0] = vAn[0][0]; vAc[0][1] = vAn[0][1]; vAc[1][0] = vAn[1][0]; vAc[1][1] = vAn[1][1]; }
            PG8_WAIT_V(8); PG8_WAIT_L(0); PG8_BAR; PG8_MMA(0, 0, At, B0); PG8_MMA(0, 1, At, B1); PG8_BAR; PG8_SCHED;
            PG8_LDA(At, 0, 1); PG8_STAGE(PG8_SB(0, 0), b2, voffB); PG8_STAGE(PG8_SB(0, 1), b2 + hstep, voffB); PG8_STAGE(PG8_SA(0, 0), a2, vAc[0]);
            PG8_WAIT_V(8); PG8_WAIT_L(0); PG8_BAR; PG8_MMA(1, 0, At, B0); PG8_MMA(1, 1, At, B1); PG8_BAR; PG8_SCHED;
            PG8_LDB(B0, 1, 0); PG8_LDB(B1, 1, 1); PG8_SCHED; PG8_LDA(At, 1, 0); PG8_STAGE(PG8_SA(0, 1), a2, vAc[1]);
            PG8_WAIT_V(8); PG8_WAIT_L(0); PG8_BAR; PG8_MMA(0, 0, At, B0); PG8_MMA(0, 1, At, B1); PG8_BAR; PG8_SCHED;
            PG8_LDA(At, 1, 1); PG8_STAGE(PG8_SB(1, 0), b3, voffB); PG8_STAGE(PG8_SB(1, 1), b3 + hstep, voffB); PG8_STAGE(PG8_SA(1, 0), a3, vAc[0]);
            PG8_WAIT_V(8); PG8_WAIT_L(0); PG8_BAR; PG8_MMA(1, 0, At, B0); PG8_MMA(1, 1, At, B1); PG8_BAR; PG8_SCHED;
        }
        if (wr == 0) PG8_BAR;
        { unsigned long long g_t0 = PROBE_SUB == 31 ? __builtin_amdgcn_s_memrealtime() : 0ull;
          E(acc, cur, wr, wc, fr, fq);
          if (PROBE_SUB == 31) { asm volatile("s_waitcnt vmcnt(0)" ::: "memory"); const unsigned long long _t = __builtin_amdgcn_s_memrealtime(); if (tid == 0) *(volatile unsigned long long*)((char*)lds + LDS_MISC + 128) += _t - g_t0; } }
        if (!has_next) break;
#pragma unroll
        for (int a = 0; a < 2; ++a)
#pragma unroll
            for (int b = 0; b < 2; ++b)
#pragma unroll
                for (int m = 0; m < 4; ++m)
#pragma unroll
                    for (int n = 0; n < 2; ++n) acc[a][b][m][n] = (f32x4){0.f, 0.f, 0.f, 0.f};
        cur = nxt; cA = nA; cB = nB; ++ui;
        if (wr == 1) PG8_BAR;
    }
    PG8_WAIT_V(0);
    PG8_BAR;
#undef PG8_SA
#undef PG8_SB
#undef PG8_STAGE
#undef PG8_LDA
#undef PG8_LDB
#undef PG8_MMA
#undef PG8_WAIT_V
#undef PG8_WAIT_L
#undef PG8_BAR
#undef PG8_SCHED
#undef PG8_VA
}
}

__device__ __forceinline__ u32x4 pair16(const u32x2 o0, const u32x2 o1, const int fq, int& coloff) {
    const bool odd = fq & 1;
    const u32x2 send = odd ? o0 : o1, keep = odd ? o1 : o0;
    u32x2 got; got.x = (unsigned)__shfl_xor((int)send.x, 16); got.y = (unsigned)__shfl_xor((int)send.y, 16);
    coloff = (odd ? 16 : 0) + 4 * (fq & 2);
    return odd ? (u32x4){got.x, got.y, keep.x, keep.y} : (u32x4){keep.x, keep.y, got.x, got.y};
}
struct EpiInProj {
    bf16* P; const float* tab8; const float* tab16;
    __device__ __forceinline__ void operator()(pg8::Acc& acc, const pg8::Unit& u, int wr, int wc, int fr, int fq) const {
        const int row0 = u.pm * 256;
        const bool lat = (u.pm % 33) != 0;
#pragma unroll
        for (int bj = 0; bj < 2; ++bj) {
            const int c32 = u.pn * 8 + bj * 4 + wc, cb = c32 * 32;
            int kind = 0;
            float scale = 1.f;
            if (c32 < 8) { kind = 1; if (c32 >= 4) scale = 0.17677669529663687f; }
            else if (c32 >= 16 && c32 < 24) kind = 3;
            else if (c32 >= 24 && c32 < 28) scale = 0.17677669529663687f;
            else if (c32 >= 40 && c32 < 48) kind = 3;
            else if (c32 >= 48 && c32 < 80) { kind = 2; if (c32 < 64) scale = 0.18033688011112042f; }
#pragma unroll
            for (int ai = 0; ai < 2; ++ai)
#pragma unroll
                for (int m = 0; m < 4; ++m) {
                    const int row = row0 + 128 * ai + 64 * wr + 16 * m + fr;
                    const int pos = row >= POSB ? row - POSB : row, t = pos - CTX, prow = (t >> 6) & 127, pcol = t & 63;
                    f32x4 v0 = acc[ai][bj][m][0], v1 = acc[ai][bj][m][1];
                    if (kind == 1) {
                        if (lat) {
#pragma unroll
                            for (int n = 0; n < 2; ++n) {
                                const int pp = n ? pcol : prow;
                                const float* tb = tab8 + (pp * 8 + 4 * (fq & 1)) * 2;
                                const f32x4 t0 = *(const f32x4*)tb, t1 = *(const f32x4*)(tb + 4);
                                const float cs[4] = {t0.x, t0.z, t1.x, t1.z}, sn[4] = {t0.y, t0.w, t1.y, t1.w};
                                f32x4& v = n ? v1 : v0;
#pragma unroll
                                for (int i = 0; i < 4; ++i) { const float me = v[i], other = __shfl_xor(me, 32);
                                    v[i] = (fq < 2) ? me * cs[i] - other * sn[i] : other * sn[i] + me * cs[i]; }
                            }
                        }
                    } else if (kind == 2) {
                        if (lat) {
                            const int pp = (c32 & 1) ? pcol : prow;
                            const float* tb = tab16 + (pp * 16 + 4 * fq) * 2;
                            const f32x4 t0 = *(const f32x4*)tb, t1 = *(const f32x4*)(tb + 4);
                            const float cs[4] = {t0.x, t0.z, t1.x, t1.z}, sn[4] = {t0.y, t0.w, t1.y, t1.w};
#pragma unroll
                            for (int i = 0; i < 4; ++i) { const float a0 = v0[i], a1 = v1[i]; v0[i] = a0 * cs[i] - a1 * sn[i]; v1[i] = a0 * sn[i] + a1 * cs[i]; }
                        }
                    } else if (kind == 3) {
#pragma unroll
                        for (int i = 0; i < 4; ++i) { v0[i] = silu_f(v0[i]); v1[i] = silu_f(v1[i]); }
                    }
                    u32x2 o0, o1; o0.x = pk2(v0.x * scale, v0.y * scale); o0.y = pk2(v0.z * scale, v0.w * scale); o1.x = pk2(v1.x * scale, v1.y * scale); o1.y = pk2(v1.z * scale, v1.w * scale);
                    int co; const u32x4 o16 = pair16(o0, o1, fq, co);
                    *(u32x4*)(P + (size_t)row * NP + cb + co) = o16;
                }
        }
    }
};
struct EpiF32 {
    float* O; int ldo;
    __device__ __forceinline__ void operator()(pg8::Acc& acc, const pg8::Unit& u, int wr, int wc, int fr, int fq) const {
#pragma unroll
        for (int ai = 0; ai < 2; ++ai)
#pragma unroll
            for (int m = 0; m < 4; ++m) { float* rp = O + (size_t)(u.pm * 256 + 128 * ai + 64 * wr + 16 * m + fr) * ldo + (u.pn & 3) * 256 + 32 * wc + 4 * fq;
#pragma unroll
                for (int bj = 0; bj < 2; ++bj)
#pragma unroll
                    for (int n = 0; n < 2; ++n) *(f32x4*)(rp + 128 * bj + 16 * n) = acc[ai][bj][m][n]; }
    }
};
struct EpiBf16 {
    bf16* O; int ldo;
    __device__ __forceinline__ void operator()(pg8::Acc& acc, const pg8::Unit& u, int wr, int wc, int fr, int fq) const {
#pragma unroll
        for (int ai = 0; ai < 2; ++ai)
#pragma unroll
            for (int m = 0; m < 4; ++m) { bf16* rp0 = O + (size_t)(u.pm * 256 + 128 * ai + 64 * wr + 16 * m + fr) * ldo + (u.pn & 3) * 256 + 32 * wc;
#pragma unroll
                for (int bj = 0; bj < 2; ++bj) { const f32x4 v0 = acc[ai][bj][m][0], v1 = acc[ai][bj][m][1];
                    u32x2 o0, o1; o0.x = pk2(v0.x, v0.y); o0.y = pk2(v0.z, v0.w); o1.x = pk2(v1.x, v1.y); o1.y = pk2(v1.z, v1.w);
                    int co; const u32x4 o16 = pair16(o0, o1, fq, co);
                    *(u32x4*)(rp0 + 128 * bj + co) = o16; } }
    }
};
struct EpiFp8 {
    unsigned char* O;
    __device__ __forceinline__ void operator()(pg8::Acc& acc, const pg8::Unit& u, int wr, int wc, int fr, int fq) const {
        const int lane = fr + 16 * fq;
#pragma unroll
        for (int ai = 0; ai < 2; ++ai)
#pragma unroll
            for (int m = 0; m < 4; ++m) {
                unsigned wd[4];
#pragma unroll
                for (int q = 0; q < 4; ++q) { f32x4 v = acc[ai][q >> 1][m][q & 1] * 32.f;
#pragma unroll
                    for (int i = 0; i < 4; ++i) v[i] = fminf(fmaxf(v[i], -440.f), 440.f);
                    int w = 0; w = __builtin_amdgcn_cvt_pk_fp8_f32(v.x, v.y, w, false); w = __builtin_amdgcn_cvt_pk_fp8_f32(v.z, v.w, w, true); wd[q] = (unsigned)w; }
                unsigned ow[4];
#pragma unroll
                for (int s_ = 0; s_ < 4; ++s_) {
                    const int give = (fq - s_) & 3;
                    const unsigned val = give == 0 ? wd[0] : give == 1 ? wd[1] : give == 2 ? wd[2] : wd[3];
                    const int src = (fq + s_) & 3;
                    const unsigned got = (unsigned)__shfl((int)val, fr + 16 * src);
                    if (src == 0) ow[0] = got; if (src == 1) ow[1] = got; if (src == 2) ow[2] = got; if (src == 3) ow[3] = got;
                }
                unsigned char* rp = O + (size_t)(u.pm * 256 + 128 * ai + 64 * wr + 16 * m + fr) * D + (u.pn & 3) * 256 + 32 * wc + 128 * (fq >> 1) + 16 * (fq & 1);
                *(u32x4*)rp = (u32x4){ow[0], ow[1], ow[2], ow[3]};
                (void)lane;
            }
    }
};
struct EpiGateUp {
    bf16* H;
    __device__ __forceinline__ void operator()(pg8::Acc& acc, const pg8::Unit& u, int wr, int wc, int fr, int fq) const {
#pragma unroll
        for (int ai = 0; ai < 2; ++ai)
#pragma unroll
            for (int m = 0; m < 4; ++m) { bf16* rp = H + (size_t)(u.pm * 256 + 128 * ai + 64 * wr + 16 * m + fr) * DEXP + 128 * (u.pn & 1) + 16 * wc;
                u32x2 o[2];
#pragma unroll
                for (int bj = 0; bj < 2; ++bj) { const f32x4 g = acc[ai][bj][m][0], uu = acc[ai][bj][m][1];
                    o[bj].x = pk2(silu_f(g.x) * uu.x, silu_f(g.y) * uu.y); o[bj].y = pk2(silu_f(g.z) * uu.z, silu_f(g.w) * uu.w); }
                int co; const u32x4 o16 = pair16(o[0], o[1], fq, co);
                *(u32x4*)(rp + (co & 8) + ((co & 16) ? 64 : 0)) = o16; }
    }
};

__device__ __forceinline__ int virt_block() { const int G = (int)gridDim.x, bx = (int)blockIdx.x; return (G % 8 == 0) ? (bx % 8) * (G / 8) + bx / 8 : bx; }
struct DenseSched {
    int nM, nN, nunits, skipctx;
    __device__ __forceinline__ bool next(int i, pg8::Unit& u) const {
        const int L = i * (int)gridDim.x + (int)blockIdx.x; if (L >= nunits) return false;
        int wgid = L; { const int q = nunits / 8, r = nunits % 8, xcd = wgid % 8, off = wgid / 8; wgid = (xcd < r ? xcd * (q + 1) : r * (q + 1) + (xcd - r) * q) + off; }
        const int nig = 8 * nN, gid = wgid / nig, fm = gid * 8, gsz = (nM - fm) < 8 ? (nM - fm) : 8;
        int pm = fm + ((wgid % nig) % gsz); u.pn = (wgid % nig) / gsz;
        if (skipctx) pm = pm + 1 + (pm >= 32 ? 1 : 0); u.pm = pm; u.e = 0; u.ti = 0; return true;
    }
    __device__ __forceinline__ int src_row(const pg8::Unit&, int) const { return 0; }
};
__device__ __forceinline__ void phase_b(PRef p, int l, char* lds) {
    DenseSched S{66, 12, 66 * 12, 0};
    EpiInProj E{(bf16*)(p.ws + WS_P), (const float*)(p.ws + WS_TAB8), (const float*)(p.ws + WS_TAB16)};
    pg8::gemm_phase<EpiInProj, DenseSched, false>((LAS unsigned char*)lds, (const bf16*)(p.ws + WS_HL), (const bf16*)(p.ws + WS_WIN), D, S, E);
    lr_tasks(p, l, (66 * 12) % (int)gridDim.x);
}

constexpr int L_BF = 0;
constexpr int L_BS = 16896;
constexpr int L_SEG = 33792;
constexpr int L_A = 36864;
constexpr int LO_QF = 36864;
constexpr int LO_KF = LO_QF + 10240;
constexpr int LO_QB = LO_KF + 10240;
constexpr int LO_KB = LO_QB + 10240;
constexpr int LO_QI = LO_KB + 10240;
constexpr int LO_ST = LO_QI + 18432;
constexpr int LO_VT = LO_ST + 9216;
constexpr int LO_W = 0;
constexpr int LO_SS = LO_VT + 17408;
static_assert(34816 <= L_A, "W overlay");
static_assert(LO_SS + 1024 <= LDS_MISC, "lin LDS");

#define GSTAMP(k) do { if (PROBE_SUB) { const unsigned long long _t = __builtin_amdgcn_s_memrealtime(); if (PROBE_SUB == (k) && tid_now() == 0) *(volatile unsigned long long*)(lds + LDS_MISC + 128) += _t - g_t0; g_t0 = _t; } } while (0)
struct LinCfg { int type; int qcol, kcol, vcol, gcol, ocol; };

__device__ __forceinline__ void lin_prefix(PRef p, int l, int type, int h, int r0, bool already, char* lds, const bool st = true) {
    const int tid = tid_now();
    float* bf = (float*)(lds + L_BF); float* bs = (float*)(lds + L_BS); float* seg = (float*)(lds + L_SEG);
    if (type == 0) {
        const float* sc = (const float*)(p.ws + WS_SCAL) + l * 16;
        const float lgf = sc[2 + h], lgb = sc[6 + h];
        for (int i = tid; i < 128 * 32; i += NTHR) { const int j = i >> 5, kk = i & 31; bf[j * 33 + kk] = (float)(j + 1) * lgf; bs[j * 33 + kk] = (float)(128 - j) * lgb; }
        __syncthreads();
        return;
    }
    float* LA = (float*)(p.ws + WS_LA);
    if (already) {
        for (int i = tid; i < 128 * 32; i += NTHR) { const int j = i >> 5, kk = i & 31; const float* s = LA + (size_t)(r0 + j) * 256 + h * 32 + kk; bf[j * 33 + kk] = s[0]; bs[j * 33 + kk] = s[128]; }
        __syncthreads();
        return;
    }
    for (int i = tid; i < 128 * 32; i += NTHR) { const int j = i >> 5, kk = i & 31; const float* s = LA + (size_t)(r0 + j) * 256 + h * 32 + kk; bf[j * 33 + kk] = s[0]; bs[j * 33 + kk] = s[128]; }
    __syncthreads();
    const int chain = tid & 63, sg = tid >> 6, dir = chain >> 5, kk = chain & 31;
    float* arr = dir ? bs : bf;
    float tot = 0.f;
    for (int q = 0; q < 16; ++q) tot += arr[(sg * 16 + q) * 33 + kk];
    seg[chain * 8 + sg] = tot;
    __syncthreads();
    float off = 0.f;
    if (dir == 0) { for (int q = 0; q < sg; ++q) off += seg[chain * 8 + q];
        for (int q = 0; q < 16; ++q) { const int j = sg * 16 + q; off += arr[j * 33 + kk]; arr[j * 33 + kk] = off; } }
    else { for (int q = 7; q > sg; --q) off += seg[chain * 8 + q];
        for (int q = 15; q >= 0; --q) { const int j = sg * 16 + q; off += arr[j * 33 + kk]; arr[j * 33 + kk] = off; } }
    __syncthreads();
    if (st) for (int i = tid; i < 128 * 32; i += NTHR) { const int j = i >> 5, k2 = i & 31; float* s = LA + (size_t)(r0 + j) * 256 + h * 32 + k2; s[0] = bf[j * 33 + k2]; s[128] = bs[j * 33 + k2]; }
}

__device__ __forceinline__ LinCfg lin_cfg(int type, int h) {
    LinCfg c; c.type = type;
    if (type == 0) { c.qcol = h * 32; c.kcol = 128 + h * 32; c.vcol = 256 + h * 64; c.gcol = 512 + h * 64; c.ocol = h * 64; }
    else { c.qcol = 768 + h * 32; c.kcol = 896 + h * 32; c.vcol = 1024 + h * 64; c.gcol = 1280 + h * 64; c.ocol = 256 + h * 64; }
    return c;
}
__device__ __forceinline__ size_t us_index(int b, int h, int type, int dir, int c) { return ((((size_t)(b * 4 + h) * 2 + type) * 2 + dir) * NCH + c) * 2048; }

__device__ __forceinline__ void lin_u_item(PRef p, int l, int item, char* lds, const bool st) {
    unsigned long long g_t0 = PROBE_SUB ? __builtin_amdgcn_s_memrealtime() : 0ull;
    const int tid = tid_now();
    const int c = item % NCH, rest = item / NCH, type = rest & 1, h = (rest >> 1) & 3, b = rest >> 3;
    const LinCfg cf = lin_cfg(type, h);
    const int r0 = b * POSB + c * 128;
    const bf16* P = (const bf16*)(p.ws + WS_P);
    const u32x4 kv4 = *(const u32x4*)(P + (size_t)(r0 + (tid >> 2)) * NP + cf.kcol + 8 * (tid & 3));
    u32x4 vpre[2];
#pragma unroll
    for (int i = 0; i < 2; ++i) { const int q = tid + 512 * i; vpre[i] = *(const u32x4*)(P + (size_t)(r0 + (q >> 3)) * NP + cf.vcol + 8 * (q & 7)); }
    lin_prefix(p, l, type, h, r0, false, lds, st);
    GSTAMP(12);
    const float* bf = (const float*)(lds + L_BF); const float* bs = (const float*)(lds + L_BS);
    bf16* kut = (bf16*)(lds + L_A);
    bf16* vt = kut + 2 * 32 * 136;
    { const int j = tid >> 2, c = tid & 3;
      const unsigned kw[4] = {kv4.x, kv4.y, kv4.z, kv4.w};
#pragma unroll
      for (int e = 0; e < 8; ++e) { const int kk = 8 * c + e; const float kv = (e & 1) ? bfhi(kw[e >> 1]) : bflo(kw[e >> 1]);
          kut[kk * 136 + j] = (bf16)f2bf(kv * __expf(bf[127 * 33 + kk] - bf[j * 33 + kk]));
          kut[(32 + kk) * 136 + j] = (bf16)f2bf(kv * __expf(bs[0 * 33 + kk] - bs[j * 33 + kk])); } }
#pragma unroll
    for (int i = 0; i < 2; ++i) { const int q = tid + 512 * i, j = q >> 3, c = q & 7;
        const unsigned vw[4] = {vpre[i].x, vpre[i].y, vpre[i].z, vpre[i].w};
#pragma unroll
        for (int e = 0; e < 4; ++e) { vt[(8 * c + 2 * e) * 136 + j] = (bf16)(vw[e] & 0xffff); vt[(8 * c + 2 * e + 1) * 136 + j] = (bf16)(vw[e] >> 16); } }
    if (st && type == 1 && tid < 64) { const int dir = tid >> 5, kk = tid & 31;
        ((float*)(p.ws + WS_DEC))[(((size_t)(b * 4 + h) * 2 + dir) * NCH + c) * 32 + kk] = __expf(dir ? bs[kk] : bf[127 * 33 + kk]); }
    __syncthreads();
    GSTAMP(13);
    { const int lane = tid & 63, wid = tid >> 6, li = lane & 31, hi = lane >> 5;
      if (wid < 4) {
          const int dir = wid >> 1, bd = wid & 1;
          f32x16 u = {0};
#pragma unroll
          for (int s = 0; s < 8; ++s) {
              const bf16x8 ka = *(const bf16x8*)(kut + (dir * 32 + li) * 136 + 16 * s + 8 * hi), vb = *(const bf16x8*)(vt + (bd * 32 + li) * 136 + 16 * s + 8 * hi);
              u = __builtin_amdgcn_mfma_f32_32x32x16_bf16(ka, vb, u, 0, 0, 0);
          }
          float* U = (float*)(p.ws + WS_US) + us_index(b, h, type, dir, c) + bd * 32 + li;
          if (st) {
#pragma unroll
              for (int r = 0; r < 16; ++r) U[((r & 3) + 8 * (r >> 2) + 4 * hi) * 64] = u[r]; }
      } }
    __syncthreads();
    GSTAMP(14);
}

__device__ __forceinline__ void vt_item(PRef p, int l, int item, char* lds, const bool st) {
    unsigned long long g_t0 = PROBE_SUB ? __builtin_amdgcn_s_memrealtime() : 0ull;
    const int tid = tid_now();
    const int g64 = item % 132, h = (item / 132) & 3, b = item / 528;
    const bf16* P = (const bf16*)(p.ws + WS_P); bf16* VT = (bf16*)(p.ws + WS_VT);
    bf16* t = (bf16*)lds;
#pragma unroll
    for (int i = 0; i < 2; ++i) { const int q = tid + 512 * i, j = q >> 4, ch = q & 15;
        const u32x4 v = *(const u32x4*)(P + (size_t)(b * POSB + g64 * 64 + j) * NP + 2560 + h * 128 + ch * 8);
        const int jp = (j & ~12) | ((j & 4) << 1) | ((j & 8) >> 1);
        const unsigned w[4] = {v.x, v.y, v.z, v.w};
#pragma unroll
        for (int e = 0; e < 4; ++e) { t[(ch * 8 + 2 * e) * 72 + jp] = (bf16)(w[e] & 0xffff); t[(ch * 8 + 2 * e + 1) * 72 + jp] = (bf16)(w[e] >> 16); } }
    { const int key = tid >> 3, part = tid & 7;
      const bf16* kr = P + (size_t)(b * POSB + g64 * 64 + key) * NP + 2048 + h * 128 + part * 8;
      const u32x4 k0 = *(const u32x4*)kr, k1 = *(const u32x4*)(kr + 64);
      const unsigned w0[4] = {k0.x, k0.y, k0.z, k0.w}, w1[4] = {k1.x, k1.y, k1.z, k1.w};
      float s0 = 0.f, s1 = 0.f;
#pragma unroll
      for (int e = 0; e < 4; ++e) { s0 += bflo(w0[e]) * bflo(w0[e]) + bfhi(w0[e]) * bfhi(w0[e]); s1 += bflo(w1[e]) * bflo(w1[e]) + bfhi(w1[e]) * bfhi(w1[e]); }
      s0 += __shfl_xor(s0, 1); s0 += __shfl_xor(s0, 2); s0 += __shfl_xor(s0, 4); s1 += __shfl_xor(s1, 1); s1 += __shfl_xor(s1, 2); s1 += __shfl_xor(s1, 4);
      s0 = wave_max(s0); s1 = wave_max(s1);
      float* kred = (float*)(lds + 32768);
      if ((tid & 63) == 0) { kred[(tid >> 6) * 2] = s0; kred[(tid >> 6) * 2 + 1] = s1; } }
    __syncthreads();
    if (st && tid < 2) { const float* kred = (const float*)(lds + 32768); float mxk = kred[tid];
        for (int w = 1; w < 8; ++w) mxk = fmaxf(mxk, kred[2 * w + tid]);
        atomicMax((unsigned*)(p.ws + WS_CTL) + CW_KMAX + (((l * 2 + b) * 4 + h) * 2 + tid) * 64, __builtin_bit_cast(unsigned, mxk)); }
#pragma unroll
    for (int i = 0; i < 2; ++i) { const int q = tid + 512 * i, dv = q >> 3, ch = q & 7;
        if (st) *(u32x4*)(VT + ((size_t)(b * 4 + h) * 128 + dv) * POSB + g64 * 64 + ch * 8) = *(const u32x4*)(t + dv * 72 + ch * 8); }
    __syncthreads();
    GSTAMP(11);
}

__device__ __forceinline__ void phase_c(PRef p, int l, char* lds, const bool st) {
    constexpr int NU = NCH * 16, NV = 2 * 4 * 132;
    for (int it = blockIdx.x; it < NU + NV; it += gridDim.x) {
        if (it < NV) vt_item(p, l, it, lds, st); else lin_u_item(p, l, it - NV, lds, st);
    }
}

__device__ __forceinline__ void phase_d(PRef p, int l, const bool st) {
    const int gt = blockIdx.x * NTHR + tid_now();
    if (gt >= 32 * 2048) return;
    const int e = gt & 2047, chain = gt >> 11;
    const int dir = chain & 1, type = (chain >> 1) & 1, h = (chain >> 2) & 3, b = chain >> 4;
    float* U = (float*)(p.ws + WS_US) + (size_t)chain * NCH * 2048 + e;
    const float* DEC = (const float*)(p.ws + WS_DEC) + ((size_t)(b * 4 + h) * 2 + dir) * NCH * 32 + (e >> 6);
    const float* sc = (const float*)(p.ws + WS_SCAL) + l * 16;
    const float dret = __expf(128.f * sc[2 + dir * 4 + h]);
    float S = 0.f;
#pragma unroll 1
    for (int s0 = 0; s0 < NCH; s0 += 22) {
        float u[22], dd[22];
#pragma unroll
        for (int q = 0; q < 22; ++q) { const int s = s0 + q, c = dir == 0 ? s : (s < 2 ? 1 - s : 67 - s); u[q] = U[(size_t)c * 2048]; dd[q] = type ? DEC[c * 32] : dret; }
#pragma unroll
        for (int q = 0; q < 22; ++q) { const int s = s0 + q, c = dir == 0 ? s : (s < 2 ? 1 - s : 67 - s); if (st) U[(size_t)c * 2048] = S; S = dd[q] * S + u[q]; }
        if (!st && S == 12345.678f) U[0] = S;
    }
}

__device__ __forceinline__ void lin_out_item(PRef p, int l, int item, char* lds) {
    unsigned long long g_t0 = PROBE_SUB ? __builtin_amdgcn_s_memrealtime() : 0ull;
    const int tid = tid_now(), lane = tid & 63, wid = tid >> 6;
    const int c = item % NCH, rest = item / NCH, type = rest & 1, h = (rest >> 1) & 3, b = rest >> 3;
    const LinCfg cf = lin_cfg(type, h);
    const int r0 = b * POSB + c * 128;
    lin_prefix(p, l, type, h, r0, true, lds);
    GSTAMP(21);
    const float* bf = (const float*)(lds + L_BF); const float* bs = (const float*)(lds + L_BS);
    bf16* qf = (bf16*)(lds + LO_QF); bf16* kf = (bf16*)(lds + LO_KF); bf16* qb = (bf16*)(lds + LO_QB); bf16* kb = (bf16*)(lds + LO_KB);
    bf16* qi = (bf16*)(lds + LO_QI); bf16* st = (bf16*)(lds + LO_ST); bf16* vt = (bf16*)(lds + LO_VT); bf16* W = (bf16*)(lds + LO_W);
    float* ssq = (float*)(lds + LO_SS);
    const bf16* P = (const bf16*)(p.ws + WS_P);
    { const int j = tid >> 2, c = tid & 3;
      const u32x4 q4 = *(const u32x4*)(P + (size_t)(r0 + j) * NP + cf.qcol + 8 * c), k4 = *(const u32x4*)(P + (size_t)(r0 + j) * NP + cf.kcol + 8 * c);
      const unsigned qw[4] = {q4.x, q4.y, q4.z, q4.w}, kw[4] = {k4.x, k4.y, k4.z, k4.w};
      unsigned oqf[4], okf[4], oqb[4], okb[4], oqi[4], oqj[4];
#pragma unroll
      for (int e2 = 0; e2 < 4; ++e2) {
          float vqf[2], vkf[2], vqb[2], vkb[2], vqi[2], vqj[2];
#pragma unroll
          for (int z = 0; z < 2; ++z) { const int kk = 8 * c + 2 * e2 + z;
              const float qv = z ? bfhi(qw[e2]) : bflo(qw[e2]), kv = z ? bfhi(kw[e2]) : bflo(kw[e2]);
              const float f = bf[j * 33 + kk], fm = bf[63 * 33 + kk], sx = bs[j * 33 + kk], sm = bs[64 * 33 + kk];
              vqf[z] = qv * __expf(f - fm); vkf[z] = kv * __expf(fm - f); vqb[z] = qv * __expf(sx - sm); vkb[z] = kv * __expf(sm - sx);
              vqi[z] = qv * __expf(f); vqj[z] = qv * __expf(sx); }
          oqf[e2] = pk2(vqf[0], vqf[1]); okf[e2] = pk2(vkf[0], vkf[1]); oqb[e2] = pk2(vqb[0], vqb[1]); okb[e2] = pk2(vkb[0], vkb[1]);
          oqi[e2] = pk2(vqi[0], vqi[1]); oqj[e2] = pk2(vqj[0], vqj[1]); }
      *(u32x4*)(qf + j * 40 + 8 * c) = (u32x4){oqf[0], oqf[1], oqf[2], oqf[3]}; *(u32x4*)(kf + j * 40 + 8 * c) = (u32x4){okf[0], okf[1], okf[2], okf[3]};
      *(u32x4*)(qb + j * 40 + 8 * c) = (u32x4){oqb[0], oqb[1], oqb[2], oqb[3]}; *(u32x4*)(kb + j * 40 + 8 * c) = (u32x4){okb[0], okb[1], okb[2], okb[3]};
      *(u32x4*)(qi + j * 72 + 8 * c) = (u32x4){oqi[0], oqi[1], oqi[2], oqi[3]}; *(u32x4*)(qi + j * 72 + 32 + 8 * c) = (u32x4){oqj[0], oqj[1], oqj[2], oqj[3]}; }
#pragma unroll
    for (int i = 0; i < 2; ++i) { const int q = tid + 512 * i, j = q >> 3, c = q & 7;
        const u32x4 v4 = *(const u32x4*)(P + (size_t)(r0 + j) * NP + cf.vcol + 8 * c);
        const unsigned vw[4] = {v4.x, v4.y, v4.z, v4.w};
#pragma unroll
        for (int e = 0; e < 4; ++e) { vt[(8 * c + 2 * e) * 136 + j] = (bf16)(vw[e] & 0xffff); vt[(8 * c + 2 * e + 1) * 136 + j] = (bf16)(vw[e] >> 16); } }
    { const float* Sf = (const float*)(p.ws + WS_US) + us_index(b, h, type, 0, c); const float* Sb = (const float*)(p.ws + WS_US) + us_index(b, h, type, 1, c);
      const f32x4 sf4 = *(const f32x4*)(Sf + 4 * tid), sb4 = *(const f32x4*)(Sb + 4 * tid);
      const int kk = (4 * tid) >> 6, dv = (4 * tid) & 63;
#pragma unroll
      for (int e = 0; e < 4; ++e) { st[(dv + e) * 72 + kk] = (bf16)f2bf(sf4[e]); st[(dv + e) * 72 + 32 + kk] = (bf16)f2bf(sb4[e]); } }
    __syncthreads();
    GSTAMP(22);
    const int li = lane & 31, hi = lane >> 5;
    {
        const int bi = wid >> 1;
#pragma unroll
        for (int jj = 0; jj < 2; ++jj) {
            const int bj = (wid & 1) * 2 + jj;
            f32x16 af = {0}, ab = {0};
#pragma unroll
            for (int s = 0; s < 2; ++s) {
                const bf16x8 kfa = *(const bf16x8*)(kf + (bj * 32 + li) * 40 + 16 * s + 8 * hi), qfb = *(const bf16x8*)(qf + (bi * 32 + li) * 40 + 16 * s + 8 * hi);
                const bf16x8 kba = *(const bf16x8*)(kb + (bj * 32 + li) * 40 + 16 * s + 8 * hi), qbb = *(const bf16x8*)(qb + (bi * 32 + li) * 40 + 16 * s + 8 * hi);
                af = __builtin_amdgcn_mfma_f32_32x32x16_bf16(kfa, qfb, af, 0, 0, 0);
                ab = __builtin_amdgcn_mfma_f32_32x32x16_bf16(kba, qbb, ab, 0, 0, 0);
            }
            const int i = bi * 32 + li;
#pragma unroll
            for (int a = 0; a < 4; ++a) {
                float w[4];
#pragma unroll
                for (int q = 0; q < 4; ++q) { const int j = bj * 32 + 8 * a + 4 * hi + q; w[q] = (i >= j ? af[4 * a + q] : 0.f) + (j >= i ? ab[4 * a + q] : 0.f); }
                u32x2 o; o.x = pk2(w[0], w[1]); o.y = pk2(w[2], w[3]);
                *(u32x2*)(W + i * 136 + bj * 32 + 8 * a + 4 * hi) = o;
            }
        }
    }
    __syncthreads();
    GSTAMP(23);
    const int bi = wid >> 1, bd = wid & 1;
    f32x16 o = {0};
#pragma unroll
    for (int s = 0; s < 8; ++s) {
        const bf16x8 va = *(const bf16x8*)(vt + (bd * 32 + li) * 136 + 16 * s + 8 * hi), wb = *(const bf16x8*)(W + (bi * 32 + li) * 136 + 16 * s + 8 * hi);
        o = __builtin_amdgcn_mfma_f32_32x32x16_bf16(va, wb, o, 0, 0, 0);
    }
#pragma unroll
    for (int s = 0; s < 4; ++s) {
        const bf16x8 sa = *(const bf16x8*)(st + (bd * 32 + li) * 72 + 16 * s + 8 * hi), qq = *(const bf16x8*)(qi + (bi * 32 + li) * 72 + 16 * s + 8 * hi);
        o = __builtin_amdgcn_mfma_f32_32x32x16_bf16(sa, qq, o, 0, 0, 0);
    }
    float ss = 0.f;
#pragma unroll
    for (int r = 0; r < 16; ++r) ss += o[r] * o[r];
    ss += __shfl_xor(ss, 32);
    const int tok = bi * 32 + li;
    if (hi == 0) ssq[tok * 2 + bd] = ss;
    __syncthreads();
    const bool need = (l == 0) || (c >= 2);
    if (need) {
        const float rn = rsqrtf((ssq[tok * 2] + ssq[tok * 2 + 1]) * (1.f / 64.f) + EPS);
        bf16* CAT = (bf16*)(p.ws + WS_CAT);
        const float* gg = p.in[15] + l * 64;
#pragma unroll
        for (int a = 0; a < 4; ++a) {
            const int dv = bd * 32 + 8 * a + 4 * hi;
            const u32x2 gt = *(const u32x2*)(P + (size_t)(r0 + tok) * NP + cf.gcol + dv);
            f32x4 g4 = {1.f, 1.f, 1.f, 1.f};
            if (type == 1) g4 = *(const f32x4*)(gg + dv);
            u32x2 ov; ov.x = pk2(o[4 * a] * rn * g4.x * bflo(gt.x), o[4 * a + 1] * rn * g4.y * bfhi(gt.x));
            ov.y = pk2(o[4 * a + 2] * rn * g4.z * bflo(gt.y), o[4 * a + 3] * rn * g4.w * bfhi(gt.y));
            *(u32x2*)(CAT + (size_t)(r0 + tok) * D + cf.ocol + dv) = ov;
        }
    }
    __syncthreads();
    GSTAMP(24);
}

constexpr int AT_STAGE = 32768, AT_K0 = 0, AT_K1 = 8192, AT_V = 16384, AT_X = 0;
#ifndef ATT_SETPRIO
#define ATT_SETPRIO 0
#endif
#define AT_PRIO(x) do { if (ATT_SETPRIO) __builtin_amdgcn_s_setprio(x); } while (0)
#define AT_SB() __builtin_amdgcn_sched_barrier(0)
#define AT_LDK(kfv, Kl) do { _Pragma("unroll") for (int kb = 0; kb < 2; ++kb) _Pragma("unroll") for (int s_ = 0; s_ < 4; ++s_) { const int krow = kb * 32 + qi; \
        kfv[kb][s_] = *(const bf16x8*)((Kl) + krow * 128 + (((2 * s_ + hi) ^ ((krow >> 1) & 7)) << 4)); } } while (0)
#define AT_LDV(vfv, Vl, t) do { const int vrow = 32 * (t) + qi; _Pragma("unroll") for (int c_ = 0; c_ < 4; ++c_) \
        vfv[c_] = *(const bf16x8*)((Vl) + vrow * 128 + (((2 * c_ + hi) ^ ((vrow >> 1) & 7)) << 4)); } while (0)
#define AT_QKM(sTv, kfv) do { AT_PRIO(1); \
        sTv[0] = __builtin_amdgcn_mfma_f32_32x32x16_bf16(kfv[0][0], qf[0], negm, 0, 0, 0); sTv[1] = __builtin_amdgcn_mfma_f32_32x32x16_bf16(kfv[1][0], qf[0], negm, 0, 0, 0); \
        _Pragma("unroll") for (int s_ = 1; s_ < 4; ++s_) { sTv[0] = __builtin_amdgcn_mfma_f32_32x32x16_bf16(kfv[0][s_], qf[s_], sTv[0], 0, 0, 0); \
            sTv[1] = __builtin_amdgcn_mfma_f32_32x32x16_bf16(kfv[1][s_], qf[s_], sTv[1], 0, 0, 0); } \
        AT_PRIO(0); } while (0)
#define AT_SOFTMAX(sTv, pfv) do { float _ls = 0.f; \
        _Pragma("unroll") for (int kb = 0; kb < 2; ++kb) _Pragma("unroll") for (int r = 0; r < 16; ++r) { const float pv = __builtin_amdgcn_exp2f(sTv[kb][r]); sTv[kb][r] = pv; _ls += pv; } \
        lrun += _ls; \
        _Pragma("unroll") for (int kb = 0; kb < 2; ++kb) _Pragma("unroll") for (int ks = 0; ks < 2; ++ks) { \
            u32x4 w; w.x = pk2(sTv[kb][8 * ks + 0], sTv[kb][8 * ks + 1]); w.y = pk2(sTv[kb][8 * ks + 2], sTv[kb][8 * ks + 3]); \
            w.z = pk2(sTv[kb][8 * ks + 4], sTv[kb][8 * ks + 5]); w.w = pk2(sTv[kb][8 * ks + 6], sTv[kb][8 * ks + 7]); pfv[kb][ks] = __builtin_bit_cast(bf16x8, w); } } while (0)
#define AT_PVM(pfv, vfv, t) do { AT_PRIO(1); \
        _Pragma("unroll") for (int c_ = 0; c_ < 4; ++c_) oacc[t] = __builtin_amdgcn_mfma_f32_32x32x16_bf16(vfv[c_], pfv[c_ >> 1][c_ & 1], oacc[t], 0, 0, 0); \
        AT_PRIO(0); } while (0)
__device__ __forceinline__ void attn_finish(PRef p, int l, int b, int h, int qpos0, char* lds, f32x16 (&oacc)[4], const float inv);
__device__ __forceinline__ void attn_unit(PRef p, int l, int b, int h, int qpos0, int nkeys, char* lds) {
    const int tid = tid_now(), lane = tid & 63, wid = __builtin_amdgcn_readfirstlane(tid >> 6), m = wid >> 2, qr = (wid & 3) * 32, qi = lane & 31, hi = lane >> 5;
    const bf16* P = (const bf16*)(p.ws + WS_P); const bf16* VT = (const bf16*)(p.ws + WS_VT);
    const size_t rowb = (size_t)b * POSB;
    LAS unsigned char* l3 = (LAS unsigned char*)lds;
    const bf16* gbase = wid < 4 ? P + rowb * NP + 2048 + h * 128 : VT + (size_t)(b * 4 + h) * 128 * POSB;
    const unsigned ginc = wid < 4 ? 64u * NP : 64u;
    unsigned go[4]; unsigned ldst[4];
#pragma unroll
    for (int j = 0; j < 4; ++j) {
        const int g = wid * 4 + j;
        const int r = 8 * (g & 7) + (g >= 16 ? 64 * ((g >> 3) & 1) : 0) + (lane >> 3);
        const int c = (lane & 7) ^ ((r >> 1) & 7);
        if (g < 16) { go[j] = (unsigned)r * NP + (g >> 3) * 64 + c * 8; ldst[j] = (g < 8 ? AT_K0 : AT_K1) + (8 * (g & 7)) * 128; }
        else { go[j] = (unsigned)r * POSB + c * 8; ldst[j] = AT_V + (8 * (g & 7) + 64 * ((g >> 3) & 1)) * 128; }
    }
#define AT_ISSUE(stage, kt) do { const bf16* _gb = gbase + (size_t)(kt) * ginc; _Pragma("unroll") for (int _j = 0; _j < 4; ++_j) \
        __builtin_amdgcn_global_load_lds((const unsigned*)(_gb + go[_j]), (LAS unsigned*)(l3 + (stage) * AT_STAGE + ldst[_j]), 16, 0, 0); } while (0)
    bf16x8 qf[4]; float q2 = 0.f;
    { const bf16* qp = P + (rowb + qpos0 + qr + qi) * NP + 1536 + h * 128 + m * 64 + 8 * hi;
#pragma unroll
      for (int s = 0; s < 4; ++s) { const u32x4 w = *(const u32x4*)(qp + 16 * s); qf[s] = __builtin_bit_cast(bf16x8, w);
          q2 += bflo(w.x) * bflo(w.x) + bfhi(w.x) * bfhi(w.x) + bflo(w.y) * bflo(w.y) + bfhi(w.y) * bfhi(w.y) + bflo(w.z) * bflo(w.z) + bfhi(w.z) * bfhi(w.z) + bflo(w.w) * bflo(w.w) + bfhi(w.w) * bfhi(w.w); } }
    q2 += __shfl_xor(q2, 32);
    const float k2 = __builtin_bit_cast(float, __hip_atomic_load((const unsigned*)(p.ws + WS_CTL) + CW_KMAX + (((l * 2 + b) * 4 + h) * 2 + m) * 64, __ATOMIC_RELAXED, __HIP_MEMORY_SCOPE_AGENT));
    const float mq = sqrtf(q2 * k2) * 1.002f + 1e-6f;
    f32x16 negm;
#pragma unroll
    for (int r = 0; r < 16; ++r) negm[r] = -mq;
    asm volatile("" : "+v"(negm));
    asm volatile("s_waitcnt vmcnt(0)" ::: "memory");
    const int nt = nkeys >> 6;
    AT_ISSUE(0, 0);
    if (nt > 1) AT_ISSUE(1, 1);
    f32x16 oacc[4];
#pragma unroll
    for (int t = 0; t < 4; ++t) oacc[t] = (f32x16){0};
    float lrun = 0.f;
    bf16x8 pf[2][2];
#pragma unroll
    for (int i = 0; i < 2; ++i)
#pragma unroll
        for (int j = 0; j < 2; ++j) pf[i][j] = (bf16x8){0, 0, 0, 0, 0, 0, 0, 0};
    int stage = 0;
#pragma unroll 1
    for (int kt = 0; kt < nt; ++kt) {
        if (kt + 1 < nt) asm volatile("s_waitcnt vmcnt(4)" ::: "memory"); else asm volatile("s_waitcnt vmcnt(0)" ::: "memory");
        __builtin_amdgcn_s_barrier();
        if (kt + 2 < nt) AT_ISSUE((stage + 2) & 3, kt + 2);
        const char* Kl = lds + stage * AT_STAGE + (m ? AT_K1 : AT_K0);
        f32x16 sT[2]; bf16x8 kf[2][4];
        {
            const char* Vc = lds + stage * AT_STAGE + AT_V;
            bf16x8 va[4], vb[4];
            AT_LDK(kf, Kl); AT_SB();
            AT_QKM(sT, kf); AT_SB();
            AT_LDV(va, Vc, 0); AT_LDV(vb, Vc, 1); AT_SB();
            AT_SOFTMAX(sT, pf); AT_SB();
            AT_PVM(pf, va, 0); AT_SB(); AT_LDV(va, Vc, 2); AT_SB(); AT_PVM(pf, vb, 1); AT_SB(); AT_LDV(vb, Vc, 3); AT_SB(); AT_PVM(pf, va, 2); AT_SB(); AT_PVM(pf, vb, 3); AT_SB();
        }
        stage = (stage + 1) & 3;
    }
#undef AT_ISSUE
    const float ltot = lrun + __shfl_xor(lrun, 32);
    const float inv = 1.f / ltot;
    __syncthreads();
    return attn_finish(p, l, b, h, qpos0, lds, oacc, inv);
}
__device__ __forceinline__ void attn_finish(PRef p, int l, int b, int h, int qpos0, char* lds, f32x16 (&oacc)[4], const float inv) {
    const int tid = tid_now(), lane = tid & 63, wid = __builtin_amdgcn_readfirstlane(tid >> 6), m = wid >> 2, qr = (wid & 3) * 32, qi = lane & 31, hi = lane >> 5;
    const size_t rowb = (size_t)b * POSB;
    float* X = (float*)(lds + AT_X) + (wid & 3) * 4096;
    if (m == 1) {
#pragma unroll
        for (int t = 0; t < 4; ++t)
#pragma unroll
            for (int r = 0; r < 16; ++r) X[(t * 16 + r) * 64 + lane] = oacc[t][r] * inv;
    }
    __syncthreads();
    if (m == 0) {
        const float* sc = (const float*)(p.ws + WS_SCAL) + l * 16;
        const float lam = sc[0], post = 1.f - sc[1];
        float ss = 0.f;
#pragma unroll
        for (int t = 0; t < 4; ++t)
#pragma unroll
            for (int r = 0; r < 16; ++r) { const float v = oacc[t][r] * inv - lam * X[(t * 16 + r) * 64 + lane]; oacc[t][r] = v; ss += v * v; }
        ss += __shfl_xor(ss, 32);
        const float rn = rsqrtf(ss * (1.f / 128.f) + EPS) * post;
        bf16* CAT = (bf16*)(p.ws + WS_CAT) + (rowb + qpos0 + qr + qi) * D + 512 + h * 128;
        const float* dg = p.in[17] + l * 128;
#pragma unroll
        for (int t = 0; t < 4; ++t)
#pragma unroll
            for (int a = 0; a < 4; ++a) {
                const int dv = 32 * t + 8 * a + 4 * hi;
                const f32x4 g4 = *(const f32x4*)(dg + dv);
                u32x2 ov; ov.x = pk2(oacc[t][4 * a] * rn * g4.x, oacc[t][4 * a + 1] * rn * g4.y); ov.y = pk2(oacc[t][4 * a + 2] * rn * g4.z, oacc[t][4 * a + 3] * rn * g4.w);
                *(u32x2*)(CAT + dv) = ov;
            }
    }
    __syncthreads();
}

__device__ __forceinline__ void phase_e(PRef p, int l, char* lds) {
    const int n_att = 512 + (l == 0 ? 16 : 0);
    const int n_lin = NCH * 16;
    for (int it = blockIdx.x; it < n_att + n_lin; it += gridDim.x) {
        if (it < 512) { const int bh = it & 7, qb = it >> 3; attn_unit(p, l, bh >> 2, bh & 3, CTX + qb * 128, POSB, lds); }
        else if (it < n_att) { const int u = it - 512, bh = u & 7, qb = u >> 3; attn_unit(p, l, bh >> 2, bh & 3, qb * 128, CTX, lds); }
        else { const int item = it - n_att; if (l == 0 || (item % NCH) >= 2) lin_out_item(p, l, item, lds); }
    }
}

__device__ __forceinline__ void phase_f(PRef p, int l, char* lds) {
    DenseSched S{(l == 0) ? 66 : 64, 4, ((l == 0) ? 66 : 64) * 4, l != 0};
    EpiBf16 E{(bf16*)(p.ws + WS_MO), D};
    pg8::gemm_phase<EpiBf16, DenseSched, false>((LAS unsigned char*)lds, (const bf16*)(p.ws + WS_CAT), (const bf16*)(p.ws + WS_WOUT), D, S, E);
}

__device__ __forceinline__ int ffn_row(int l, int idx) {
    if (l == 0) return idx;
    const int b = idx >> 13, t = idx & 8191; return b * POSB + CTX + t;
}
constexpr int GR_STRIDE = 2064, GR_HI = 0, GR_LO = 32 * GR_STRIDE, GR_LG = 64 * GR_STRIDE;
constexpr int GR_HIST = GR_LG + 8192, GR_BASE = GR_HIST + 256, GR_PAIR = GR_BASE + 256;
static_assert(GR_PAIR + 2048 <= LDS_MISC, "router LDS");
__device__ __forceinline__ void phase_g(PRef p, int l, char* lds, const bool st) {
    unsigned long long g_t0 = PROBE_SUB ? __builtin_amdgcn_s_memrealtime() : 0ull;
    const int tid = tid_now(), lane = tid & 63, wave = __builtin_amdgcn_readfirstlane(tid >> 6);
    const int ntok = (l == 0) ? R : BATCH * SEQ;
    const float* mods = (const float*)(p.ws + WS_MODS) + (size_t)l * 3 * 6144;
    const float* gpost = p.in[7] + l * D; const float* gpre = p.in[8] + l * D;
    const float bias = p.in[19][l * NEXP + lane];
    const bf16* MO = (const bf16*)(p.ws + WS_MO); bf16* HL = (bf16*)(p.ws + WS_HL);
    const bf16* WRH = (const bf16*)(p.ws + WS_WRH); const bf16* WRL = (const bf16*)(p.ws + WS_WRL);
    float* LG = (float*)(lds + GR_LG);
    unsigned* cnt = (unsigned*)(p.ws + WS_CTL) + CW_CNT + l * 4096;
    int* rowtok = (int*)(p.ws + WS_ROWTOK); int* pslot = (int*)(p.ws + WS_PSLOT); float* pw = (float*)(p.ws + WS_PW);
    int* hist = (int*)(lds + GR_HIST); int* base = (int*)(lds + GR_BASE); int* pair_i = (int*)(lds + GR_PAIR); float* pair_w = (float*)(lds + GR_PAIR + 1024);
    for (int g0 = blockIdx.x * 32; g0 < ntok; g0 += gridDim.x * 32) {
#pragma unroll 1
        for (int hf = 0; hf < 2; ++hf) {
            const float* gpost_ = gpost; const float* gpre_ = gpre; asm volatile("" : "+s"(gpost_), "+s"(gpre_));
            f32x4 mv[2][4], xv[2][4];
            int rowv[2]; const float* mdv[2];
#pragma unroll
            for (int rr = 0; rr < 2; ++rr) {
                const int row = ffn_row(l, g0 + 4 * wave + 2 * hf + rr); rowv[rr] = row;
                const int b = row_b(row), pos = row - b * POSB, rt = pos < CTX ? 2 : b; mdv[rr] = mods + rt * 6144;
                const float* xr = resid_row_ptr(p, l, row); const bf16* mr = MO + (size_t)row * D;
#pragma unroll
                for (int j = 0; j < 4; ++j) { const u32x2 mb = *(const u32x2*)(mr + 4 * lane + 256 * j); mv[rr][j] = (f32x4){bflo(mb.x), bfhi(mb.x), bflo(mb.y), bfhi(mb.y)}; xv[rr][j] = *(const f32x4*)(xr + 4 * lane + 256 * j); }
            }
            f32x4 gp4[4], gq4[4];
#pragma unroll
            for (int j = 0; j < 4; ++j) { gp4[j] = *(const f32x4*)(gpost_ + 4 * lane + 256 * j); gq4[j] = *(const f32x4*)(gpre_ + 4 * lane + 256 * j); }
            float ss[2], ss2[2];
#pragma unroll
            for (int rr = 0; rr < 2; ++rr) { ss[rr] = 0.f;
#pragma unroll
                for (int j = 0; j < 4; ++j) ss[rr] += mv[rr][j].x * mv[rr][j].x + mv[rr][j].y * mv[rr][j].y + mv[rr][j].z * mv[rr][j].z + mv[rr][j].w * mv[rr][j].w; }
#pragma unroll
            for (int o = 1; o < 64; o <<= 1) {
#pragma unroll
                for (int rr = 0; rr < 2; ++rr) ss[rr] += __shfl_xor(ss[rr], o); }
#pragma unroll
            for (int rr = 0; rr < 2; ++rr) {
                const float* md = mdv[rr]; float* xo = resid_row_out(p, rowv[rr]);
                const float r1 = rsqrtf(ss[rr] * (1.f / D) + EPS);
                ss2[rr] = 0.f;
#pragma unroll
                for (int j = 0; j < 4; ++j) { const int k0 = 4 * lane + 256 * j;
                    const f32x4 gt = *(const f32x4*)(md + 2 * D + k0);
                    xv[rr][j] = xv[rr][j] + gt * (mv[rr][j] * r1 * gp4[j]);
                    if (st) *(f32x4*)(xo + k0) = xv[rr][j];
                    ss2[rr] += xv[rr][j].x * xv[rr][j].x + xv[rr][j].y * xv[rr][j].y + xv[rr][j].z * xv[rr][j].z + xv[rr][j].w * xv[rr][j].w; }
            }
#pragma unroll
            for (int o = 1; o < 64; o <<= 1) {
#pragma unroll
                for (int rr = 0; rr < 2; ++rr) ss2[rr] += __shfl_xor(ss2[rr], o); }
#pragma unroll
            for (int rr = 0; rr < 2; ++rr) {
                const int lr = 4 * wave + 2 * hf + rr;
                const int row = rowv[rr];
                const float* md = mdv[rr];
                const float r2 = rsqrtf(ss2[rr] * (1.f / D) + EPS);
#pragma unroll
                for (int j = 0; j < 4; ++j) { const int k0 = 4 * lane + 256 * j;
                    const f32x4 s1 = *(const f32x4*)(md + 4 * D + k0), s0 = *(const f32x4*)(md + 3 * D + k0);
                    const f32x4 hv = xv[rr][j] * r2 * gq4[j] * (s1 + 1.f) + s0;
                    unsigned hb[4], lb[4];
#pragma unroll
                    for (int i = 0; i < 4; ++i) { hb[i] = f2bf(hv[i]); lb[i] = f2bf(hv[i] - __builtin_bit_cast(float, hb[i] << 16)); }
                    u32x2 oh; oh.x = hb[0] | (hb[1] << 16); oh.y = hb[2] | (hb[3] << 16);
                    u32x2 ol; ol.x = lb[0] | (lb[1] << 16); ol.y = lb[2] | (lb[3] << 16);
                    if (st) *(u32x2*)(HL + (size_t)row * D + k0) = oh;
                    *(u32x2*)(lds + GR_HI + lr * GR_STRIDE + 2 * k0) = oh;
                    *(u32x2*)(lds + GR_LO + lr * GR_STRIDE + 2 * k0) = ol; }
            }
        }
        if (tid < 64) hist[tid] = 0;
        __syncthreads();
        GSTAMP(1);
        {
            const int et = wave & 3, tt = wave >> 2, fr = lane & 15, fq = lane >> 4;
            const bf16* wh = WRH + (size_t)(et * 16 + fr) * D + 8 * fq; const bf16* wl = WRL + (size_t)(et * 16 + fr) * D + 8 * fq;
            const char* hh = lds + GR_HI + (tt * 16 + fr) * GR_STRIDE + 16 * fq; const char* hl2 = lds + GR_LO + (tt * 16 + fr) * GR_STRIDE + 16 * fq;
            f32x4 acc = {0.f, 0.f, 0.f, 0.f};
#pragma unroll 1
            for (int s0 = 0; s0 < 32; s0 += 8) {
                bf16x8 whi[8], wlo[8];
#pragma unroll
                for (int i = 0; i < 8; ++i) { whi[i] = *(const bf16x8*)(wh + 32 * (s0 + i)); wlo[i] = *(const bf16x8*)(wl + 32 * (s0 + i)); }
                __builtin_amdgcn_sched_barrier(0);
#pragma unroll
                for (int i = 0; i < 8; ++i) {
                    const bf16x8 hhi = *(const bf16x8*)(hh + 64 * (s0 + i)), hlo = *(const bf16x8*)(hl2 + 64 * (s0 + i));
                    acc = __builtin_amdgcn_mfma_f32_16x16x32_bf16(whi[i], hhi, acc, 0, 0, 0);
                    acc = __builtin_amdgcn_mfma_f32_16x16x32_bf16(whi[i], hlo, acc, 0, 0, 0);
                    acc = __builtin_amdgcn_mfma_f32_16x16x32_bf16(wlo[i], hhi, acc, 0, 0, 0);
                }
                __builtin_amdgcn_sched_barrier(0);
            }
            *(f32x4*)(LG + (tt * 16 + fr) * 64 + et * 16 + 4 * fq) = acc;
        }
        __syncthreads();
        GSTAMP(2);
#pragma unroll
        for (int rr = 0; rr < 4; ++rr) {
            const int lr = 4 * wave + rr;
            const int row = ffn_row(l, g0 + lr);
            const float score = 1.f / (1.f + __expf(-LG[lr * 64 + lane]));
            const float sel = score + bias;
            const int grp = lane >> 3;
            float m1 = sel; m1 = fmaxf(m1, __shfl_xor(m1, 1)); m1 = fmaxf(m1, __shfl_xor(m1, 2)); m1 = fmaxf(m1, __shfl_xor(m1, 4));
            const unsigned long long bm = __ballot(sel == m1);
            const int first = __builtin_ctz((unsigned)((bm >> (8 * grp)) & 0xffull)) + 8 * grp;
            float m2 = (lane == first) ? -INFINITY : sel; m2 = fmaxf(m2, __shfl_xor(m2, 1)); m2 = fmaxf(m2, __shfl_xor(m2, 2)); m2 = fmaxf(m2, __shfl_xor(m2, 4));
            const float gs = m1 + m2;
            int rank = 0;
#pragma unroll
            for (int g2 = 0; g2 < 8; ++g2) { const float o = __shfl(gs, 8 * g2); rank += (o > gs || (o == gs && g2 < grp)) ? 1 : 0; }
            float mv = rank < 4 ? sel : -INFINITY;
            float wsum = 0.f; float myw = 0.f; int mye = 0;
#pragma unroll
            for (int k = 0; k < 6; ++k) {
                const float mx = wave_max(mv);
                const unsigned long long b2 = __ballot(mv == mx);
                const int e = __builtin_ctzll(b2);
                const float sce = __shfl(score, e);
                wsum += sce;
                if (lane == k) { myw = sce; mye = e; }
                if (lane == e) mv = -INFINITY;
            }
            if (lane < 6) { const int lrk = atomicAdd(hist + mye, 1); pair_i[lr * 8 + lane] = (mye << 16) | lrk; pair_w[lr * 8 + lane] = myw / wsum * 2.5f; }
        }
        __syncthreads();
        GSTAMP(3);
        if (st && tid < 64) { const int hc = hist[tid]; if (hc > 0) base[tid] = (int)atomicAdd(cnt + tid * 64, (unsigned)hc); }
        __syncthreads();
        if (st && tid < 192) { const int lr = tid / 6, k = tid - lr * 6; const int row = ffn_row(l, g0 + lr);
            const int pi = pair_i[lr * 8 + k], e = pi >> 16, rk = base[e] + (pi & 0xffff);
            rowtok[e * CAP + rk] = row; pslot[row * 8 + k] = (e << 16) | rk; pw[row * 8 + k] = pair_w[lr * 8 + k]; }
        GSTAMP(4);
    }
}

constexpr int M_TBL = 133120;
__device__ __forceinline__ void moe_table(PRef p, int l, char* lds) {
    int* tb = (int*)(lds + M_TBL);
    const unsigned* cnt = (const unsigned*)(p.ws + WS_CTL) + CW_CNT + l * 4096;
    if (tid_now() == 0) {
        int acc = 0;
        for (int e = 0; e < 65; ++e) { const int c = e < 64 ? (int)__hip_atomic_load(cnt + e * 64, __ATOMIC_RELAXED, __HIP_MEMORY_SCOPE_AGENT) : (l == 0 ? R : BATCH * SEQ);
            tb[e] = acc; tb[128 + e] = c; acc += (c + 255) >> 8; }
        tb[65] = acc;
    }
    __syncthreads();
}
__device__ __forceinline__ int moe_find(const int* tb, int tile) { int e = 0; while (e < 64 && tile >= tb[e + 1]) ++e; return e; }

struct MoeSched {
    const int* tb; const int* rowtok; int nsub, nunits, l;
    __device__ __forceinline__ bool next(int i, pg8::Unit& u) const {
        const int L = i * (int)gridDim.x + virt_block(); if (L >= nunits) return false;
        const int tile = L / nsub, sub = L - tile * nsub, e = moe_find(tb, tile);
        u.pm = tile; u.pn = e * nsub + sub; u.e = e; u.ti = tile - tb[e]; return true;
    }
    __device__ __forceinline__ int src_row(const pg8::Unit& u, int r) const {
        const int idx = u.ti * 256 + r; if (idx >= tb[128 + u.e]) return 0;
        return u.e < 64 ? rowtok[u.e * CAP + idx] : ffn_row(l, idx);
    }
};
__device__ __forceinline__ void phase_h(PRef p, int l, char* lds) {
    moe_table(p, l, lds);
    const int* tb = (const int*)(lds + M_TBL);
    MoeSched S{tb, (const int*)(p.ws + WS_ROWTOK), 2, tb[65] * 2, l};
    EpiGateUp E{(bf16*)(p.ws + WS_HB)};
    pg8::gemm_phase<EpiGateUp, MoeSched, true>((LAS unsigned char*)lds, (const bf16*)(p.ws + WS_HL), (const bf16*)(p.ws + WS_WGU), D, S, E);
}
__device__ __forceinline__ void phase_i(PRef p, int l, char* lds) {
    moe_table(p, l, lds);
    const int* tb = (const int*)(lds + M_TBL);
    MoeSched S{tb, (const int*)(p.ws + WS_ROWTOK), 4, tb[65] * 4, l};
    EpiFp8 E{(unsigned char*)(p.ws + WS_Y)};
    pg8::gemm_phase<EpiFp8, MoeSched, false>((LAS unsigned char*)lds, (const bf16*)(p.ws + WS_HB), (const bf16*)(p.ws + WS_WD), DEXP, S, E);
}
__device__ __forceinline__ void phase_j(PRef p, int l, char* lds, const bool st) {
    moe_table(p, l, lds);
    const int* tb = (const int*)(lds + M_TBL);
    const int tid = tid_now(), lane = tid & 63, wave = tid >> 6;
    const int ntok = (l == 0) ? R : BATCH * SEQ;
    const float* mods = (const float*)(p.ws + WS_MODS) + (size_t)l * 3 * 6144;
    const float* gpost = p.in[9] + l * D;
    const unsigned char* Y = (const unsigned char*)(p.ws + WS_Y);
    const int* pslot = (const int*)(p.ws + WS_PSLOT); const float* pw = (const float*)(p.ws + WS_PW);
    const int wstride = (int)gridDim.x * NWAVE;
    for (int base = blockIdx.x * NWAVE + wave; base < ntok; base += 2 * wstride) {
        int idx[2]; bool ok[2]; idx[0] = base; idx[1] = base + wstride; ok[0] = true; ok[1] = idx[1] < ntok; if (!ok[1]) idx[1] = idx[0];
        int ps[2][6]; float pwv[2][6]; int rowv[2];
#pragma unroll
        for (int tk = 0; tk < 2; ++tk) { rowv[tk] = ffn_row(l, idx[tk]);
#pragma unroll
            for (int k = 0; k < 6; ++k) { ps[tk][k] = pslot[rowv[tk] * 8 + k]; pwv[tk][k] = pw[rowv[tk] * 8 + k]; } }
        f32x4 f[2][4];
#pragma unroll
        for (int tk = 0; tk < 2; ++tk) { const unsigned char* yr = Y + ((size_t)tb[64] * 256 + idx[tk]) * D;
#pragma unroll
            for (int j = 0; j < 4; ++j) { const int v = *(const int*)(yr + 4 * lane + 256 * j);
                const f32x2_t lo = __builtin_amdgcn_cvt_pk_f32_fp8(v, false), hi2 = __builtin_amdgcn_cvt_pk_f32_fp8(v, true);
                f[tk][j] = (f32x4){lo.x, lo.y, hi2.x, hi2.y} * 0.03125f; } }
#pragma unroll
        for (int k = 0; k < 6; ++k) {
#pragma unroll
            for (int tk = 0; tk < 2; ++tk) {
                const int e = ps[tk][k] >> 16, rk = ps[tk][k] & 0xffff; const float w = pwv[tk][k] * 0.03125f;
                const unsigned char* yr = Y + ((size_t)tb[e] * 256 + rk) * D;
#pragma unroll
                for (int j = 0; j < 4; ++j) { const int v = *(const int*)(yr + 4 * lane + 256 * j);
                    const f32x2_t lo = __builtin_amdgcn_cvt_pk_f32_fp8(v, false), hi2 = __builtin_amdgcn_cvt_pk_f32_fp8(v, true);
                    f[tk][j].x += w * lo.x; f[tk][j].y += w * lo.y; f[tk][j].z += w * hi2.x; f[tk][j].w += w * hi2.y; }
            }
        }
        float ss[2];
#pragma unroll
        for (int tk = 0; tk < 2; ++tk) { ss[tk] = 0.f;
#pragma unroll
            for (int j = 0; j < 4; ++j) ss[tk] += f[tk][j].x * f[tk][j].x + f[tk][j].y * f[tk][j].y + f[tk][j].z * f[tk][j].z + f[tk][j].w * f[tk][j].w; }
#pragma unroll
        for (int o = 1; o < 64; o <<= 1) { ss[0] += __shfl_xor(ss[0], o); ss[1] += __shfl_xor(ss[1], o); }
        float s2[2];
#pragma unroll
        for (int tk = 0; tk < 2; ++tk) {
            const int row = rowv[tk];
            const int b = row_b(row), pos = row - b * POSB, rt = pos < CTX ? 2 : b;
            const float* md = mods + rt * 6144;
            float* xo = resid_row_out(p, row);
            const float rn = rsqrtf(ss[tk] * (1.f / D) + EPS);
            s2[tk] = 0.f;
#pragma unroll
            for (int j = 0; j < 4; ++j) { const int k0 = 4 * lane + 256 * j;
                const f32x4 gp = *(const f32x4*)(gpost + k0), gt = *(const f32x4*)(md + 5 * D + k0);
                const f32x4 xv = *(const f32x4*)(xo + k0);
                f[tk][j] = xv + gt * (f[tk][j] * rn * gp);
                if (st && ok[tk]) *(f32x4*)(xo + k0) = f[tk][j];
                s2[tk] += f[tk][j].x * f[tk][j].x + f[tk][j].y * f[tk][j].y + f[tk][j].z * f[tk][j].z + f[tk][j].w * f[tk][j].w; }
        }
        if (l == 0) {
#pragma unroll
            for (int o = 1; o < 64; o <<= 1) { s2[0] += __shfl_xor(s2[0], o); s2[1] += __shfl_xor(s2[1], o); }
            const float* gpre1 = p.in[6] + D; bf16* HL = (bf16*)(p.ws + WS_HL); asm volatile("" : "+s"(gpre1), "+s"(HL));
#pragma unroll
            for (int tk = 0; tk < 2; ++tk) {
                const int row = rowv[tk];
                const int b = row_b(row), pos = row - b * POSB, rt = pos < CTX ? 2 : b;
                const float* md1 = mods + rt * 6144 + 3 * 6144;
                const float rs = rsqrtf(s2[tk] * (1.f / D) + EPS);
#pragma unroll
                for (int j = 0; j < 4; ++j) { const int k0 = 4 * lane + 256 * j;
                    const f32x4 g = *(const f32x4*)(gpre1 + k0), s1 = *(const f32x4*)(md1 + D + k0), s0 = *(const f32x4*)(md1 + k0);
                    const f32x4 h = f[tk][j] * rs * g * (s1 + 1.f) + s0;
                    u32x2 o; o.x = pk2(h.x, h.y); o.y = pk2(h.z, h.w);
                    if (st && ok[tk]) *(u32x2*)(HL + (size_t)row * D + k0) = o; }
            }
        }
    }
    if (st && l == 0) { __syncthreads(); convert_weights(p, 1, lds); }
}

__global__ void __launch_bounds__(NTHR, 2) mk_fwd(Params p_arg) {
    extern __shared__ __attribute__((aligned(16))) unsigned char lds_raw[];
    char* lds = (char*)lds_raw;
    volatile unsigned* misc = (volatile unsigned*)(lds + LDS_MISC);
    if (threadIdx.x < 64) misc[threadIdx.x] = 0u;
    __syncthreads();
    XcdBarrier bar; bar.bar = (unsigned*)(p_arg.ws + WS_CTL) + CW_BAR; bar.x = 0; bar.st = misc;
    const int ph_lo = p_arg.ph_lo, ph_hi = p_arg.ph_hi;
    if (ph_hi - ph_lo > 1) bar = xcd_barrier_post((unsigned*)(p_arg.ws + WS_CTL) + CW_BAR, misc);
#ifndef PROBE_MASK
#define PROBE_MASK 0
#endif
#define PROBE_MULT 2
#ifndef ONLY_PHASE
#define ONLY_PHASE -1
#endif
#define PH_ON(k) (ONLY_PHASE < 0 || ((ONLY_PHASE >> (k)) & 1))
#ifndef DBL_MASK
#define DBL_MASK 0
#endif
    unsigned long long t_prev = PROBE_MASK ? __builtin_amdgcn_s_memrealtime() : 0ull, t_acc = 0ull;
#define KARGS() const __attribute__((address_space(4))) Params* pk = (const __attribute__((address_space(4))) Params*)__builtin_amdgcn_kernarg_segment_ptr(); \
        asm volatile("" : "+s"(pk) :: "memory"); PRef p = *pk
#define RUN(ph, ty, call) do { if (ph_lo <= (ph) && (ph) < ph_hi) { { KARGS(); call; } if ((ph) + 1 < ph_hi) xcd_barrier(bar); \
        if (PROBE_MASK) { const unsigned long long t_now = __builtin_amdgcn_s_memrealtime(); if ((PROBE_MASK >> (ty)) & 1) t_acc += t_now - t_prev; t_prev = t_now; } } } while (0)
    RUN(0, 10, if (PH_ON(0)) phase_p0(p, lds));
    RUN(1, 0, if (PH_ON(1)) phase_a(p, 0, lds, true));
    RUN(2, 1, if (PH_ON(2)) phase_b(p, 0, lds));
    RUN(3, 2, if (PH_ON(3)) phase_c(p, 0, lds, true));
    RUN(4, 3, if (PH_ON(4)) phase_d(p, 0, true));
    RUN(5, 4, if (PH_ON(5)) phase_e(p, 0, lds));
    RUN(6, 5, if (PH_ON(6)) phase_f(p, 0, lds));
    RUN(7, 6, if (PH_ON(7)) phase_g(p, 0, lds, true));
    RUN(8, 7, if (PH_ON(8)) phase_h(p, 0, lds));
    RUN(9, 8, if (PH_ON(9)) phase_i(p, 0, lds));
    RUN(10, 9, if (PH_ON(10)) phase_j(p, 0, lds, true));
    RUN(12, 1, if (PH_ON(2)) phase_b(p, 1, lds));
    RUN(13, 2, if (PH_ON(3)) phase_c(p, 1, lds, true));
    RUN(14, 3, if (PH_ON(4)) phase_d(p, 1, true));
    RUN(15, 4, if (PH_ON(5)) phase_e(p, 1, lds));
    RUN(16, 5, if (PH_ON(6)) phase_f(p, 1, lds));
    RUN(17, 6, if (PH_ON(7)) phase_g(p, 1, lds, true));
    RUN(18, 7, if (PH_ON(8)) phase_h(p, 1, lds));
    RUN(19, 8, if (PH_ON(9)) phase_i(p, 1, lds));
    RUN(20, 9, if (PH_ON(10)) phase_j(p, 1, lds, true));
    if (PROBE_SUB && blockIdx.x == 0) { const unsigned long long acc2 = *(volatile unsigned long long*)(lds + LDS_MISC + 128); const unsigned long long t0 = __builtin_amdgcn_s_memrealtime(); while (__builtin_amdgcn_s_memrealtime() - t0 < 4ull * acc2) __builtin_amdgcn_s_sleep(8); }
    if (PROBE_MASK && blockIdx.x == 0) { const unsigned long long t0 = __builtin_amdgcn_s_memrealtime(); while (__builtin_amdgcn_s_memrealtime() - t0 < PROBE_MULT * t_acc) __builtin_amdgcn_s_sleep(8); }
}
}

extern "C" void kernel_launch(void* const* d_in, const int* in_sizes, int n_in, void* d_out, int out_size, void* d_ws, size_t ws_size, hipStream_t stream) {
    static int grid = 0;
    if (grid == 0) {
        if (n_in != 26 || ws_size < WS_END) { fprintf(stderr, "kernel_launch: unexpected n_in %d / ws_size %zu\n", n_in, ws_size); grid = -1; return; }
        int dev = 0, cus = 0, per_cu = 0;
        (void)hipGetDevice(&dev); (void)hipDeviceGetAttribute(&cus, hipDeviceAttributeMultiprocessorCount, dev);
        (void)hipFuncSetAttribute((const void*)mk_fwd, hipFuncAttributeMaxDynamicSharedMemorySize, LDS_BYTES);
        (void)hipOccupancyMaxActiveBlocksPerMultiprocessor(&per_cu, (const void*)mk_fwd, NTHR, LDS_BYTES);
        (void)hipGetLastError();
        if (per_cu < 1) fprintf(stderr, "kernel_launch: occupancy query says %d blocks per CU\n", per_cu);
        grid = cus;
    }
    if (grid < 0) return;
    (void)hipMemsetAsync((char*)d_ws + WS_CTL, 0, 1 * MiB, stream);
    Params p{};
    for (int i = 0; i < 26; ++i) p.in[i] = (const float*)d_in[i];
    p.out = (float*)d_out; p.ws = (unsigned char*)d_ws;
#if MK_LAUNCHES == 1
    p.ph_lo = 0; p.ph_hi = NPHASE;
    hipLaunchKernelGGL(mk_fwd, dim3(grid), dim3(NTHR), LDS_BYTES, stream, p);
#else
    for (int ph = 0; ph < NPHASE; ++ph) { p.ph_lo = ph; p.ph_hi = ph + 1; hipLaunchKernelGGL(mk_fwd, dim3(grid), dim3(NTHR), LDS_BYTES, stream, p); }
#endif
}
```

```cpp
#include <hip/hip_runtime.h>
#include <cstdio>
#include <cstdint>

#ifndef MK_LAUNCHES
#define MK_LAUNCHES 1
#endif

namespace {
typedef unsigned short bf16;
typedef short bf16x8 __attribute__((ext_vector_type(8)));
typedef float f32x4 __attribute__((ext_vector_type(4)));
typedef float f32x16 __attribute__((ext_vector_type(16)));
typedef unsigned u32x4 __attribute__((ext_vector_type(4)));
typedef unsigned u32x2 __attribute__((ext_vector_type(2)));
#define LAS __attribute__((address_space(3)))

constexpr int D = 1024, BATCH = 2, SEQ = 8192, CTX = 256, POSB = SEQ + CTX  , R = BATCH * POSB  ;
constexpr int NIN = 3088, NP = 3072;
constexpr int NEXP = 64, DEXP = 256, CAP = R;
constexpr int NCH = POSB / 128;
constexpr float EPS = 1e-6f;
constexpr int NTHR = 512, NWAVE = 8;
constexpr int NPHASE = 21;
constexpr int HB_ROWS = 134912;

constexpr size_t MiB = 1u << 20;
constexpr size_t WS_CTL = 0;
constexpr size_t WS_MODS = 1 * MiB;
constexpr size_t WS_TAB8 = WS_MODS + 192 * 1024;
constexpr size_t WS_TAB16 = WS_TAB8 + 8192;
constexpr size_t WS_SCAL = WS_TAB16 + 16384;
constexpr size_t WS_WRH = WS_MODS + 256 * 1024;
constexpr size_t WS_WRL = WS_MODS + 384 * 1024;
constexpr size_t WS_WLR = WS_MODS + 512 * 1024;
constexpr size_t WS_GWP = WS_MODS + 576 * 1024;
constexpr size_t WS_HCTX = 2 * MiB;
constexpr size_t WS_ROWTOK = 4 * MiB;
constexpr size_t WS_PSLOT = 9 * MiB;
constexpr size_t WS_PW = 10 * MiB;
constexpr size_t WS_DEC = 11 * MiB;
constexpr size_t WS_WIN = 12 * MiB;
constexpr size_t WS_WOUT = 18 * MiB;
constexpr size_t WS_WGU = 20 * MiB;
constexpr size_t WS_WD = 85 * MiB;
constexpr size_t WS_HL = 118 * MiB;
constexpr size_t WS_HB = 151 * MiB;
constexpr size_t WS_X = 217 * MiB;
constexpr size_t WS_P = WS_X;
constexpr size_t WS_VT = 316 * MiB;
constexpr size_t WS_US = 333 * MiB;
constexpr size_t WS_CAT = 366 * MiB;
constexpr size_t WS_MO = 399 * MiB;
constexpr size_t WS_LA = 465 * MiB;
constexpr size_t WS_Y = WS_X;
constexpr size_t WS_END = 482 * MiB;
static_assert(WS_Y + (size_t)HB_ROWS * 2048 <= WS_END, "Y fits");
static_assert(WS_HB + (size_t)HB_ROWS * 512 <= WS_X, "HB fits");

constexpr int CW_BAR = 4096;
constexpr int CW_CNT = 16384;
constexpr int CW_KMAX = 32768;

constexpr int LDS_BYTES = 147456;
constexpr int LDS_MISC = 147456 - 256;

struct Params { const float* in[26]; float* out; unsigned char* ws; int ph_lo, ph_hi; };
typedef const __attribute__((address_space(4))) Params& PRef;

__device__ __forceinline__ unsigned f2bf(float f) { unsigned u = __builtin_bit_cast(unsigned, f); return (u + 0x7fffu + ((u >> 16) & 1u)) >> 16; }
typedef float f32x2_t __attribute__((ext_vector_type(2)));
typedef __bf16 bf16x2_t __attribute__((ext_vector_type(2)));
__device__ __forceinline__ unsigned pk2(float lo, float hi) { f32x2_t v = {lo, hi}; bf16x2_t b = __builtin_convertvector(v, bf16x2_t); return __builtin_bit_cast(unsigned, b); }
__device__ __forceinline__ float bf2f(unsigned short b) { return __builtin_bit_cast(float, (unsigned)b << 16); }
__device__ __forceinline__ float bflo(unsigned u) { return __builtin_bit_cast(float, u << 16); }
__device__ __forceinline__ float bfhi(unsigned u) { return __builtin_bit_cast(float, u & 0xffff0000u); }
__device__ __forceinline__ float wave_sum(float v) {
#pragma unroll
    for (int o = 1; o < 64; o <<= 1) v += __shfl_xor(v, o);
    return v;
}
__device__ __forceinline__ float wave_max(float v) {
#pragma unroll
    for (int o = 1; o < 64; o <<= 1) v = fmaxf(v, __shfl_xor(v, o));
    return v;
}
__device__ __forceinline__ float silu_f(float x) { return x / (1.f + __expf(-x)); }
__device__ __forceinline__ float logsig_f(float x) { return fminf(x, 0.f) - log1pf(__expf(-fabsf(x))); }
#define LDS_FENCE() asm volatile("s_waitcnt lgkmcnt(0)" ::: "memory")
#ifndef PROBE_SUB
#define PROBE_SUB 0
#endif

__device__ __forceinline__ int tid_now() { int t = threadIdx.x; asm volatile("" : "+v"(t)); return t; }

#define XB_TMO      128
#define XB_XCNT(j)  (256  + 64 * (j))
#define XB_XSUB(j)  (1280 + 64 * (j))
#define XB_XGEN(j)  (2304 + 64 * (j))
#define XB_TOP      3328
#define XB_TOPGEN   3392
#define XCD_BAR_WORDS 3456
#define XB_SPIN_CAP (1u << 20)
__device__ __forceinline__ unsigned xb_ld(unsigned* p)              { return __hip_atomic_load(p, __ATOMIC_RELAXED, __HIP_MEMORY_SCOPE_AGENT); }
__device__ __forceinline__ unsigned xb_add(unsigned* p, unsigned v) { return __hip_atomic_fetch_add(p, v, __ATOMIC_RELAXED, __HIP_MEMORY_SCOPE_AGENT); }
__device__ __forceinline__ unsigned xb_xcc_id() { return (unsigned)__builtin_amdgcn_s_getreg((3 << 11) | 20) & 0xFu; }
#define XB_SPIN(cond, bar) do { unsigned _sp = 0; while (cond) { __builtin_amdgcn_s_sleep(1); \
    if ((++_sp & 255u) == 0u) { if (xb_ld(&(bar)[XB_TMO])) break; if (_sp > XB_SPIN_CAP) { atomicAdd(&(bar)[XB_TMO], 1u); break; } } } } while (0)
struct XcdBarrier { unsigned* bar; unsigned x; volatile unsigned* st; };
__device__ __forceinline__ XcdBarrier xcd_barrier_post(unsigned* bar, volatile unsigned* st) {
    XcdBarrier b; b.bar = bar; b.x = xb_xcc_id(); b.st = st;
    if (threadIdx.x == 0) (void)xb_add(&bar[XB_XCNT(b.x)], 1u);
    return b;
}
__device__ __forceinline__ void xcd_barrier_complete(unsigned* bar, unsigned x, unsigned& nloc, unsigned& nx) {
    const unsigned G = gridDim.x;
    unsigned sum, cnt, mine, sp = 0u;
    for (;;) {
        sum = 0u; cnt = 0u; mine = 0u;
#pragma unroll
        for (unsigned j = 0; j < 16; ++j) { const unsigned c = xb_ld(&bar[XB_XCNT(j)]); sum += c; cnt += (c > 0u) ? 1u : 0u; mine = (j == x) ? c : mine; }
        if (sum == G) break;
        __builtin_amdgcn_s_sleep(1);
        if ((++sp & 255u) == 0u) { if (xb_ld(&bar[XB_TMO])) break; if (sp > XB_SPIN_CAP) { atomicAdd(&bar[XB_TMO], 1u); break; } }
    }
    nloc = mine > 0u ? mine : 1u; nx = cnt > 0u ? cnt : 1u;
}
__device__ __forceinline__ void xcd_barrier(const XcdBarrier& b) {
    asm volatile("s_waitcnt vmcnt(0)" ::: "memory");
    __syncthreads();
    if (threadIdx.x == 0) {
        unsigned* bar = b.bar;
        __builtin_amdgcn_s_waitcnt(0);
        unsigned nloc = b.st[0], nx = b.st[1];
        if (nloc == 0u) { xcd_barrier_complete(bar, b.x, nloc, nx); b.st[0] = nloc; b.st[1] = nx; }
        const unsigned old = xb_add(&bar[XB_XSUB(b.x)], 1u);
        const unsigned gen = old / nloc;
        if (old + 1u == (gen + 1u) * nloc) {
            __builtin_amdgcn_fence(__ATOMIC_RELEASE, "agent");
            asm volatile("s_waitcnt vmcnt(0)" ::: "memory");
            const unsigned og = xb_add(&bar[XB_TOP], 1u);
            const unsigned tg = og / nx;
            if (og + 1u == (tg + 1u) * nx) xb_add(&bar[XB_TOPGEN], 1u);
            else XB_SPIN(xb_ld(&bar[XB_TOPGEN]) == tg, bar);
            __builtin_amdgcn_fence(__ATOMIC_ACQUIRE, "agent");
            xb_add(&bar[XB_XGEN(b.x)], 1u);
            asm volatile("s_waitcnt vmcnt(0)" ::: "memory");
        } else {
            XB_SPIN(xb_ld(&bar[XB_XGEN(b.x)]) == gen, bar);
            __builtin_amdgcn_fence(__ATOMIC_ACQUIRE, "agent");
            asm volatile("s_waitcnt vmcnt(0)" ::: "memory");
        }
    }
    __syncthreads();
}

__device__ __forceinline__ int row_b(int row) { return row >= POSB ? 1 : 0; }

struct CvItem { const float* src; bf16* dst; int ldw, ldt, k0, drow0, dstep; };
__device__ __forceinline__ void cv_load(const CvItem& d, f32x4 (&v)[8], int lane) {
    const int kr = lane >> 3, c4 = lane & 7;
#pragma unroll
    for (int i = 0; i < 8; ++i) v[i] = __builtin_nontemporal_load((const f32x4*)(d.src + (size_t)(d.k0 + 8 * i + kr) * d.ldw + 4 * c4));
}
__device__ __forceinline__ void cv_finish(const CvItem& d, const f32x4 (&v)[8], float* scr, int lane) {
    const int kr = lane >> 3, c4 = lane & 7;
#pragma unroll
    for (int i = 0; i < 8; ++i) { float* q = scr + (8 * i + kr) * 33 + 4 * c4; q[0] = v[i].x; q[1] = v[i].y; q[2] = v[i].z; q[3] = v[i].w; }
    LDS_FENCE();
    const int c = lane & 7;
#pragma unroll
    for (int j = 0; j < 4; ++j) {
        const int n = (lane >> 3) + 8 * j; const float* s = scr + (8 * c) * 33 + n;
        u32x4 o; o.x = pk2(s[0 * 33], s[1 * 33]); o.y = pk2(s[2 * 33], s[3 * 33]); o.z = pk2(s[4 * 33], s[5 * 33]); o.w = pk2(s[6 * 33], s[7 * 33]);
        const int dr = d.drow0 + (n & 15) + (n >> 4) * d.dstep;
        __builtin_nontemporal_store(o, (u32x4*)(d.dst + (size_t)dr * d.ldt + d.k0 + 8 * c));
    }
    LDS_FENCE();
}

constexpr int CV_IN = 16 * 96, CV_OUT = 16 * 32, CV_GU = 65 * 256, CV_D = 65 * 128, CV_TOTAL = CV_IN + CV_OUT + CV_GU + CV_D;

__device__ __forceinline__ CvItem cv_decode(PRef p, int l, int it) {
    bf16* WIN = (bf16*)(p.ws + WS_WIN); bf16* WOUT = (bf16*)(p.ws + WS_WOUT); bf16* WGU = (bf16*)(p.ws + WS_WGU); bf16* WD = (bf16*)(p.ws + WS_WD);
    CvItem d; int r = it;
    if (r < CV_IN) { const int kb = r / 96, nb = r % 96, n0 = 32 * nb;
        d.src = p.in[10] + (size_t)l * D * NIN + n0 + (n0 >= 1536 ? 16 : 0); d.ldw = NIN; d.k0 = 64 * kb; d.dst = WIN; d.ldt = D; d.drow0 = n0; d.dstep = 16; return d; }
    r -= CV_IN;
    if (r < CV_OUT) { const int kb = r / 32, nb = r % 32;
        d.src = p.in[11] + (size_t)l * D * D + 32 * nb; d.ldw = D; d.k0 = 64 * kb; d.dst = WOUT; d.ldt = D; d.drow0 = 32 * nb; d.dstep = 16; return d; }
    r -= CV_OUT;
    if (r < CV_GU) { const int e = r >> 8, rem = r & 255, which = rem >> 7, it2 = rem & 127, kb = it2 >> 3, nb = it2 & 7, hc0 = 32 * nb;
        d.src = ((e < 64) ? (which ? p.in[21] : p.in[20]) + ((size_t)l * 64 + e) * D * DEXP : (which ? p.in[24] : p.in[23]) + (size_t)l * D * DEXP) + hc0;
        d.ldw = DEXP; d.k0 = 64 * kb; d.dst = WGU + (size_t)e * 512 * D; d.ldt = D;
        d.drow0 = 256 * (hc0 >> 7) + 128 * ((hc0 >> 6) & 1) + 32 * ((hc0 >> 4) & 3) + 16 * which; d.dstep = 32; return d; }
    r -= CV_GU;
    { const int e = r >> 7, it2 = r & 127, kb = it2 >> 5, nb = it2 & 31;
        d.src = ((e < 64) ? p.in[22] + ((size_t)l * 64 + e) * DEXP * D : p.in[25] + (size_t)l * DEXP * D) + 32 * nb;
        d.ldw = D; d.k0 = 64 * kb; d.dst = WD + (size_t)e * D * DEXP; d.ldt = DEXP; d.drow0 = 32 * nb; d.dstep = 16; return d; }
}

__device__ __forceinline__ void convert_weights(PRef p, int l, char* lds) {
    const int lane = tid_now() & 63, wave = tid_now() >> 6;
    float* scr = (float*)(lds + wave * 8704);
    const int gw = blockIdx.x * NWAVE + wave, NGW = gridDim.x * NWAVE;
    { bf16* WRH = (bf16*)(p.ws + WS_WRH); bf16* WRL = (bf16*)(p.ws + WS_WRL); const float* wrt = p.in[18] + (size_t)l * D * NEXP;
      for (int i = gw * 64 + lane; i < D * NEXP; i += NGW * 64) { const int k = i >> 6, e = i & 63; const float w = wrt[i]; const unsigned h = f2bf(w);
          WRH[e * D + k] = (bf16)h; WRL[e * D + k] = (bf16)f2bf(w - __builtin_bit_cast(float, h << 16)); } }
    { bf16* WLR = (bf16*)(p.ws + WS_WLR); bf16* GWP = (bf16*)(p.ws + WS_GWP);
      for (int i = gw * 64 + lane; i < 32 * D; i += NGW * 64) { const int n = i >> 10, k = i & 1023;
          WLR[i] = (bf16)(n < 16 ? f2bf(p.in[10][(size_t)l * D * NIN + (size_t)k * NIN + 1536 + n]) : 0u); }
      for (int i = gw * 64 + lane; i < 256 * 16; i += NGW * 64) { const int c = i >> 4, pos = i & 15, n = (pos & 3) | ((pos & 4) << 1) | ((pos & 8) >> 1);
          GWP[i] = (bf16)f2bf(p.in[13][l * 4096 + ((c >> 7) * 16 + n) * 128 + (c & 127)]); } }
    f32x4 va[8], vb[8];
    int it = gw;
    if (it >= CV_TOTAL) return;
    CvItem da = cv_decode(p, l, it), db = da;
    cv_load(da, va, lane);
#pragma unroll 1
    for (;;) {
        const int it1 = it + NGW; const bool more1 = it1 < CV_TOTAL;
        if (more1) { db = cv_decode(p, l, it1); cv_load(db, vb, lane); }
        cv_finish(da, va, scr, lane);
        if (!more1) break;
        const int it2 = it1 + NGW; const bool more2 = it2 < CV_TOTAL;
        if (more2) { da = cv_decode(p, l, it2); cv_load(da, va, lane); }
        cv_finish(db, vb, scr, lane);
        if (!more2) break;
        it = it2;
    }
}

__device__ __forceinline__ void sincos_exact(float ang, float& s, float& c) {
    const double x = (double)ang;
    const double k = rint(x * 0.15915494309189535);
    const double r = x - k * 6.283185307179586476925;
    const double r2 = r * r;
    double ts = r, ss = r, tc = 1.0, cs = 1.0;
#pragma unroll 1
    for (int n = 1; n <= 15; ++n) { ts *= -r2 / (double)((2 * n) * (2 * n + 1)); ss += ts; tc *= -r2 / (double)((2 * n - 1) * (2 * n)); cs += tc; }
    s = (float)ss; c = (float)cs;
}

__device__ __forceinline__ void phase_p0(PRef p, char* lds) {
    const int tid = tid_now();
    {
        float* cond = (float*)lds;
        float* red = (float*)(lds + 12288);
        for (int i = tid; i < 3 * D; i += NTHR) { const int r = i >> 10, k = i & 1023; const float v = (r < 2) ? p.in[1][r * D + k] : p.in[3][k]; cond[i] = silu_f(v); }
        __syncthreads();
        for (int item = blockIdx.x; item < 384; item += gridDim.x) {
            const int l = item / 192, n0 = (item % 192) * 32;
            const int cg = tid & 7, ks = tid >> 3;
            const float* W = p.in[4] + (size_t)l * D * 6144 + n0 + 4 * cg + (size_t)(ks * 16) * 6144;
            f32x4 w[16];
#pragma unroll
            for (int kk = 0; kk < 16; ++kk) w[kk] = *(const f32x4*)(W + (size_t)kk * 6144);
            f32x4 a0 = {0, 0, 0, 0}, a1 = a0, a2 = a0;
#pragma unroll
            for (int kk = 0; kk < 16; ++kk) { const int k = ks * 16 + kk; a0 += w[kk] * cond[k]; a1 += w[kk] * cond[D + k]; a2 += w[kk] * cond[2 * D + k]; }
#pragma unroll
            for (int i = 0; i < 4; ++i) { red[(ks * 3 + 0) * 32 + 4 * cg + i] = a0[i]; red[(ks * 3 + 1) * 32 + 4 * cg + i] = a1[i]; red[(ks * 3 + 2) * 32 + 4 * cg + i] = a2[i]; }
            __syncthreads();
            if (tid < 96) { const int r = tid >> 5, n = tid & 31; float sm = 0.f;
                for (int q = 0; q < 64; ++q) sm += red[(q * 3 + r) * 32 + n];
                ((float*)(p.ws + WS_MODS))[(l * 3 + r) * 6144 + n0 + n] = sm + p.in[5][l * 6144 + n0 + n]; }
            __syncthreads();
        }
    }
    if (blockIdx.x == gridDim.x - 1) {
        float* t8 = (float*)(p.ws + WS_TAB8); float* t16 = (float*)(p.ws + WS_TAB16);
        for (int i = tid; i < 128 * 8 + 128 * 16; i += NTHR) {
            int pos, fi, q; float* dst;
            if (i < 1024) { pos = i >> 3; fi = i & 7; q = 8; dst = t8 + 2 * i; } else { const int j = i - 1024; pos = j >> 4; fi = j & 15; q = 16; dst = t16 + 2 * j; }
            const float freq = (float)exp(-(double)fi / (double)q * 9.210340371976184);
            const float ang = (float)pos * freq; float s, c; sincos_exact(ang, s, c); dst[0] = c; dst[1] = s;
        }
        if (tid < 2) { const int l = tid; const float* lp = p.in[16] + l * 256; float s1 = 0.f, s2 = 0.f;
            for (int i = 0; i < 64; ++i) { s1 += lp[i] * lp[64 + i]; s2 += lp[128 + i] * lp[192 + i]; }
            const float lam_init = 0.8f - 0.6f * expf(-0.3f * (float)l);
            float* sc = (float*)(p.ws + WS_SCAL) + l * 16;
            sc[0] = expf(s1) - expf(s2) + lam_init; sc[1] = lam_init;
            for (int i = 0; i < 8; ++i) sc[2 + i] = logsig_f(p.in[12][l * 8 + i]); }
    }
    __syncthreads();
    convert_weights(p, 0, lds);
}

__device__ __forceinline__ const float* resid_row_ptr(PRef p, int l, int row) {
    const int b = row_b(row), pos = row - b * POSB;
    if (l == 0) return pos < CTX ? p.in[2] + ((size_t)b * CTX + pos) * D : p.in[0] + ((size_t)b * SEQ + pos - CTX) * D;
    return pos < CTX ? (const float*)(p.ws + WS_HCTX) + ((size_t)b * CTX + pos) * D : p.out + ((size_t)b * SEQ + pos - CTX) * D;
}
__device__ __forceinline__ float* resid_row_out(PRef p, int row) {
    const int b = row_b(row), pos = row - b * POSB;
    return pos < CTX ? (float*)(p.ws + WS_HCTX) + ((size_t)b * CTX + pos) * D : p.out + ((size_t)b * SEQ + pos - CTX) * D;
}

__device__ __forceinline__ void phase_a(PRef p, int l, char* lds, const bool st) {
    const int tid = tid_now(), lane = tid & 63, wave = tid >> 6;
    const float* mods = (const float*)(p.ws + WS_MODS) + (size_t)l * 3 * 6144;
    const float* gpre = p.in[6] + l * D;
    bf16* HL = (bf16*)(p.ws + WS_HL);
    for (int row = blockIdx.x * NWAVE + wave; row < R; row += gridDim.x * NWAVE) {
        const int b = row_b(row), pos = row - b * POSB, rt = pos < CTX ? 2 : b;
        const float* xr = resid_row_ptr(p, l, row);
        const float* sh = mods + rt * 6144; const float* sc = sh + D;
        f32x4 v[4]; float ss = 0.f;
#pragma unroll
        for (int j = 0; j < 4; ++j) { v[j] = *(const f32x4*)(xr + 4 * lane + 256 * j); ss += v[j].x * v[j].x + v[j].y * v[j].y + v[j].z * v[j].z + v[j].w * v[j].w; }
        const float rs = rsqrtf(wave_sum(ss) * (1.f / D) + EPS);
#pragma unroll
        for (int j = 0; j < 4; ++j) {
            const int k0 = 4 * lane + 256 * j;
            const f32x4 g = *(const f32x4*)(gpre + k0), s1 = *(const f32x4*)(sc + k0), s0 = *(const f32x4*)(sh + k0);
            const f32x4 h = v[j] * rs * g * (s1 + 1.f) + s0;
            u32x2 o; o.x = pk2(h.x, h.y); o.y = pk2(h.z, h.w);
            if (st) *(u32x2*)(HL + (size_t)row * D + k0) = o;
        }
    }
}

__device__ __forceinline__ float logsig_fast(float x) { return fminf(x, 0.f) - __logf(1.f + __expf(-fabsf(x))); }
__device__ __forceinline__ void lr_tasks(PRef p, int l, int first_blk) {
    if ((int)blockIdx.x < first_blk) return;
    const int tid = tid_now(), lane = tid & 63, wave = tid >> 6, li = lane & 31, hi = lane >> 5;
    const bf16* HL = (const bf16*)(p.ws + WS_HL); float* LA = (float*)(p.ws + WS_LA);
    const bf16* WLR = (const bf16*)(p.ws + WS_WLR); const bf16* GWP = (const bf16*)(p.ws + WS_GWP);
    const float* gb = p.in[14] + l * 256;
    const int nw = ((int)gridDim.x - first_blk) * NWAVE;
    for (int task = ((int)blockIdx.x - first_blk) * NWAVE + wave; task < R / 32; task += nw) {
        const int r0 = task * 32;
        const bf16* ap = WLR + (size_t)li * D + 8 * hi; const bf16* bp = HL + (size_t)(r0 + li) * D + 8 * hi;
        f32x16 lrT = {0};
#pragma unroll 8
        for (int s = 0; s < 64; ++s) lrT = __builtin_amdgcn_mfma_f32_32x32x16_bf16(*(const bf16x8*)(ap + 16 * s), *(const bf16x8*)(bp + 16 * s), lrT, 0, 0, 0);
        u32x4 w; w.x = pk2(lrT[0], lrT[1]); w.y = pk2(lrT[2], lrT[3]); w.z = pk2(lrT[4], lrT[5]); w.w = pk2(lrT[6], lrT[7]);
        const bf16x8 lrb = __builtin_bit_cast(bf16x8, w);
        float* orow = LA + (size_t)(r0 + li) * 256;
#pragma unroll 2
        for (int t = 0; t < 8; ++t) {
            const bf16x8 ga = *(const bf16x8*)(GWP + (size_t)(32 * t + li) * 16 + 8 * hi);
            f32x16 z = {0};
            z = __builtin_amdgcn_mfma_f32_32x32x16_bf16(ga, lrb, z, 0, 0, 0);
#pragma unroll
            for (int a = 0; a < 4; ++a) { const int c = 32 * t + 8 * a + 4 * hi;
                const f32x4 bb = *(const f32x4*)(gb + c);
                f32x4 la; la.x = logsig_fast(z[4 * a] + bb.x) * 0.0625f; la.y = logsig_fast(z[4 * a + 1] + bb.y) * 0.0625f;
                la.z = logsig_fast(z[4 * a + 2] + bb.z) * 0.0625f; la.w = logsig_fast(z[4 * a + 3] + bb.w) * 0.0625f;
                *(f32x4*)(orow + c) = la; }
        }
    }
}

namespace pg8 {
constexpr int BM = 256, BK = 64, HALF = 128, HTB = HALF * BK * 2;
__device__ __forceinline__ int lds_byte(int r, int c) { const int st = (r >> 4) * 2 + (c >> 5), rr = r & 15, cc = c & 31, ob = rr * 64 + cc * 2; return st * 1024 + (ob ^ (((ob >> 9) & 1) << 5)); }
__device__ __forceinline__ void stage_rc(int b, int& R, int& C) { const int st = b / 1024, sb = b % 1024, swz = sb ^ (((sb >> 9) & 1) << 5); R = (st >> 1) * 16 + swz / 64; C = (st & 1) * 32 + (swz % 64) / 2; }
struct Unit { int pm, pn, e, ti; };
typedef f32x4 Acc[2][2][4][2];

template <class Epi, class Sched, bool GATHER>
__device__ __forceinline__ void gemm_phase(LAS unsigned char* lds, const bf16* A, const bf16* Bt, const int K, const Sched& S, const Epi& E) {
    const int tid = tid_now(), wid = __builtin_amdgcn_readfirstlane(tid >> 6), lane = tid & 63, wr = wid >> 2, wc = wid & 3, fr = lane & 15, fq = lane >> 4;
    const int nt = K / BK;
    unsigned voffB[2]; int Rst[2], Cst[2];
#pragma unroll
    for (int i = 0; i < 2; ++i) { int Rr, Cc; stage_rc(tid * 16 + i * 8192, Rr, Cc); Rst[i] = Rr; Cst[i] = Cc; voffB[i] = (unsigned)(Rr * K + Cc) * 2u; }
    const size_t kstep = (size_t)(BK * 2), hstep = (size_t)HALF * K * 2, tstep = 2 * hstep;
    const unsigned ldsw = (unsigned)wid * 1024u;
    const int aoff = lds_byte(wr * 64 + fr, fq * 8), boff = lds_byte(wc * 32 + fr, fq * 8);
#define PG8_SA(b, h) (((b) * 2 + (h)) * HTB)
#define PG8_SB(b, h) ((4 + (b) * 2 + (h)) * HTB)
#define PG8_STAGE(bufoff, gbase, voff) do { _Pragma("unroll") for (int _i = 0; _i < 2; ++_i) \
        __builtin_amdgcn_global_load_lds((const unsigned*)((const char*)(gbase) + (voff)[_i]), (LAS unsigned*)(lds + (bufoff) + ldsw + _i * 8192), 16, 0, 0); } while (0)
#define PG8_LDA(dst, b, h) do { _Pragma("unroll") for (int m = 0; m < 4; ++m) _Pragma("unroll") for (int k = 0; k < 2; ++k) dst[m][k] = *(const LAS bf16x8*)(lds + PG8_SA(b, h) + aoff + m * 2048 + k * 1024); } while (0)
#define PG8_LDB(dst, b, h) do { _Pragma("unroll") for (int n = 0; n < 2; ++n) _Pragma("unroll") for (int k = 0; k < 2; ++k) dst[n][k] = *(const LAS bf16x8*)(lds + PG8_SB(b, h) + boff + n * 2048 + k * 1024); } while (0)
#define PG8_MMA(ai, bj, At, Bt_) do { __builtin_amdgcn_s_setprio(1); _Pragma("unroll") for (int m = 0; m < 4; ++m) _Pragma("unroll") for (int n = 0; n < 2; ++n) _Pragma("unroll") for (int k = 0; k < 2; ++k) \
        acc[ai][bj][m][n] = __builtin_amdgcn_mfma_f32_16x16x32_bf16(Bt_[n][k], At[m][k], acc[ai][bj][m][n], 0, 0, 0); __builtin_amdgcn_s_setprio(0); } while (0)
#define PG8_WAIT_V(n) asm volatile("s_waitcnt vmcnt(" #n ")" ::: "memory")
#define PG8_WAIT_L(n) asm volatile("s_waitcnt lgkmcnt(" #n ")" ::: "memory")
#define PG8_BAR __builtin_amdgcn_s_barrier()
#define PG8_SCHED __builtin_amdgcn_sched_barrier(0)
#define PG8_VA(dst, u) do { _Pragma("unroll") for (int _h = 0; _h < 2; ++_h) _Pragma("unroll") for (int _i = 0; _i < 2; ++_i) \
        dst[_h][_i] = GATHER ? (unsigned)(S.src_row(u, _h * HALF + Rst[_i]) * K + Cst[_i]) * 2u : (unsigned)((_h * HALF + Rst[_i]) * K + Cst[_i]) * 2u; } while (0)
    Unit cur, nxt; int ui = 0;
    if (!S.next(0, cur)) return;
    Acc acc;
#pragma unroll
    for (int a = 0; a < 2; ++a)
#pragma unroll
        for (int b = 0; b < 2; ++b)
#pragma unroll
            for (int m = 0; m < 4; ++m)
#pragma unroll
                for (int n = 0; n < 2; ++n) acc[a][b][m][n] = (f32x4){0.f, 0.f, 0.f, 0.f};
    bf16x8 At[4][2], B0[2][2], B1[2][2];
    unsigned vAc[2][2], vAn[2][2];
    PG8_VA(vAc, cur);
    const char* cA = (const char*)A + (GATHER ? (size_t)0 : (size_t)cur.pm * tstep); const char* cB = (const char*)Bt + (size_t)cur.pn * tstep;
    PG8_STAGE(PG8_SB(0, 0), cB, voffB); PG8_STAGE(PG8_SB(0, 1), cB + hstep, voffB); PG8_STAGE(PG8_SA(0, 0), cA, vAc[0]); PG8_STAGE(PG8_SA(0, 1), cA, vAc[1]);
    if (wr == 1) PG8_BAR;
    PG8_WAIT_V(2); PG8_BAR;
    PG8_STAGE(PG8_SB(1, 0), cB + kstep, voffB); PG8_STAGE(PG8_SA(1, 0), cA + kstep, vAc[0]); PG8_STAGE(PG8_SB(1, 1), cB + hstep + kstep, voffB);
    PG8_WAIT_V(6); PG8_BAR;
    for (;;) {
        const bool has_next = S.next(ui + 1, nxt);
        const char* nA = has_next ? (const char*)A + (GATHER ? (size_t)0 : (size_t)nxt.pm * tstep) : cA; const char* nB = has_next ? (const char*)Bt + (size_t)nxt.pn * tstep : cB;
        if (GATHER) { if (has_next) PG8_VA(vAn, nxt); else { vAn[0][0] = vAc[0][0]; vAn[0][1] = vAc[0][1]; vAn[1][0] = vAc[1][0]; vAn[1][1] = vAc[1][1]; } }
#pragma unroll 1
        for (int t = 0; t < nt; t += 2) {
            const bool last = (t == nt - 2);
            const char* a1 = cA + (size_t)(t + 1) * kstep;
            const char* a2 = last ? nA : cA + (size_t)(t + 2) * kstep; const char* b2 = last ? nB : cB + (size_t)(t + 2) * kstep;
            const char* a3 = a2 + kstep; const char* b3 = b2 + kstep;
            PG8_LDB(B0, 0, 0); PG8_LDB(B1, 0, 1); PG8_SCHED; PG8_LDA(At, 0, 0); PG8_STAGE(PG8_SA(1, 1), a1, vAc[1]);
            if (GATHER && last) { vAc[0][0] = vAn[0][0]; vAc[0][1] = vAn[0][1]; vAc[1][0] = vAn[1][0]; vAc[1][1] = vAn[1][1]; }
            PG8_WAIT_V(8); PG8_WAIT_L(0); PG8_BAR; PG8_MMA(0, 0, At, B0); PG8_MMA(0, 1, At, B1); PG8_BAR; PG8_SCHED;
            PG8_LDA(At, 0, 1); PG8_STAGE(PG8_SB(0, 0), b2, voffB); PG8_STAGE(PG8_SB(0, 1), b2 + hstep, voffB); PG8_STAGE(PG8_SA(0, 0), a2, vAc[0]);
            PG8_WAIT_V(8); PG8_WAIT_L(0); PG8_BAR; PG8_MMA(1, 0, At, B0); PG8_MMA(1, 1, At, B1); PG8_BAR; PG8_SCHED;
            PG8_LDB(B0, 1, 0); PG8_LDB(B1, 1, 1); PG8_SCHED; PG8_LDA(At, 1, 0); PG8_STAGE(PG8_SA(0, 1), a2, vAc[1]);
            PG8_WAIT_V(8); PG8_WAIT_L(0); PG8_BAR; PG8_MMA(0, 0, At, B0); PG8_MMA(0, 1, At, B1); PG8_BAR; PG8_SCHED;
            PG8_LDA(At, 1, 1); PG8_STAGE(PG8_SB(1, 0), b3, voffB); PG8_STAGE(PG8_SB(1, 1), b3 + hstep, voffB); PG8_STAGE(PG8_SA(1, 0), a3, vAc[0]);
            PG8_WAIT_V(8); PG8_WAIT_L(0); PG8_BAR; PG8_MMA(1, 0, At, B0); PG8_MMA(1, 1, At, B1); PG8_BAR; PG8_SCHED;
        }
        if (wr == 0) PG8_BAR;
        { unsigned long long g_t0 = PROBE_SUB == 31 ? __builtin_amdgcn_s_memrealtime() : 0ull;
          E(acc, cur, wr, wc, fr, fq);
          if (PROBE_SUB == 31) { asm volatile("s_waitcnt vmcnt(0)" ::: "memory"); const unsigned long long _t = __builtin_amdgcn_s_memrealtime(); if (tid == 0) *(volatile unsigned long long*)((char*)lds + LDS_MISC + 128) += _t - g_t0; } }
        if (!has_next) break;
#pragma unroll
        for (int a = 0; a < 2; ++a)
#pragma unroll
            for (int b = 0; b < 2; ++b)
#pragma unroll
                for (int m = 0; m < 4; ++m)
#pragma unroll
                    for (int n = 0; n < 2; ++n) acc[a][b][m][n] = (f32x4){0.f, 0.f, 0.f, 0.f};
        cur = nxt; cA = nA; cB = nB; ++ui;
        if (wr == 1) PG8_BAR;
    }
    PG8_WAIT_V(0);
    PG8_BAR;
#undef PG8_SA
#undef PG8_SB
#undef PG8_STAGE
#undef PG8_LDA
#undef PG8_LDB
#undef PG8_MMA
#undef PG8_WAIT_V
#undef PG8_WAIT_L
#undef PG8_BAR
#undef PG8_SCHED
#undef PG8_VA
}
}

__device__ __forceinline__ u32x4 pair16(const u32x2 o0, const u32x2 o1, const int fq, int& coloff) {
    const bool odd = fq & 1;
    const u32x2 send = odd ? o0 : o1, keep = odd ? o1 : o0;
    u32x2 got; got.x = (unsigned)__shfl_xor((int)send.x, 16); got.y = (unsigned)__shfl_xor((int)send.y, 16);
    coloff = (odd ? 16 : 0) + 4 * (fq & 2);
    return odd ? (u32x4){got.x, got.y, keep.x, keep.y} : (u32x4){keep.x, keep.y, got.x, got.y};
}
struct EpiInProj {
    bf16* P; const float* tab8; const float* tab16;
    __device__ __forceinline__ void operator()(pg8::Acc& acc, const pg8::Unit& u, int wr, int wc, int fr, int fq) const {
        const int row0 = u.pm * 256;
        const bool lat = (u.pm % 33) != 0;
#pragma unroll
        for (int bj = 0; bj < 2; ++bj) {
            const int c32 = u.pn * 8 + bj * 4 + wc, cb = c32 * 32;
            int kind = 0;
            float scale = 1.f;
            if (c32 < 8) { kind = 1; if (c32 >= 4) scale = 0.17677669529663687f; }
            else if (c32 >= 16 && c32 < 24) kind = 3;
            else if (c32 >= 24 && c32 < 28) scale = 0.17677669529663687f;
            else if (c32 >= 40 && c32 < 48) kind = 3;
            else if (c32 >= 48 && c32 < 80) { kind = 2; if (c32 < 64) scale = 0.18033688011112042f; }
#pragma unroll
            for (int ai = 0; ai < 2; ++ai)
#pragma unroll
                for (int m = 0; m < 4; ++m) {
                    const int row = row0 + 128 * ai + 64 * wr + 16 * m + fr;
                    const int pos = row >= POSB ? row - POSB : row, t = pos - CTX, prow = (t >> 6) & 127, pcol = t & 63;
                    f32x4 v0 = acc[ai][bj][m][0], v1 = acc[ai][bj][m][1];
                    if (kind == 1) {
                        if (lat) {
#pragma unroll
                            for (int n = 0; n < 2; ++n) {
                                const int pp = n ? pcol : prow;
                                const float* tb = tab8 + (pp * 8 + 4 * (fq & 1)) * 2;
                                const f32x4 t0 = *(const f32x4*)tb, t1 = *(const f32x4*)(tb + 4);
                                const float cs[4] = {t0.x, t0.z, t1.x, t1.z}, sn[4] = {t0.y, t0.w, t1.y, t1.w};
                                f32x4& v = n ? v1 : v0;
#pragma unroll
                                for (int i = 0; i < 4; ++i) { const float me = v[i], other = __shfl_xor(me, 32);
                                    v[i] = (fq < 2) ? me * cs[i] - other * sn[i] : other * sn[i] + me * cs[i]; }
                            }
                        }
                    } else if (kind == 2) {
                        if (lat) {
                            const int pp = (c32 & 1) ? pcol : prow;
                            const float* tb = tab16 + (pp * 16 + 4 * fq) * 2;
                            const f32x4 t0 = *(const f32x4*)tb, t1 = *(const f32x4*)(tb + 4);
                            const float cs[4] = {t0.x, t0.z, t1.x, t1.z}, sn[4] = {t0.y, t0.w, t1.y, t1.w};
#pragma unroll
                            for (int i = 0; i < 4; ++i) { const float a0 = v0[i], a1 = v1[i]; v0[i] = a0 * cs[i] - a1 * sn[i]; v1[i] = a0 * sn[i] + a1 * cs[i]; }
                        }
                    } else if (kind == 3) {
#pragma unroll
                        for (int i = 0; i < 4; ++i) { v0[i] = silu_f(v0[i]); v1[i] = silu_f(v1[i]); }
                    }
                    u32x2 o0, o1; o0.x = pk2(v0.x * scale, v0.y * scale); o0.y = pk2(v0.z * scale, v0.w * scale); o1.x = pk2(v1.x * scale, v1.y * scale); o1.y = pk2(v1.z * scale, v1.w * scale);
                    int co; const u32x4 o16 = pair16(o0, o1, fq, co);
                    *(u32x4*)(P + (size_t)row * NP + cb + co) = o16;
                }
        }
    }
};
struct EpiF32 {
    float* O; int ldo;
    __device__ __forceinline__ void operator()(pg8::Acc& acc, const pg8::Unit& u, int wr, int wc, int fr, int fq) const {
#pragma unroll
        for (int ai = 0; ai < 2; ++ai)
#pragma unroll
            for (int m = 0; m < 4; ++m) { float* rp = O + (size_t)(u.pm * 256 + 128 * ai + 64 * wr + 16 * m + fr) * ldo + (u.pn & 3) * 256 + 32 * wc + 4 * fq;
#pragma unroll
                for (int bj = 0; bj < 2; ++bj)
#pragma unroll
                    for (int n = 0; n < 2; ++n) *(f32x4*)(rp + 128 * bj + 16 * n) = acc[ai][bj][m][n]; }
    }
};
struct EpiBf16 {
    bf16* O; int ldo;
    __device__ __forceinline__ void operator()(pg8::Acc& acc, const pg8::Unit& u, int wr, int wc, int fr, int fq) const {
#pragma unroll
        for (int ai = 0; ai < 2; ++ai)
#pragma unroll
            for (int m = 0; m < 4; ++m) { bf16* rp0 = O + (size_t)(u.pm * 256 + 128 * ai + 64 * wr + 16 * m + fr) * ldo + (u.pn & 3) * 256 + 32 * wc;
#pragma unroll
                for (int bj = 0; bj < 2; ++bj) { const f32x4 v0 = acc[ai][bj][m][0], v1 = acc[ai][bj][m][1];
                    u32x2 o0, o1; o0.x = pk2(v0.x, v0.y); o0.y = pk2(v0.z, v0.w); o1.x = pk2(v1.x, v1.y); o1.y = pk2(v1.z, v1.w);
                    int co; const u32x4 o16 = pair16(o0, o1, fq, co);
                    *(u32x4*)(rp0 + 128 * bj + co) = o16; } }
    }
};
struct EpiFp8 {
    unsigned char* O;
    __device__ __forceinline__ void operator()(pg8::Acc& acc, const pg8::Unit& u, int wr, int wc, int fr, int fq) const {
        const int lane = fr + 16 * fq;
#pragma unroll
        for (int ai = 0; ai < 2; ++ai)
#pragma unroll
            for (int m = 0; m < 4; ++m) {
                unsigned wd[4];
#pragma unroll
                for (int q = 0; q < 4; ++q) { f32x4 v = acc[ai][q >> 1][m][q & 1] * 32.f;
#pragma unroll
                    for (int i = 0; i < 4; ++i) v[i] = fminf(fmaxf(v[i], -440.f), 440.f);
                    int w = 0; w = __builtin_amdgcn_cvt_pk_fp8_f32(v.x, v.y, w, false); w = __builtin_amdgcn_cvt_pk_fp8_f32(v.z, v.w, w, true); wd[q] = (unsigned)w; }
                unsigned ow[4];
#pragma unroll
                for (int s_ = 0; s_ < 4; ++s_) {
                    const int give = (fq - s_) & 3;
                    const unsigned val = give == 0 ? wd[0] : give == 1 ? wd[1] : give == 2 ? wd[2] : wd[3];
                    const int src = (fq + s_) & 3;
                    const unsigned got = (unsigned)__shfl((int)val, fr + 16 * src);
                    if (src == 0) ow[0] = got; if (src == 1) ow[1] = got; if (src == 2) ow[2] = got; if (src == 3) ow[3] = got;
                }
                unsigned char* rp = O + (size_t)(u.pm * 256 + 128 * ai + 64 * wr + 16 * m + fr) * D + (u.pn & 3) * 256 + 32 * wc + 128 * (fq >> 1) + 16 * (fq & 1);
                *(u32x4*)rp = (u32x4){ow[0], ow[1], ow[2], ow[3]};
                (void)lane;
            }
    }
};
struct EpiGateUp {
    bf16* H;
    __device__ __forceinline__ void operator()(pg8::Acc& acc, const pg8::Unit& u, int wr, int wc, int fr, int fq) const {
#pragma unroll
        for (int ai = 0; ai < 2; ++ai)
#pragma unroll
            for (int m = 0; m < 4; ++m) { bf16* rp = H + (size_t)(u.pm * 256 + 128 * ai + 64 * wr + 16 * m + fr) * DEXP + 128 * (u.pn & 1) + 16 * wc;
                u32x2 o[2];
#pragma unroll
                for (int bj = 0; bj < 2; ++bj) { const f32x4 g = acc[ai][bj][m][0], uu = acc[ai][bj][m][1];
                    o[bj].x = pk2(silu_f(g.x) * uu.x, silu_f(g.y) * uu.y); o[bj].y = pk2(silu_f(g.z) * uu.z, silu_f(g.w) * uu.w); }
                int co; const u32x4 o16 = pair16(o[0], o[1], fq, co);
                *(u32x4*)(rp + (co & 8) + ((co & 16) ? 64 : 0)) = o16; }
    }
};

__device__ __forceinline__ int virt_block() { const int G = (int)gridDim.x, bx = (int)blockIdx.x; return (G % 8 == 0) ? (bx % 8) * (G / 8) + bx / 8 : bx; }
struct DenseSched {
    int nM, nN, nunits, skipctx;
    __device__ __forceinline__ bool next(int i, pg8::Unit& u) const {
        const int L = i * (int)gridDim.x + (int)blockIdx.x; if (L >= nunits) return false;
        int wgid = L; { const int q = nunits / 8, r = nunits % 8, xcd = wgid % 8, off = wgid / 8; wgid = (xcd < r ? xcd * (q + 1) : r * (q + 1) + (xcd - r) * q) + off; }
        const int nig = 8 * nN, gid = wgid / nig, fm = gid * 8, gsz = (nM - fm) < 8 ? (nM - fm) : 8;
        int pm = fm + ((wgid % nig) % gsz); u.pn = (wgid % nig) / gsz;
        if (skipctx) pm = pm + 1 + (pm >= 32 ? 1 : 0); u.pm = pm; u.e = 0; u.ti = 0; return true;
    }
    __device__ __forceinline__ int src_row(const pg8::Unit&, int) const { return 0; }
};
__device__ __forceinline__ void phase_b(PRef p, int l, char* lds) {
    DenseSched S{66, 12, 66 * 12, 0};
    EpiInProj E{(bf16*)(p.ws + WS_P), (const float*)(p.ws + WS_TAB8), (const float*)(p.ws + WS_TAB16)};
    pg8::gemm_phase<EpiInProj, DenseSched, false>((LAS unsigned char*)lds, (const bf16*)(p.ws + WS_HL), (const bf16*)(p.ws + WS_WIN), D, S, E);
    lr_tasks(p, l, (66 * 12) % (int)gridDim.x);
}

constexpr int L_BF = 0;
constexpr int L_BS = 16896;
constexpr int L_SEG = 33792;
constexpr int L_A = 36864;
constexpr int LO_QF = 36864;
constexpr int LO_KF = LO_QF + 10240;
constexpr int LO_QB = LO_KF + 10240;
constexpr int LO_KB = LO_QB + 10240;
constexpr int LO_QI = LO_KB + 10240;
constexpr int LO_ST = LO_QI + 18432;
constexpr int LO_VT = LO_ST + 9216;
constexpr int LO_W = 0;
constexpr int LO_SS = LO_VT + 17408;
static_assert(34816 <= L_A, "W overlay");
static_assert(LO_SS + 1024 <= LDS_MISC, "lin LDS");

#define GSTAMP(k) do { if (PROBE_SUB) { const unsigned long long _t = __builtin_amdgcn_s_memrealtime(); if (PROBE_SUB == (k) && tid_now() == 0) *(volatile unsigned long long*)(lds + LDS_MISC + 128) += _t - g_t0; g_t0 = _t; } } while (0)
struct LinCfg { int type; int qcol, kcol, vcol, gcol, ocol; };

__device__ __forceinline__ void lin_prefix(PRef p, int l, int type, int h, int r0, bool already, char* lds, const bool st = true) {
    const int tid = tid_now();
    float* bf = (float*)(lds + L_BF); float* bs = (float*)(lds + L_BS); float* seg = (float*)(lds + L_SEG);
    if (type == 0) {
        const float* sc = (const float*)(p.ws + WS_SCAL) + l * 16;
        const float lgf = sc[2 + h], lgb = sc[6 + h];
        for (int i = tid; i < 128 * 32; i += NTHR) { const int j = i >> 5, kk = i & 31; bf[j * 33 + kk] = (float)(j + 1) * lgf; bs[j * 33 + kk] = (float)(128 - j) * lgb; }
        __syncthreads();
        return;
    }
    float* LA = (float*)(p.ws + WS_LA);
    if (already) {
        for (int i = tid; i < 128 * 32; i += NTHR) { const int j = i >> 5, kk = i & 31; const float* s = LA + (size_t)(r0 + j) * 256 + h * 32 + kk; bf[j * 33 + kk] = s[0]; bs[j * 33 + kk] = s[128]; }
        __syncthreads();
        return;
    }
    for (int i = tid; i < 128 * 32; i += NTHR) { const int j = i >> 5, kk = i & 31; const float* s = LA + (size_t)(r0 + j) * 256 + h * 32 + kk; bf[j * 33 + kk] = s[0]; bs[j * 33 + kk] = s[128]; }
    __syncthreads();
    const int chain = tid & 63, sg = tid >> 6, dir = chain >> 5, kk = chain & 31;
    float* arr = dir ? bs : bf;
    float tot = 0.f;
    for (int q = 0; q < 16; ++q) tot += arr[(sg * 16 + q) * 33 + kk];
    seg[chain * 8 + sg] = tot;
    __syncthreads();
    float off = 0.f;
    if (dir == 0) { for (int q = 0; q < sg; ++q) off += seg[chain * 8 + q];
        for (int q = 0; q < 16; ++q) { const int j = sg * 16 + q; off += arr[j * 33 + kk]; arr[j * 33 + kk] = off; } }
    else { for (int q = 7; q > sg; --q) off += seg[chain * 8 + q];
        for (int q = 15; q >= 0; --q) { const int j = sg * 16 + q; off += arr[j * 33 + kk]; arr[j * 33 + kk] = off; } }
    __syncthreads();
    if (st) for (int i = tid; i < 128 * 32; i += NTHR) { const int j = i >> 5, k2 = i & 31; float* s = LA + (size_t)(r0 + j) * 256 + h * 32 + k2; s[0] = bf[j * 33 + k2]; s[128] = bs[j * 33 + k2]; }
}

__device__ __forceinline__ LinCfg lin_cfg(int type, int h) {
    LinCfg c; c.type = type;
    if (type == 0) { c.qcol = h * 32; c.kcol = 128 + h * 32; c.vcol = 256 + h * 64; c.gcol = 512 + h * 64; c.ocol = h * 64; }
    else { c.qcol = 768 + h * 32; c.kcol = 896 + h * 32; c.vcol = 1024 + h * 64; c.gcol = 1280 + h * 64; c.ocol = 256 + h * 64; }
    return c;
}
__device__ __forceinline__ size_t us_index(int b, int h, int type, int dir, int c) { return ((((size_t)(b * 4 + h) * 2 + type) * 2 + dir) * NCH + c) * 2048; }

__device__ __forceinline__ void lin_u_item(PRef p, int l, int item, char* lds, const bool st) {
    unsigned long long g_t0 = PROBE_SUB ? __builtin_amdgcn_s_memrealtime() : 0ull;
    const int tid = tid_now();
    const int type = item & 1, h = (item >> 1) & 3, b = (item >> 3) & 1, c = item >> 4;
    const LinCfg cf = lin_cfg(type, h);
    const int r0 = b * POSB + c * 128;
    const bf16* P = (const bf16*)(p.ws + WS_P);
    const u32x4 kv4 = *(const u32x4*)(P + (size_t)(r0 + (tid >> 2)) * NP + cf.kcol + 8 * (tid & 3));
    u32x4 vpre[2];
#pragma unroll
    for (int i = 0; i < 2; ++i) { const int q = tid + 512 * i; vpre[i] = *(const u32x4*)(P + (size_t)(r0 + (q >> 3)) * NP + cf.vcol + 8 * (q & 7)); }
    lin_prefix(p, l, type, h, r0, false, lds, st);
    GSTAMP(12);
    const float* bf = (const float*)(lds + L_BF); const float* bs = (const float*)(lds + L_BS);
    bf16* kut = (bf16*)(lds + L_A);
    bf16* vt = kut + 2 * 32 * 136;
    { const int j = tid >> 2, c = tid & 3;
      const unsigned kw[4] = {kv4.x, kv4.y, kv4.z, kv4.w};
#pragma unroll
      for (int e = 0; e < 8; ++e) { const int kk = 8 * c + e; const float kv = (e & 1) ? bfhi(kw[e >> 1]) : bflo(kw[e >> 1]);
          kut[kk * 136 + j] = (bf16)f2bf(kv * __expf(bf[127 * 33 + kk] - bf[j * 33 + kk]));
          kut[(32 + kk) * 136 + j] = (bf16)f2bf(kv * __expf(bs[0 * 33 + kk] - bs[j * 33 + kk])); } }
#pragma unroll
    for (int i = 0; i < 2; ++i) { const int q = tid + 512 * i, j = q >> 3, c = q & 7;
        const unsigned vw[4] = {vpre[i].x, vpre[i].y, vpre[i].z, vpre[i].w};
#pragma unroll
        for (int e = 0; e < 4; ++e) { vt[(8 * c + 2 * e) * 136 + j] = (bf16)(vw[e] & 0xffff); vt[(8 * c + 2 * e + 1) * 136 + j] = (bf16)(vw[e] >> 16); } }
    if (st && type == 1 && tid < 64) { const int dir = tid >> 5, kk = tid & 31;
        ((float*)(p.ws + WS_DEC))[(((size_t)(b * 4 + h) * 2 + dir) * NCH + c) * 32 + kk] = __expf(dir ? bs[kk] : bf[127 * 33 + kk]); }
    __syncthreads();
    GSTAMP(13);
    { const int lane = tid & 63, wid = tid >> 6, li = lane & 31, hi = lane >> 5;
      if (wid < 4) {
          const int dir = wid >> 1, bd = wid & 1;
          f32x16 u = {0};
#pragma unroll
          for (int s = 0; s < 8; ++s) {
              const bf16x8 ka = *(const bf16x8*)(kut + (dir * 32 + li) * 136 + 16 * s + 8 * hi), vb = *(const bf16x8*)(vt + (bd * 32 + li) * 136 + 16 * s + 8 * hi);
              u = __builtin_amdgcn_mfma_f32_32x32x16_bf16(ka, vb, u, 0, 0, 0);
          }
          float* U = (float*)(p.ws + WS_US) + us_index(b, h, type, dir, c) + bd * 32 + li;
          if (st) {
#pragma unroll
              for (int r = 0; r < 16; ++r) U[((r & 3) + 8 * (r >> 2) + 4 * hi) * 64] = u[r]; }
      } }
    __syncthreads();
    GSTAMP(14);
}

__device__ __forceinline__ void vt_item(PRef p, int l, int item, char* lds, const bool st) {
    unsigned long long g_t0 = PROBE_SUB ? __builtin_amdgcn_s_memrealtime() : 0ull;
    const int tid = tid_now();
    const int g64 = item % 132, h = (item / 132) & 3, b = item / 528;
    const bf16* P = (const bf16*)(p.ws + WS_P); bf16* VT = (bf16*)(p.ws + WS_VT);
    bf16* t = (bf16*)lds;
#pragma unroll
    for (int i = 0; i < 2; ++i) { const int q = tid + 512 * i, j = q >> 4, ch = q & 15;
        const u32x4 v = *(const u32x4*)(P + (size_t)(b * POSB + g64 * 64 + j) * NP + 2560 + h * 128 + ch * 8);
        const int jp = (j & ~12) | ((j & 4) << 1) | ((j & 8) >> 1);
        const unsigned w[4] = {v.x, v.y, v.z, v.w};
#pragma unroll
        for (int e = 0; e < 4; ++e) { t[(ch * 8 + 2 * e) * 72 + jp] = (bf16)(w[e] & 0xffff); t[(ch * 8 + 2 * e + 1) * 72 + jp] = (bf16)(w[e] >> 16); } }
    { const int key = tid >> 3, part = tid & 7;
      const bf16* kr = P + (size_t)(b * POSB + g64 * 64 + key) * NP + 2048 + h * 128 + part * 8;
      const u32x4 k0 = *(const u32x4*)kr, k1 = *(const u32x4*)(kr + 64);
      const unsigned w0[4] = {k0.x, k0.y, k0.z, k0.w}, w1[4] = {k1.x, k1.y, k1.z, k1.w};
      float s0 = 0.f, s1 = 0.f;
#pragma unroll
      for (int e = 0; e < 4; ++e) { s0 += bflo(w0[e]) * bflo(w0[e]) + bfhi(w0[e]) * bfhi(w0[e]); s1 += bflo(w1[e]) * bflo(w1[e]) + bfhi(w1[e]) * bfhi(w1[e]); }
      s0 += __shfl_xor(s0, 1); s0 += __shfl_xor(s0, 2); s0 += __shfl_xor(s0, 4); s1 += __shfl_xor(s1, 1); s1 += __shfl_xor(s1, 2); s1 += __shfl_xor(s1, 4);
      s0 = wave_max(s0); s1 = wave_max(s1);
      float* kred = (float*)(lds + 32768);
      if ((tid & 63) == 0) { kred[(tid >> 6) * 2] = s0; kred[(tid >> 6) * 2 + 1] = s1; } }
    __syncthreads();
    if (st && tid < 2) { const float* kred = (const float*)(lds + 32768); float mxk = kred[tid];
        for (int w = 1; w < 8; ++w) mxk = fmaxf(mxk, kred[2 * w + tid]);
        atomicMax((unsigned*)(p.ws + WS_CTL) + CW_KMAX + (((l * 2 + b) * 4 + h) * 2 + tid) * 64, __builtin_bit_cast(unsigned, mxk)); }
#pragma unroll
    for (int i = 0; i < 2; ++i) { const int q = tid + 512 * i, dv = q >> 3, ch = q & 7;
        if (st) *(u32x4*)(VT + ((size_t)(b * 4 + h) * 128 + dv) * POSB + g64 * 64 + ch * 8) = *(const u32x4*)(t + dv * 72 + ch * 8); }
    __syncthreads();
    GSTAMP(11);
}

__device__ __forceinline__ void phase_c(PRef p, int l, char* lds, const bool st) {
    constexpr int NU = NCH * 16, NV = 2 * 4 * 132;
    for (int it = blockIdx.x; it < NU + NV; it += gridDim.x) {
        if (it < NV) vt_item(p, l, it, lds, st);
        else { const int u = it - NV, c = u % NCH, rest = u / NCH; lin_u_item(p, l, (c << 4) | rest, lds, st); }
    }
}

__device__ __forceinline__ void phase_d(PRef p, int l, const bool st) {
    const int gt = blockIdx.x * NTHR + tid_now();
    if (gt >= 32 * 2048) return;
    const int e = gt & 2047, chain = gt >> 11;
    const int dir = chain & 1, type = (chain >> 1) & 1, h = (chain >> 2) & 3, b = chain >> 4;
    float* U = (float*)(p.ws + WS_US) + (size_t)chain * NCH * 2048 + e;
    const float* DEC = (const float*)(p.ws + WS_DEC) + ((size_t)(b * 4 + h) * 2 + dir) * NCH * 32 + (e >> 6);
    const float* sc = (const float*)(p.ws + WS_SCAL) + l * 16;
    const float dret = __expf(128.f * sc[2 + dir * 4 + h]);
    float S = 0.f;
#pragma unroll 1
    for (int s0 = 0; s0 < NCH; s0 += 22) {
        float u[22], dd[22];
#pragma unroll
        for (int q = 0; q < 22; ++q) { const int s = s0 + q, c = dir == 0 ? s : (s < 2 ? 1 - s : 67 - s); u[q] = U[(size_t)c * 2048]; dd[q] = type ? DEC[c * 32] : dret; }
#pragma unroll
        for (int q = 0; q < 22; ++q) { const int s = s0 + q, c = dir == 0 ? s : (s < 2 ? 1 - s : 67 - s); if (st) U[(size_t)c * 2048] = S; S = dd[q] * S + u[q]; }
        if (!st && S == 12345.678f) U[0] = S;
    }
}

__device__ __forceinline__ void lin_out_item(PRef p, int l, int item, char* lds) {
    unsigned long long g_t0 = PROBE_SUB ? __builtin_amdgcn_s_memrealtime() : 0ull;
    const int tid = tid_now(), lane = tid & 63, wid = tid >> 6;
    const int type = item & 1, h = (item >> 1) & 3, b = (item >> 3) & 1, c = item >> 4;
    const LinCfg cf = lin_cfg(type, h);
    const int r0 = b * POSB + c * 128;
    lin_prefix(p, l, type, h, r0, true, lds);
    GSTAMP(21);
    const float* bf = (const float*)(lds + L_BF); const float* bs = (const float*)(lds + L_BS);
    bf16* qf = (bf16*)(lds + LO_QF); bf16* kf = (bf16*)(lds + LO_KF); bf16* qb = (bf16*)(lds + LO_QB); bf16* kb = (bf16*)(lds + LO_KB);
    bf16* qi = (bf16*)(lds + LO_QI); bf16* st = (bf16*)(lds + LO_ST); bf16* vt = (bf16*)(lds + LO_VT); bf16* W = (bf16*)(lds + LO_W);
    float* ssq = (float*)(lds + LO_SS);
    const bf16* P = (const bf16*)(p.ws + WS_P);
    { const int j = tid >> 2, c = tid & 3;
      const u32x4 q4 = *(const u32x4*)(P + (size_t)(r0 + j) * NP + cf.qcol + 8 * c), k4 = *(const u32x4*)(P + (size_t)(r0 + j) * NP + cf.kcol + 8 * c);
      const unsigned qw[4] = {q4.x, q4.y, q4.z, q4.w}, kw[4] = {k4.x, k4.y, k4.z, k4.w};
      unsigned oqf[4], okf[4], oqb[4], okb[4], oqi[4], oqj[4];
#pragma unroll
      for (int e2 = 0; e2 < 4; ++e2) {
          float vqf[2], vkf[2], vqb[2], vkb[2], vqi[2], vqj[2];
#pragma unroll
          for (int z = 0; z < 2; ++z) { const int kk = 8 * c + 2 * e2 + z;
              const float qv = z ? bfhi(qw[e2]) : bflo(qw[e2]), kv = z ? bfhi(kw[e2]) : bflo(kw[e2]);
              const float f = bf[j * 33 + kk], fm = bf[63 * 33 + kk], sx = bs[j * 33 + kk], sm = bs[64 * 33 + kk];
              vqf[z] = qv * __expf(f - fm); vkf[z] = kv * __expf(fm - f); vqb[z] = qv * __expf(sx - sm); vkb[z] = kv * __expf(sm - sx);
              vqi[z] = qv * __expf(f); vqj[z] = qv * __expf(sx); }
          oqf[e2] = pk2(vqf[0], vqf[1]); okf[e2] = pk2(vkf[0], vkf[1]); oqb[e2] = pk2(vqb[0], vqb[1]); okb[e2] = pk2(vkb[0], vkb[1]);
          oqi[e2] = pk2(vqi[0], vqi[1]); oqj[e2] = pk2(vqj[0], vqj[1]); }
      *(u32x4*)(qf + j * 40 + 8 * c) = (u32x4){oqf[0], oqf[1], oqf[2], oqf[3]}; *(u32x4*)(kf + j * 40 + 8 * c) = (u32x4){okf[0], okf[1], okf[2], okf[3]};
      *(u32x4*)(qb + j * 40 + 8 * c) = (u32x4){oqb[0], oqb[1], oqb[2], oqb[3]}; *(u32x4*)(kb + j * 40 + 8 * c) = (u32x4){okb[0], okb[1], okb[2], okb[3]};
      *(u32x4*)(qi + j * 72 + 8 * c) = (u32x4){oqi[0], oqi[1], oqi[2], oqi[3]}; *(u32x4*)(qi + j * 72 + 32 + 8 * c) = (u32x4){oqj[0], oqj[1], oqj[2], oqj[3]}; }
#pragma unroll
    for (int i = 0; i < 2; ++i) { const int q = tid + 512 * i, j = q >> 3, c = q & 7;
        const u32x4 v4 = *(const u32x4*)(P + (size_t)(r0 + j) * NP + cf.vcol + 8 * c);
        const unsigned vw[4] = {v4.x, v4.y, v4.z, v4.w};
#pragma unroll
        for (int e = 0; e < 4; ++e) { vt[(8 * c + 2 * e) * 136 + j] = (bf16)(vw[e] & 0xffff); vt[(8 * c + 2 * e + 1) * 136 + j] = (bf16)(vw[e] >> 16); } }
    { const float* Sf = (const float*)(p.ws + WS_US) + us_index(b, h, type, 0, c); const float* Sb = (const float*)(p.ws + WS_US) + us_index(b, h, type, 1, c);
      const f32x4 sf4 = *(const f32x4*)(Sf + 4 * tid), sb4 = *(const f32x4*)(Sb + 4 * tid);
      const int kk = (4 * tid) >> 6, dv = (4 * tid) & 63;
#pragma unroll
      for (int e = 0; e < 4; ++e) { st[(dv + e) * 72 + kk] = (bf16)f2bf(sf4[e]); st[(dv + e) * 72 + 32 + kk] = (bf16)f2bf(sb4[e]); } }
    __syncthreads();
    GSTAMP(22);
    const int li = lane & 31, hi = lane >> 5;
    {
        const int bi = wid >> 1;
#pragma unroll
        for (int jj = 0; jj < 2; ++jj) {
            const int bj = (wid & 1) * 2 + jj;
            f32x16 af = {0}, ab = {0};
#pragma unroll
            for (int s = 0; s < 2; ++s) {
                const bf16x8 kfa = *(const bf16x8*)(kf + (bj * 32 + li) * 40 + 16 * s + 8 * hi), qfb = *(const bf16x8*)(qf + (bi * 32 + li) * 40 + 16 * s + 8 * hi);
                const bf16x8 kba = *(const bf16x8*)(kb + (bj * 32 + li) * 40 + 16 * s + 8 * hi), qbb = *(const bf16x8*)(qb + (bi * 32 + li) * 40 + 16 * s + 8 * hi);
                af = __builtin_amdgcn_mfma_f32_32x32x16_bf16(kfa, qfb, af, 0, 0, 0);
                ab = __builtin_amdgcn_mfma_f32_32x32x16_bf16(kba, qbb, ab, 0, 0, 0);
            }
            const int i = bi * 32 + li;
#pragma unroll
            for (int a = 0; a < 4; ++a) {
                float w[4];
#pragma unroll
                for (int q = 0; q < 4; ++q) { const int j = bj * 32 + 8 * a + 4 * hi + q; w[q] = (i >= j ? af[4 * a + q] : 0.f) + (j >= i ? ab[4 * a + q] : 0.f); }
                u32x2 o; o.x = pk2(w[0], w[1]); o.y = pk2(w[2], w[3]);
                *(u32x2*)(W + i * 136 + bj * 32 + 8 * a + 4 * hi) = o;
            }
        }
    }
    __syncthreads();
    GSTAMP(23);
    const int bi = wid >> 1, bd = wid & 1;
    f32x16 o = {0};
#pragma unroll
    for (int s = 0; s < 8; ++s) {
        const bf16x8 va = *(const bf16x8*)(vt + (bd * 32 + li) * 136 + 16 * s + 8 * hi), wb = *(const bf16x8*)(W + (bi * 32 + li) * 136 + 16 * s + 8 * hi);
        o = __builtin_amdgcn_mfma_f32_32x32x16_bf16(va, wb, o, 0, 0, 0);
    }
#pragma unroll
    for (int s = 0; s < 4; ++s) {
        const bf16x8 sa = *(const bf16x8*)(st + (bd * 32 + li) * 72 + 16 * s + 8 * hi), qq = *(const bf16x8*)(qi + (bi * 32 + li) * 72 + 16 * s + 8 * hi);
        o = __builtin_amdgcn_mfma_f32_32x32x16_bf16(sa, qq, o, 0, 0, 0);
    }
    float ss = 0.f;
#pragma unroll
    for (int r = 0; r < 16; ++r) ss += o[r] * o[r];
    ss += __shfl_xor(ss, 32);
    const int tok = bi * 32 + li;
    if (hi == 0) ssq[tok * 2 + bd] = ss;
    __syncthreads();
    const bool need = (l == 0) || (c >= 2);
    if (need) {
        const float rn = rsqrtf((ssq[tok * 2] + ssq[tok * 2 + 1]) * (1.f / 64.f) + EPS);
        bf16* CAT = (bf16*)(p.ws + WS_CAT);
        const float* gg = p.in[15] + l * 64;
#pragma unroll
        for (int a = 0; a < 4; ++a) {
            const int dv = bd * 32 + 8 * a + 4 * hi;
            const u32x2 gt = *(const u32x2*)(P + (size_t)(r0 + tok) * NP + cf.gcol + dv);
            f32x4 g4 = {1.f, 1.f, 1.f, 1.f};
            if (type == 1) g4 = *(const f32x4*)(gg + dv);
            u32x2 ov; ov.x = pk2(o[4 * a] * rn * g4.x * bflo(gt.x), o[4 * a + 1] * rn * g4.y * bfhi(gt.x));
            ov.y = pk2(o[4 * a + 2] * rn * g4.z * bflo(gt.y), o[4 * a + 3] * rn * g4.w * bfhi(gt.y));
            *(u32x2*)(CAT + (size_t)(r0 + tok) * D + cf.ocol + dv) = ov;
        }
    }
    __syncthreads();
    GSTAMP(24);
}

constexpr int AT_STAGE = 32768, AT_K0 = 0, AT_K1 = 8192, AT_V = 16384, AT_X = 0;
#ifndef ATT_SETPRIO
#define ATT_SETPRIO 0
#endif
#define AT_PRIO(x) do { if (ATT_SETPRIO) __builtin_amdgcn_s_setprio(x); } while (0)
#define AT_SB() __builtin_amdgcn_sched_barrier(0)
#define AT_LDK(kfv, Kl) do { _Pragma("unroll") for (int kb = 0; kb < 2; ++kb) _Pragma("unroll") for (int s_ = 0; s_ < 4; ++s_) { const int krow = kb * 32 + qi; \
        kfv[kb][s_] = *(const bf16x8*)((Kl) + krow * 128 + (((2 * s_ + hi) ^ ((krow >> 1) & 7)) << 4)); } } while (0)
#define AT_LDV(vfv, Vl, t) do { const int vrow = 32 * (t) + qi; _Pragma("unroll") for (int c_ = 0; c_ < 4; ++c_) \
        vfv[c_] = *(const bf16x8*)((Vl) + vrow * 128 + (((2 * c_ + hi) ^ ((vrow >> 1) & 7)) << 4)); } while (0)
#define AT_QKM(sTv, kfv) do { AT_PRIO(1); \
        sTv[0] = __builtin_amdgcn_mfma_f32_32x32x16_bf16(kfv[0][0], qf[0], negm, 0, 0, 0); sTv[1] = __builtin_amdgcn_mfma_f32_32x32x16_bf16(kfv[1][0], qf[0], negm, 0, 0, 0); \
        _Pragma("unroll") for (int s_ = 1; s_ < 4; ++s_) { sTv[0] = __builtin_amdgcn_mfma_f32_32x32x16_bf16(kfv[0][s_], qf[s_], sTv[0], 0, 0, 0); \
            sTv[1] = __builtin_amdgcn_mfma_f32_32x32x16_bf16(kfv[1][s_], qf[s_], sTv[1], 0, 0, 0); } \
        AT_PRIO(0); } while (0)
#define AT_SOFTMAX(sTv, pfv) do { float _ls = 0.f; \
        _Pragma("unroll") for (int kb = 0; kb < 2; ++kb) _Pragma("unroll") for (int r = 0; r < 16; ++r) { const float pv = __builtin_amdgcn_exp2f(sTv[kb][r]); sTv[kb][r] = pv; _ls += pv; } \
        lrun += _ls; \
        _Pragma("unroll") for (int kb = 0; kb < 2; ++kb) _Pragma("unroll") for (int ks = 0; ks < 2; ++ks) { \
            u32x4 w; w.x = pk2(sTv[kb][8 * ks + 0], sTv[kb][8 * ks + 1]); w.y = pk2(sTv[kb][8 * ks + 2], sTv[kb][8 * ks + 3]); \
            w.z = pk2(sTv[kb][8 * ks + 4], sTv[kb][8 * ks + 5]); w.w = pk2(sTv[kb][8 * ks + 6], sTv[kb][8 * ks + 7]); pfv[kb][ks] = __builtin_bit_cast(bf16x8, w); } } while (0)
#define AT_PVM(pfv, vfv, t) do { AT_PRIO(1); \
        _Pragma("unroll") for (int c_ = 0; c_ < 4; ++c_) oacc[t] = __builtin_amdgcn_mfma_f32_32x32x16_bf16(vfv[c_], pfv[c_ >> 1][c_ & 1], oacc[t], 0, 0, 0); \
        AT_PRIO(0); } while (0)
__device__ __forceinline__ void attn_finish(PRef p, int l, int b, int h, int qpos0, char* lds, f32x16 (&oacc)[4], const float inv);
__device__ __forceinline__ void attn_unit(PRef p, int l, int b, int h, int qpos0, int nkeys, char* lds) {
    const int tid = tid_now(), lane = tid & 63, wid = __builtin_amdgcn_readfirstlane(tid >> 6), m = wid >> 2, qr = (wid & 3) * 32, qi = lane & 31, hi = lane >> 5;
    const bf16* P = (const bf16*)(p.ws + WS_P); const bf16* VT = (const bf16*)(p.ws + WS_VT);
    const size_t rowb = (size_t)b * POSB;
    LAS unsigned char* l3 = (LAS unsigned char*)lds;
    const bf16* gbase = wid < 4 ? P + rowb * NP + 2048 + h * 128 : VT + (size_t)(b * 4 + h) * 128 * POSB;
    const unsigned ginc = wid < 4 ? 64u * NP : 64u;
    unsigned go[4]; unsigned ldst[4];
#pragma unroll
    for (int j = 0; j < 4; ++j) {
        const int g = wid * 4 + j;
        const int r = 8 * (g & 7) + (g >= 16 ? 64 * ((g >> 3) & 1) : 0) + (lane >> 3);
        const int c = (lane & 7) ^ ((r >> 1) & 7);
        if (g < 16) { go[j] = (unsigned)r * NP + (g >> 3) * 64 + c * 8; ldst[j] = (g < 8 ? AT_K0 : AT_K1) + (8 * (g & 7)) * 128; }
        else { go[j] = (unsigned)r * POSB + c * 8; ldst[j] = AT_V + (8 * (g & 7) + 64 * ((g >> 3) & 1)) * 128; }
    }
#define AT_ISSUE(stage, kt) do { const bf16* _gb = gbase + (size_t)(kt) * ginc; _Pragma("unroll") for (int _j = 0; _j < 4; ++_j) \
        __builtin_amdgcn_global_load_lds((const unsigned*)(_gb + go[_j]), (LAS unsigned*)(l3 + (stage) * AT_STAGE + ldst[_j]), 16, 0, 0); } while (0)
    bf16x8 qf[4]; float q2 = 0.f;
    { const bf16* qp = P + (rowb + qpos0 + qr + qi) * NP + 1536 + h * 128 + m * 64 + 8 * hi;
#pragma unroll
      for (int s = 0; s < 4; ++s) { const u32x4 w = *(const u32x4*)(qp + 16 * s); qf[s] = __builtin_bit_cast(bf16x8, w);
          q2 += bflo(w.x) * bflo(w.x) + bfhi(w.x) * bfhi(w.x) + bflo(w.y) * bflo(w.y) + bfhi(w.y) * bfhi(w.y) + bflo(w.z) * bflo(w.z) + bfhi(w.z) * bfhi(w.z) + bflo(w.w) * bflo(w.w) + bfhi(w.w) * bfhi(w.w); } }
    q2 += __shfl_xor(q2, 32);
    const float k2 = __builtin_bit_cast(float, __hip_atomic_load((const unsigned*)(p.ws + WS_CTL) + CW_KMAX + (((l * 2 + b) * 4 + h) * 2 + m) * 64, __ATOMIC_RELAXED, __HIP_MEMORY_SCOPE_AGENT));
    const float mq = sqrtf(q2 * k2) * 1.002f + 1e-6f;
    f32x16 negm;
#pragma unroll
    for (int r = 0; r < 16; ++r) negm[r] = -mq;
    asm volatile("" : "+v"(negm));
    asm volatile("s_waitcnt vmcnt(0)" ::: "memory");
    const int nt = nkeys >> 6;
    AT_ISSUE(0, 0);
    if (nt > 1) AT_ISSUE(1, 1);
    f32x16 oacc[4];
#pragma unroll
    for (int t = 0; t < 4; ++t) oacc[t] = (f32x16){0};
    float lrun = 0.f;
    bf16x8 pf[2][2];
#pragma unroll
    for (int i = 0; i < 2; ++i)
#pragma unroll
        for (int j = 0; j < 2; ++j) pf[i][j] = (bf16x8){0, 0, 0, 0, 0, 0, 0, 0};
    int stage = 0;
#pragma unroll 1
    for (int kt = 0; kt < nt; ++kt) {
        if (kt + 1 < nt) asm volatile("s_waitcnt vmcnt(4)" ::: "memory"); else asm volatile("s_waitcnt vmcnt(0)" ::: "memory");
        __builtin_amdgcn_s_barrier();
        if (kt + 2 < nt) AT_ISSUE((stage + 2) & 3, kt + 2);
        const char* Kl = lds + stage * AT_STAGE + (m ? AT_K1 : AT_K0);
        f32x16 sT[2]; bf16x8 kf[2][4];
        {
            const char* Vc = lds + stage * AT_STAGE + AT_V;
            bf16x8 va[4], vb[4];
            AT_LDK(kf, Kl); AT_SB();
            AT_QKM(sT, kf); AT_SB();
            AT_LDV(va, Vc, 0); AT_LDV(vb, Vc, 1); AT_SB();
            AT_SOFTMAX(sT, pf); AT_SB();
            AT_PVM(pf, va, 0); AT_SB(); AT_LDV(va, Vc, 2); AT_SB(); AT_PVM(pf, vb, 1); AT_SB(); AT_LDV(vb, Vc, 3); AT_SB(); AT_PVM(pf, va, 2); AT_SB(); AT_PVM(pf, vb, 3); AT_SB();
        }
        stage = (stage + 1) & 3;
    }
#undef AT_ISSUE
    const float ltot = lrun + __shfl_xor(lrun, 32);
    const float inv = 1.f / ltot;
    __syncthreads();
    return attn_finish(p, l, b, h, qpos0, lds, oacc, inv);
}
__device__ __forceinline__ void attn_finish(PRef p, int l, int b, int h, int qpos0, char* lds, f32x16 (&oacc)[4], const float inv) {
    const int tid = tid_now(), lane = tid & 63, wid = __builtin_amdgcn_readfirstlane(tid >> 6), m = wid >> 2, qr = (wid & 3) * 32, qi = lane & 31, hi = lane >> 5;
    const size_t rowb = (size_t)b * POSB;
    float* X = (float*)(lds + AT_X) + (wid & 3) * 4096;
    if (m == 1) {
#pragma unroll
        for (int t = 0; t < 4; ++t)
#pragma unroll
            for (int r = 0; r < 16; ++r) X[(t * 16 + r) * 64 + lane] = oacc[t][r] * inv;
    }
    __syncthreads();
    if (m == 0) {
        const float* sc = (const float*)(p.ws + WS_SCAL) + l * 16;
        const float lam = sc[0], post = 1.f - sc[1];
        float ss = 0.f;
#pragma unroll
        for (int t = 0; t < 4; ++t)
#pragma unroll
            for (int r = 0; r < 16; ++r) { const float v = oacc[t][r] * inv - lam * X[(t * 16 + r) * 64 + lane]; oacc[t][r] = v; ss += v * v; }
        ss += __shfl_xor(ss, 32);
        const float rn = rsqrtf(ss * (1.f / 128.f) + EPS) * post;
        bf16* CAT = (bf16*)(p.ws + WS_CAT) + (rowb + qpos0 + qr + qi) * D + 512 + h * 128;
        const float* dg = p.in[17] + l * 128;
#pragma unroll
        for (int t = 0; t < 4; ++t)
#pragma unroll
            for (int a = 0; a < 4; ++a) {
                const int dv = 32 * t + 8 * a + 4 * hi;
                const f32x4 g4 = *(const f32x4*)(dg + dv);
                u32x2 ov; ov.x = pk2(oacc[t][4 * a] * rn * g4.x, oacc[t][4 * a + 1] * rn * g4.y); ov.y = pk2(oacc[t][4 * a + 2] * rn * g4.z, oacc[t][4 * a + 3] * rn * g4.w);
                *(u32x2*)(CAT + dv) = ov;
            }
    }
    __syncthreads();
}

__device__ __forceinline__ void phase_e(PRef p, int l, char* lds) {
    const int n_att = 512 + (l == 0 ? 16 : 0);
    const int n_lin = NCH * 16;
    for (int it = blockIdx.x; it < n_att + n_lin; it += gridDim.x) {
        if (it < 512) { const int bh = it & 7, qb = it >> 3; attn_unit(p, l, bh >> 2, bh & 3, CTX + qb * 128, POSB, lds); }
        else if (it < n_att) { const int u = it - 512, bh = u & 7, qb = u >> 3; attn_unit(p, l, bh >> 2, bh & 3, qb * 128, CTX, lds); }
        else { const int item = it - n_att; if (l == 0 || (item >> 4) >= 2) lin_out_item(p, l, item, lds); }
    }
}

__device__ __forceinline__ void phase_f(PRef p, int l, char* lds) {
    DenseSched S{(l == 0) ? 66 : 64, 4, ((l == 0) ? 66 : 64) * 4, l != 0};
    EpiBf16 E{(bf16*)(p.ws + WS_MO), D};
    pg8::gemm_phase<EpiBf16, DenseSched, false>((LAS unsigned char*)lds, (const bf16*)(p.ws + WS_CAT), (const bf16*)(p.ws + WS_WOUT), D, S, E);
}

__device__ __forceinline__ int ffn_row(int l, int idx) {
    if (l == 0) return idx;
    const int b = idx >> 13, t = idx & 8191; return b * POSB + CTX + t;
}
constexpr int GR_STRIDE = 2064, GR_HI = 0, GR_LO = 32 * GR_STRIDE, GR_LG = 64 * GR_STRIDE;
constexpr int GR_HIST = GR_LG + 8192, GR_BASE = GR_HIST + 256, GR_PAIR = GR_BASE + 256;
static_assert(GR_PAIR + 2048 <= LDS_MISC, "router LDS");
__device__ __forceinline__ void phase_g(PRef p, int l, char* lds, const bool st) {
    unsigned long long g_t0 = PROBE_SUB ? __builtin_amdgcn_s_memrealtime() : 0ull;
    const int tid = tid_now(), lane = tid & 63, wave = __builtin_amdgcn_readfirstlane(tid >> 6);
    const int ntok = (l == 0) ? R : BATCH * SEQ;
    const float* mods = (const float*)(p.ws + WS_MODS) + (size_t)l * 3 * 6144;
    const float* gpost = p.in[7] + l * D; const float* gpre = p.in[8] + l * D;
    const float bias = p.in[19][l * NEXP + lane];
    const bf16* MO = (const bf16*)(p.ws + WS_MO); bf16* HL = (bf16*)(p.ws + WS_HL);
    const bf16* WRH = (const bf16*)(p.ws + WS_WRH); const bf16* WRL = (const bf16*)(p.ws + WS_WRL);
    float* LG = (float*)(lds + GR_LG);
    unsigned* cnt = (unsigned*)(p.ws + WS_CTL) + CW_CNT + l * 4096;
    int* rowtok = (int*)(p.ws + WS_ROWTOK); int* pslot = (int*)(p.ws + WS_PSLOT); float* pw = (float*)(p.ws + WS_PW);
    int* hist = (int*)(lds + GR_HIST); int* base = (int*)(lds + GR_BASE); int* pair_i = (int*)(lds + GR_PAIR); float* pair_w = (float*)(lds + GR_PAIR + 1024);
    for (int g0 = blockIdx.x * 32; g0 < ntok; g0 += gridDim.x * 32) {
#pragma unroll 1
        for (int hf = 0; hf < 2; ++hf) {
            const float* gpost_ = gpost; const float* gpre_ = gpre; asm volatile("" : "+s"(gpost_), "+s"(gpre_));
            f32x4 mv[2][4], xv[2][4];
            int rowv[2]; const float* mdv[2];
#pragma unroll
            for (int rr = 0; rr < 2; ++rr) {
                const int row = ffn_row(l, g0 + 4 * wave + 2 * hf + rr); rowv[rr] = row;
                const int b = row_b(row), pos = row - b * POSB, rt = pos < CTX ? 2 : b; mdv[rr] = mods + rt * 6144;
                const float* xr = resid_row_ptr(p, l, row); const bf16* mr = MO + (size_t)row * D;
#pragma unroll
                for (int j = 0; j < 4; ++j) { const u32x2 mb = *(const u32x2*)(mr + 4 * lane + 256 * j); mv[rr][j] = (f32x4){bflo(mb.x), bfhi(mb.x), bflo(mb.y), bfhi(mb.y)}; xv[rr][j] = *(const f32x4*)(xr + 4 * lane + 256 * j); }
            }
            f32x4 gp4[4], gq4[4];
#pragma unroll
            for (int j = 0; j < 4; ++j) { gp4[j] = *(const f32x4*)(gpost_ + 4 * lane + 256 * j); gq4[j] = *(const f32x4*)(gpre_ + 4 * lane + 256 * j); }
            float ss[2], ss2[2];
#pragma unroll
            for (int rr = 0; rr < 2; ++rr) { ss[rr] = 0.f;
#pragma unroll
                for (int j = 0; j < 4; ++j) ss[rr] += mv[rr][j].x * mv[rr][j].x + mv[rr][j].y * mv[rr][j].y + mv[rr][j].z * mv[rr][j].z + mv[rr][j].w * mv[rr][j].w; }
#pragma unroll
            for (int o = 1; o < 64; o <<= 1) {
#pragma unroll
                for (int rr = 0; rr < 2; ++rr) ss[rr] += __shfl_xor(ss[rr], o); }
#pragma unroll
            for (int rr = 0; rr < 2; ++rr) {
                const float* md = mdv[rr]; float* xo = resid_row_out(p, rowv[rr]);
                const float r1 = rsqrtf(ss[rr] * (1.f / D) + EPS);
                ss2[rr] = 0.f;
#pragma unroll
                for (int j = 0; j < 4; ++j) { const int k0 = 4 * lane + 256 * j;
                    const f32x4 gt = *(const f32x4*)(md + 2 * D + k0);
                    xv[rr][j] = xv[rr][j] + gt * (mv[rr][j] * r1 * gp4[j]);
                    if (st) *(f32x4*)(xo + k0) = xv[rr][j];
                    ss2[rr] += xv[rr][j].x * xv[rr][j].x + xv[rr][j].y * xv[rr][j].y + xv[rr][j].z * xv[rr][j].z + xv[rr][j].w * xv[rr][j].w; }
            }
#pragma unroll
            for (int o = 1; o < 64; o <<= 1) {
#pragma unroll
                for (int rr = 0; rr < 2; ++rr) ss2[rr] += __shfl_xor(ss2[rr], o); }
#pragma unroll
            for (int rr = 0; rr < 2; ++rr) {
                const int lr = 4 * wave + 2 * hf + rr;
                const int row = rowv[rr];
                const float* md = mdv[rr];
                const float r2 = rsqrtf(ss2[rr] * (1.f / D) + EPS);
#pragma unroll
                for (int j = 0; j < 4; ++j) { const int k0 = 4 * lane + 256 * j;
                    const f32x4 s1 = *(const f32x4*)(md + 4 * D + k0), s0 = *(const f32x4*)(md + 3 * D + k0);
                    const f32x4 hv = xv[rr][j] * r2 * gq4[j] * (s1 + 1.f) + s0;
                    unsigned hb[4], lb[4];
#pragma unroll
                    for (int i = 0; i < 4; ++i) { hb[i] = f2bf(hv[i]); lb[i] = f2bf(hv[i] - __builtin_bit_cast(float, hb[i] << 16)); }
                    u32x2 oh; oh.x = hb[0] | (hb[1] << 16); oh.y = hb[2] | (hb[3] << 16);
                    u32x2 ol; ol.x = lb[0] | (lb[1] << 16); ol.y = lb[2] | (lb[3] << 16);
                    if (st) *(u32x2*)(HL + (size_t)row * D + k0) = oh;
                    *(u32x2*)(lds + GR_HI + lr * GR_STRIDE + 2 * k0) = oh;
                    *(u32x2*)(lds + GR_LO + lr * GR_STRIDE + 2 * k0) = ol; }
            }
        }
        if (tid < 64) hist[tid] = 0;
        __syncthreads();
        GSTAMP(1);
        {
            const int et = wave & 3, tt = wave >> 2, fr = lane & 15, fq = lane >> 4;
            const bf16* wh = WRH + (size_t)(et * 16 + fr) * D + 8 * fq; const bf16* wl = WRL + (size_t)(et * 16 + fr) * D + 8 * fq;
            const char* hh = lds + GR_HI + (tt * 16 + fr) * GR_STRIDE + 16 * fq; const char* hl2 = lds + GR_LO + (tt * 16 + fr) * GR_STRIDE + 16 * fq;
            f32x4 acc = {0.f, 0.f, 0.f, 0.f};
#pragma unroll 1
            for (int s0 = 0; s0 < 32; s0 += 8) {
                bf16x8 whi[8], wlo[8];
#pragma unroll
                for (int i = 0; i < 8; ++i) { whi[i] = *(const bf16x8*)(wh + 32 * (s0 + i)); wlo[i] = *(const bf16x8*)(wl + 32 * (s0 + i)); }
                __builtin_amdgcn_sched_barrier(0);
#pragma unroll
                for (int i = 0; i < 8; ++i) {
                    const bf16x8 hhi = *(const bf16x8*)(hh + 64 * (s0 + i)), hlo = *(const bf16x8*)(hl2 + 64 * (s0 + i));
                    acc = __builtin_amdgcn_mfma_f32_16x16x32_bf16(whi[i], hhi, acc, 0, 0, 0);
                    acc = __builtin_amdgcn_mfma_f32_16x16x32_bf16(whi[i], hlo, acc, 0, 0, 0);
                    acc = __builtin_amdgcn_mfma_f32_16x16x32_bf16(wlo[i], hhi, acc, 0, 0, 0);
                }
                __builtin_amdgcn_sched_barrier(0);
            }
            *(f32x4*)(LG + (tt * 16 + fr) * 64 + et * 16 + 4 * fq) = acc;
        }
        __syncthreads();
        GSTAMP(2);
#pragma unroll
        for (int rr = 0; rr < 4; ++rr) {
            const int lr = 4 * wave + rr;
            const int row = ffn_row(l, g0 + lr);
            const float score = 1.f / (1.f + __expf(-LG[lr * 64 + lane]));
            const float sel = score + bias;
            const int grp = lane >> 3;
            float m1 = sel; m1 = fmaxf(m1, __shfl_xor(m1, 1)); m1 = fmaxf(m1, __shfl_xor(m1, 2)); m1 = fmaxf(m1, __shfl_xor(m1, 4));
            const unsigned long long bm = __ballot(sel == m1);
            const int first = __builtin_ctz((unsigned)((bm >> (8 * grp)) & 0xffull)) + 8 * grp;
            float m2 = (lane == first) ? -INFINITY : sel; m2 = fmaxf(m2, __shfl_xor(m2, 1)); m2 = fmaxf(m2, __shfl_xor(m2, 2)); m2 = fmaxf(m2, __shfl_xor(m2, 4));
            const float gs = m1 + m2;
            int rank = 0;
#pragma unroll
            for (int g2 = 0; g2 < 8; ++g2) { const float o = __shfl(gs, 8 * g2); rank += (o > gs || (o == gs && g2 < grp)) ? 1 : 0; }
            float mv = rank < 4 ? sel : -INFINITY;
            float wsum = 0.f; float myw = 0.f; int mye = 0;
#pragma unroll
            for (int k = 0; k < 6; ++k) {
                const float mx = wave_max(mv);
                const unsigned long long b2 = __ballot(mv == mx);
                const int e = __builtin_ctzll(b2);
                const float sce = __shfl(score, e);
                wsum += sce;
                if (lane == k) { myw = sce; mye = e; }
                if (lane == e) mv = -INFINITY;
            }
            if (lane < 6) { const int lrk = atomicAdd(hist + mye, 1); pair_i[lr * 8 + lane] = (mye << 16) | lrk; pair_w[lr * 8 + lane] = myw / wsum * 2.5f; }
        }
        __syncthreads();
        GSTAMP(3);
        if (st && tid < 64) { const int hc = hist[tid]; if (hc > 0) base[tid] = (int)atomicAdd(cnt + tid * 64, (unsigned)hc); }
        __syncthreads();
        if (st && tid < 192) { const int lr = tid / 6, k = tid - lr * 6; const int row = ffn_row(l, g0 + lr);
            const int pi = pair_i[lr * 8 + k], e = pi >> 16, rk = base[e] + (pi & 0xffff);
            rowtok[e * CAP + rk] = row; pslot[row * 8 + k] = (e << 16) | rk; pw[row * 8 + k] = pair_w[lr * 8 + k]; }
        GSTAMP(4);
    }
}

constexpr int M_TBL = 133120;
__device__ __forceinline__ void moe_table(PRef p, int l, char* lds) {
    int* tb = (int*)(lds + M_TBL);
    const unsigned* cnt = (const unsigned*)(p.ws + WS_CTL) + CW_CNT + l * 4096;
    if (tid_now() == 0) {
        int acc = 0;
        for (int e = 0; e < 65; ++e) { const int c = e < 64 ? (int)__hip_atomic_load(cnt + e * 64, __ATOMIC_RELAXED, __HIP_MEMORY_SCOPE_AGENT) : (l == 0 ? R : BATCH * SEQ);
            tb[e] = acc; tb[128 + e] = c; acc += (c + 255) >> 8; }
        tb[65] = acc;
    }
    __syncthreads();
}
__device__ __forceinline__ int moe_find(const int* tb, int tile) { int e = 0; while (e < 64 && tile >= tb[e + 1]) ++e; return e; }

struct MoeSched {
    const int* tb; const int* rowtok; int nsub, nunits, l;
    __device__ __forceinline__ bool next(int i, pg8::Unit& u) const {
        const int L = i * (int)gridDim.x + virt_block(); if (L >= nunits) return false;
        const int tile = L / nsub, sub = L - tile * nsub, e = moe_find(tb, tile);
        u.pm = tile; u.pn = e * nsub + sub; u.e = e; u.ti = tile - tb[e]; return true;
    }
    __device__ __forceinline__ int src_row(const pg8::Unit& u, int r) const {
        const int idx = u.ti * 256 + r; if (idx >= tb[128 + u.e]) return 0;
        return u.e < 64 ? rowtok[u.e * CAP + idx] : ffn_row(l, idx);
    }
};
__device__ __forceinline__ void phase_h(PRef p, int l, char* lds) {
    moe_table(p, l, lds);
    const int* tb = (const int*)(lds + M_TBL);
    MoeSched S{tb, (const int*)(p.ws + WS_ROWTOK), 2, tb[65] * 2, l};
    EpiGateUp E{(bf16*)(p.ws + WS_HB)};
    pg8::gemm_phase<EpiGateUp, MoeSched, true>((LAS unsigned char*)lds, (const bf16*)(p.ws + WS_HL), (const bf16*)(p.ws + WS_WGU), D, S, E);
}
__device__ __forceinline__ void phase_i(PRef p, int l, char* lds) {
    moe_table(p, l, lds);
    const int* tb = (const int*)(lds + M_TBL);
    MoeSched S{tb, (const int*)(p.ws + WS_ROWTOK), 4, tb[65] * 4, l};
    EpiFp8 E{(unsigned char*)(p.ws + WS_Y)};
    pg8::gemm_phase<EpiFp8, MoeSched, false>((LAS unsigned char*)lds, (const bf16*)(p.ws + WS_HB), (const bf16*)(p.ws + WS_WD), DEXP, S, E);
}
__device__ __forceinline__ void phase_j(PRef p, int l, char* lds, const bool st) {
    moe_table(p, l, lds);
    const int* tb = (const int*)(lds + M_TBL);
    const int tid = tid_now(), lane = tid & 63, wave = tid >> 6;
    const int ntok = (l == 0) ? R : BATCH * SEQ;
    const float* mods = (const float*)(p.ws + WS_MODS) + (size_t)l * 3 * 6144;
    const float* gpost = p.in[9] + l * D;
    const unsigned char* Y = (const unsigned char*)(p.ws + WS_Y);
    const int* pslot = (const int*)(p.ws + WS_PSLOT); const float* pw = (const float*)(p.ws + WS_PW);
    const int wstride = (int)gridDim.x * NWAVE;
    for (int base = blockIdx.x * NWAVE + wave; base < ntok; base += 2 * wstride) {
        int idx[2]; bool ok[2]; idx[0] = base; idx[1] = base + wstride; ok[0] = true; ok[1] = idx[1] < ntok; if (!ok[1]) idx[1] = idx[0];
        int ps[2][6]; float pwv[2][6]; int rowv[2];
#pragma unroll
        for (int tk = 0; tk < 2; ++tk) { rowv[tk] = ffn_row(l, idx[tk]);
#pragma unroll
            for (int k = 0; k < 6; ++k) { ps[tk][k] = pslot[rowv[tk] * 8 + k]; pwv[tk][k] = pw[rowv[tk] * 8 + k]; } }
        f32x4 f[2][4];
#pragma unroll
        for (int tk = 0; tk < 2; ++tk) { const unsigned char* yr = Y + ((size_t)tb[64] * 256 + idx[tk]) * D;
#pragma unroll
            for (int j = 0; j < 4; ++j) { const int v = *(const int*)(yr + 4 * lane + 256 * j);
                const f32x2_t lo = __builtin_amdgcn_cvt_pk_f32_fp8(v, false), hi2 = __builtin_amdgcn_cvt_pk_f32_fp8(v, true);
                f[tk][j] = (f32x4){lo.x, lo.y, hi2.x, hi2.y} * 0.03125f; } }
#pragma unroll
        for (int k = 0; k < 6; ++k) {
#pragma unroll
            for (int tk = 0; tk < 2; ++tk) {
                const int e = ps[tk][k] >> 16, rk = ps[tk][k] & 0xffff; const float w = pwv[tk][k] * 0.03125f;
                const unsigned char* yr = Y + ((size_t)tb[e] * 256 + rk) * D;
#pragma unroll
                for (int j = 0; j < 4; ++j) { const int v = *(const int*)(yr + 4 * lane + 256 * j);
                    const f32x2_t lo = __builtin_amdgcn_cvt_pk_f32_fp8(v, false), hi2 = __builtin_amdgcn_cvt_pk_f32_fp8(v, true);
                    f[tk][j].x += w * lo.x; f[tk][j].y += w * lo.y; f[tk][j].z += w * hi2.x; f[tk][j].w += w * hi2.y; }
            }
        }
        float ss[2];
#pragma unroll
        for (int tk = 0; tk < 2; ++tk) { ss[tk] = 0.f;
#pragma unroll
            for (int j = 0; j < 4; ++j) ss[tk] += f[tk][j].x * f[tk][j].x + f[tk][j].y * f[tk][j].y + f[tk][j].z * f[tk][j].z + f[tk][j].w * f[tk][j].w; }
#pragma unroll
        for (int o = 1; o < 64; o <<= 1) { ss[0] += __shfl_xor(ss[0], o); ss[1] += __shfl_xor(ss[1], o); }
        float s2[2];
#pragma unroll
        for (int tk = 0; tk < 2; ++tk) {
            const int row = rowv[tk];
            const int b = row_b(row), pos = row - b * POSB, rt = pos < CTX ? 2 : b;
            const float* md = mods + rt * 6144;
            float* xo = resid_row_out(p, row);
            const float rn = rsqrtf(ss[tk] * (1.f / D) + EPS);
            s2[tk] = 0.f;
#pragma unroll
            for (int j = 0; j < 4; ++j) { const int k0 = 4 * lane + 256 * j;
                const f32x4 gp = *(const f32x4*)(gpost + k0), gt = *(const f32x4*)(md + 5 * D + k0);
                const f32x4 xv = *(const f32x4*)(xo + k0);
                f[tk][j] = xv + gt * (f[tk][j] * rn * gp);
                if (st && ok[tk]) *(f32x4*)(xo + k0) = f[tk][j];
                s2[tk] += f[tk][j].x * f[tk][j].x + f[tk][j].y * f[tk][j].y + f[tk][j].z * f[tk][j].z + f[tk][j].w * f[tk][j].w; }
        }
        if (l == 0) {
#pragma unroll
            for (int o = 1; o < 64; o <<= 1) { s2[0] += __shfl_xor(s2[0], o); s2[1] += __shfl_xor(s2[1], o); }
            const float* gpre1 = p.in[6] + D; bf16* HL = (bf16*)(p.ws + WS_HL); asm volatile("" : "+s"(gpre1), "+s"(HL));
#pragma unroll
            for (int tk = 0; tk < 2; ++tk) {
                const int row = rowv[tk];
                const int b = row_b(row), pos = row - b * POSB, rt = pos < CTX ? 2 : b;
                const float* md1 = mods + rt * 6144 + 3 * 6144;
                const float rs = rsqrtf(s2[tk] * (1.f / D) + EPS);
#pragma unroll
                for (int j = 0; j < 4; ++j) { const int k0 = 4 * lane + 256 * j;
                    const f32x4 g = *(const f32x4*)(gpre1 + k0), s1 = *(const f32x4*)(md1 + D + k0), s0 = *(const f32x4*)(md1 + k0);
                    const f32x4 h = f[tk][j] * rs * g * (s1 + 1.f) + s0;
                    u32x2 o; o.x = pk2(h.x, h.y); o.y = pk2(h.z, h.w);
                    if (st && ok[tk]) *(u32x2*)(HL + (size_t)row * D + k0) = o; }
            }
        }
    }
    if (st && l == 0) { __syncthreads(); convert_weights(p, 1, lds); }
}

__global__ void __launch_bounds__(NTHR, 2) mk_fwd(Params p_arg) {
    extern __shared__ __attribute__((aligned(16))) unsigned char lds_raw[];
    char* lds = (char*)lds_raw;
    volatile unsigned* misc = (volatile unsigned*)(lds + LDS_MISC);
    if (threadIdx.x < 64) misc[threadIdx.x] = 0u;
    __syncthreads();
    XcdBarrier bar; bar.bar = (unsigned*)(p_arg.ws + WS_CTL) + CW_BAR; bar.x = 0; bar.st = misc;
    const int ph_lo = p_arg.ph_lo, ph_hi = p_arg.ph_hi;
    if (ph_hi - ph_lo > 1) bar = xcd_barrier_post((unsigned*)(p_arg.ws + WS_CTL) + CW_BAR, misc);
#ifndef PROBE_MASK
#define PROBE_MASK 0
#endif
#define PROBE_MULT 2
#ifndef ONLY_PHASE
#define ONLY_PHASE -1
#endif
#define PH_ON(k) (ONLY_PHASE < 0 || ((ONLY_PHASE >> (k)) & 1))
#ifndef DBL_MASK
#define DBL_MASK 0
#endif
    unsigned long long t_prev = PROBE_MASK ? __builtin_amdgcn_s_memrealtime() : 0ull, t_acc = 0ull;
#define KARGS() const __attribute__((address_space(4))) Params* pk = (const __attribute__((address_space(4))) Params*)__builtin_amdgcn_kernarg_segment_ptr(); \
        asm volatile("" : "+s"(pk) :: "memory"); PRef p = *pk
#define RUN(ph, ty, call) do { if (ph_lo <= (ph) && (ph) < ph_hi) { { KARGS(); call; } if ((ph) + 1 < ph_hi) xcd_barrier(bar); \
        if (PROBE_MASK) { const unsigned long long t_now = __builtin_amdgcn_s_memrealtime(); if ((PROBE_MASK >> (ty)) & 1) t_acc += t_now - t_prev; t_prev = t_now; } } } while (0)
    RUN(0, 10, if (PH_ON(0)) phase_p0(p, lds));
    RUN(1, 0, if (PH_ON(1)) phase_a(p, 0, lds, true));
    RUN(2, 1, if (PH_ON(2)) phase_b(p, 0, lds));
    RUN(3, 2, if (PH_ON(3)) phase_c(p, 0, lds, true));
    RUN(4, 3, if (PH_ON(4)) phase_d(p, 0, true));
    RUN(5, 4, if (PH_ON(5)) phase_e(p, 0, lds));
    RUN(6, 5, if (PH_ON(6)) phase_f(p, 0, lds));
    RUN(7, 6, if (PH_ON(7)) phase_g(p, 0, lds, true));
    RUN(8, 7, if (PH_ON(8)) phase_h(p, 0, lds));
    RUN(9, 8, if (PH_ON(9)) phase_i(p, 0, lds));
    RUN(10, 9, if (PH_ON(10)) phase_j(p, 0, lds, true));
    RUN(12, 1, if (PH_ON(2)) phase_b(p, 1, lds));
    RUN(13, 2, if (PH_ON(3)) phase_c(p, 1, lds, true));
    RUN(14, 3, if (PH_ON(4)) phase_d(p, 1, true));
    RUN(15, 4, if (PH_ON(5)) phase_e(p, 1, lds));
    RUN(16, 5, if (PH_ON(6)) phase_f(p, 1, lds));
    RUN(17, 6, if (PH_ON(7)) phase_g(p, 1, lds, true));
    RUN(18, 7, if (PH_ON(8)) phase_h(p, 1, lds));
    RUN(19, 8, if (PH_ON(9)) phase_i(p, 1, lds));
    RUN(20, 9, if (PH_ON(10)) phase_j(p, 1, lds, true));
    if (PROBE_SUB && blockIdx.x == 0) { const unsigned long long acc2 = *(volatile unsigned long long*)(lds + LDS_MISC + 128); const unsigned long long t0 = __builtin_amdgcn_s_memrealtime(); while (__builtin_amdgcn_s_memrealtime() - t0 < 4ull * acc2) __builtin_amdgcn_s_sleep(8); }
    if (PROBE_MASK && blockIdx.x == 0) { const unsigned long long t0 = __builtin_amdgcn_s_memrealtime(); while (__builtin_amdgcn_s_memrealtime() - t0 < PROBE_MULT * t_acc) __builtin_amdgcn_s_sleep(8); }
}
}

extern "C" void kernel_launch(void* const* d_in, const int* in_sizes, int n_in, void* d_out, int out_size, void* d_ws, size_t ws_size, hipStream_t stream) {
    static int grid = 0;
    if (grid == 0) {
        if (n_in != 26 || ws_size < WS_END) { fprintf(stderr, "kernel_launch: unexpected n_in %d / ws_size %zu\n", n_in, ws_size); grid = -1; return; }
        int dev = 0, cus = 0, per_cu = 0;
        (void)hipGetDevice(&dev); (void)hipDeviceGetAttribute(&cus, hipDeviceAttributeMultiprocessorCount, dev);
        (void)hipFuncSetAttribute((const void*)mk_fwd, hipFuncAttributeMaxDynamicSharedMemorySize, LDS_BYTES);
        (void)hipOccupancyMaxActiveBlocksPerMultiprocessor(&per_cu, (const void*)mk_fwd, NTHR, LDS_BYTES);
        (void)hipGetLastError();
        if (per_cu < 1) fprintf(stderr, "kernel_launch: occupancy query says %d blocks per CU\n", per_cu);
        grid = cus;
    }
    if (grid < 0) return;
    (void)hipMemsetAsync((char*)d_ws + WS_CTL, 0, 1 * MiB, stream);
    Params p{};
    for (int i = 0; i < 26; ++i) p.in[i] = (const float*)d_in[i];
    p.out = (float*)d_out; p.ws = (unsigned char*)d_ws;
#if MK_LAUNCHES == 1
    p.ph_lo = 0; p.ph_hi = NPHASE;
    hipLaunchKernelGGL(mk_fwd, dim3(grid), dim3(NTHR), LDS_BYTES, stream, p);
#else
    for (int ph = 0; ph < NPHASE; ++ph) { p.ph_lo = ph; p.ph_hi = ph + 1; hipLaunchKernelGGL(mk_fwd, dim3(grid), dim3(NTHR), LDS_BYTES, stream, p); }
#endif
}
```

```cpp
#include <hip/hip_runtime.h>
#include <cstdio>
#include <cstdint>

#ifndef MK_LAUNCHES
#define MK_LAUNCHES 1
#endif

namespace {
typedef unsigned short bf16;
typedef short bf16x8 __attribute__((ext_vector_type(8)));
typedef float f32x4 __attribute__((ext_vector_type(4)));
typedef float f32x16 __attribute__((ext_vector_type(16)));
typedef unsigned u32x4 __attribute__((ext_vector_type(4)));
typedef unsigned u32x2 __attribute__((ext_vector_type(2)));
#define LAS __attribute__((address_space(3)))

constexpr int D = 1024, BATCH = 2, SEQ = 8192, CTX = 256, POSB = SEQ + CTX  , R = BATCH * POSB  ;
constexpr int NIN = 3088, NP = 3072;
constexpr int NEXP = 64, DEXP = 256, CAP = R;
constexpr int NCH = POSB / 128;
constexpr float EPS = 1e-6f;
constexpr int NTHR = 512, NWAVE = 8;
constexpr int NPHASE = 21;
constexpr int HB_ROWS = 134912;

constexpr size_t MiB = 1u << 20;
constexpr size_t WS_CTL = 0;
constexpr size_t WS_MODS = 1 * MiB;
constexpr size_t WS_TAB8 = WS_MODS + 192 * 1024;
constexpr size_t WS_TAB16 = WS_TAB8 + 8192;
constexpr size_t WS_SCAL = WS_TAB16 + 16384;
constexpr size_t WS_WRH = WS_MODS + 256 * 1024;
constexpr size_t WS_WRL = WS_MODS + 384 * 1024;
constexpr size_t WS_WLR = WS_MODS + 512 * 1024;
constexpr size_t WS_GWP = WS_MODS + 576 * 1024;
constexpr size_t WS_HCTX = 2 * MiB;
constexpr size_t WS_ROWTOK = 4 * MiB;
constexpr size_t WS_PSLOT = 9 * MiB;
constexpr size_t WS_PW = 10 * MiB;
constexpr size_t WS_DEC = 11 * MiB;
constexpr size_t WS_WIN = 12 * MiB;
constexpr size_t WS_WOUT = 18 * MiB;
constexpr size_t WS_WGU = 20 * MiB;
constexpr size_t WS_WD = 85 * MiB;
constexpr size_t WS_HL = 118 * MiB;
constexpr size_t WS_HB = 151 * MiB;
constexpr size_t WS_X = 217 * MiB;
constexpr size_t WS_P = WS_X;
constexpr size_t WS_VT = 316 * MiB;
constexpr size_t WS_US = 333 * MiB;
constexpr size_t WS_CAT = 366 * MiB;
constexpr size_t WS_MO = 399 * MiB;
constexpr size_t WS_LA = 465 * MiB;
constexpr size_t WS_Y = WS_X;
constexpr size_t WS_END = 482 * MiB;
static_assert(WS_Y + (size_t)HB_ROWS * 2048 <= WS_END, "Y fits");
static_assert(WS_HB + (size_t)HB_ROWS * 512 <= WS_X, "HB fits");

constexpr int CW_BAR = 4096;
constexpr int CW_CNT = 16384;
constexpr int CW_KMAX = 32768;

constexpr int LDS_BYTES = 147456;
constexpr int LDS_MISC = 147456 - 256;

struct Params { const float* in[26]; float* out; unsigned char* ws; int ph_lo, ph_hi; };
typedef const __attribute__((address_space(4))) Params& PRef;

__device__ __forceinline__ unsigned f2bf(float f) { unsigned u = __builtin_bit_cast(unsigned, f); return (u + 0x7fffu + ((u >> 16) & 1u)) >> 16; }
typedef float f32x2_t __attribute__((ext_vector_type(2)));
typedef __bf16 bf16x2_t __attribute__((ext_vector_type(2)));
__device__ __forceinline__ unsigned pk2(float lo, float hi) { f32x2_t v = {lo, hi}; bf16x2_t b = __builtin_convertvector(v, bf16x2_t); return __builtin_bit_cast(unsigned, b); }
__device__ __forceinline__ float bf2f(unsigned short b) { return __builtin_bit_cast(float, (unsigned)b << 16); }
__device__ __forceinline__ float bflo(unsigned u) { return __builtin_bit_cast(float, u << 16); }
__device__ __forceinline__ float bfhi(unsigned u) { return __builtin_bit_cast(float, u & 0xffff0000u); }
__device__ __forceinline__ float wave_sum(float v) {
#pragma unroll
    for (int o = 1; o < 64; o <<= 1) v += __shfl_xor(v, o);
    return v;
}
__device__ __forceinline__ float wave_max(float v) {
#pragma unroll
    for (int o = 1; o < 64; o <<= 1) v = fmaxf(v, __shfl_xor(v, o));
    return v;
}
__device__ __forceinline__ float silu_f(float x) { return x / (1.f + __expf(-x)); }
__device__ __forceinline__ float logsig_f(float x) { return fminf(x, 0.f) - log1pf(__expf(-fabsf(x))); }
#define LDS_FENCE() asm volatile("s_waitcnt lgkmcnt(0)" ::: "memory")
#ifndef PROBE_SUB
#define PROBE_SUB 0
#endif

__device__ __forceinline__ int tid_now() { int t = threadIdx.x; asm volatile("" : "+v"(t)); return t; }

#define XB_TMO      128
#define XB_XCNT(j)  (256  + 64 * (j))
#define XB_XSUB(j)  (1280 + 64 * (j))
#define XB_XGEN(j)  (2304 + 64 * (j))
#define XB_TOP      3328
#define XB_TOPGEN   3392
#define XCD_BAR_WORDS 3456
#define XB_SPIN_CAP (1u << 20)
__device__ __forceinline__ unsigned xb_ld(unsigned* p)              { return __hip_atomic_load(p, __ATOMIC_RELAXED, __HIP_MEMORY_SCOPE_AGENT); }
__device__ __forceinline__ unsigned xb_add(unsigned* p, unsigned v) { return __hip_atomic_fetch_add(p, v, __ATOMIC_RELAXED, __HIP_MEMORY_SCOPE_AGENT); }
__device__ __forceinline__ unsigned xb_xcc_id() { return (unsigned)__builtin_amdgcn_s_getreg((3 << 11) | 20) & 0xFu; }
#define XB_SPIN(cond, bar) do { unsigned _sp = 0; while (cond) { __builtin_amdgcn_s_sleep(1); \
    if ((++_sp & 255u) == 0u) { if (xb_ld(&(bar)[XB_TMO])) break; if (_sp > XB_SPIN_CAP) { atomicAdd(&(bar)[XB_TMO], 1u); break; } } } } while (0)
struct XcdBarrier { unsigned* bar; unsigned x; volatile unsigned* st; };
__device__ __forceinline__ XcdBarrier xcd_barrier_post(unsigned* bar, volatile unsigned* st) {
    XcdBarrier b; b.bar = bar; b.x = xb_xcc_id(); b.st = st;
    if (threadIdx.x == 0) (void)xb_add(&bar[XB_XCNT(b.x)], 1u);
    return b;
}
__device__ __forceinline__ void xcd_barrier_complete(unsigned* bar, unsigned x, unsigned& nloc, unsigned& nx) {
    const unsigned G = gridDim.x;
    unsigned sum, cnt, mine, sp = 0u;
    for (;;) {
        sum = 0u; cnt = 0u; mine = 0u;
#pragma unroll
        for (unsigned j = 0; j < 16; ++j) { const unsigned c = xb_ld(&bar[XB_XCNT(j)]); sum += c; cnt += (c > 0u) ? 1u : 0u; mine = (j == x) ? c : mine; }
        if (sum == G) break;
        __builtin_amdgcn_s_sleep(1);
        if ((++sp & 255u) == 0u) { if (xb_ld(&bar[XB_TMO])) break; if (sp > XB_SPIN_CAP) { atomicAdd(&bar[XB_TMO], 1u); break; } }
    }
    nloc = mine > 0u ? mine : 1u; nx = cnt > 0u ? cnt : 1u;
}
__device__ __forceinline__ void xcd_barrier(const XcdBarrier& b) {
    asm volatile("s_waitcnt vmcnt(0)" ::: "memory");
    __syncthreads();
    if (threadIdx.x == 0) {
        unsigned* bar = b.bar;
        __builtin_amdgcn_s_waitcnt(0);
        unsigned nloc = b.st[0], nx = b.st[1];
        if (nloc == 0u) { xcd_barrier_complete(bar, b.x, nloc, nx); b.st[0] = nloc; b.st[1] = nx; }
        const unsigned old = xb_add(&bar[XB_XSUB(b.x)], 1u);
        const unsigned gen = old / nloc;
        if (old + 1u == (gen + 1u) * nloc) {
            __builtin_amdgcn_fence(__ATOMIC_RELEASE, "agent");
            asm volatile("s_waitcnt vmcnt(0)" ::: "memory");
            const unsigned og = xb_add(&bar[XB_TOP], 1u);
            const unsigned tg = og / nx;
            if (og + 1u == (tg + 1u) * nx) xb_add(&bar[XB_TOPGEN], 1u);
            else XB_SPIN(xb_ld(&bar[XB_TOPGEN]) == tg, bar);
            __builtin_amdgcn_fence(__ATOMIC_ACQUIRE, "agent");
            xb_add(&bar[XB_XGEN(b.x)], 1u);
            asm volatile("s_waitcnt vmcnt(0)" ::: "memory");
        } else {
            XB_SPIN(xb_ld(&bar[XB_XGEN(b.x)]) == gen, bar);
            __builtin_amdgcn_fence(__ATOMIC_ACQUIRE, "agent");
            asm volatile("s_waitcnt vmcnt(0)" ::: "memory");
        }
    }
    __syncthreads();
}

__device__ __forceinline__ int row_b(int row) { return row >= POSB ? 1 : 0; }

struct CvItem { const float* src; bf16* dst; int ldw, ldt, k0, drow0, dstep; };
__device__ __forceinline__ void cv_load(const CvItem& d, f32x4 (&v)[8], int lane) {
    const int kr = lane >> 3, c4 = lane & 7;
#pragma unroll
    for (int i = 0; i < 8; ++i) v[i] = __builtin_nontemporal_load((const f32x4*)(d.src + (size_t)(d.k0 + 8 * i + kr) * d.ldw + 4 * c4));
}
__device__ __forceinline__ void cv_finish(const CvItem& d, const f32x4 (&v)[8], float* scr, int lane) {
    const int kr = lane >> 3, c4 = lane & 7;
#pragma unroll
    for (int i = 0; i < 8; ++i) { float* q = scr + (8 * i + kr) * 33 + 4 * c4; q[0] = v[i].x; q[1] = v[i].y; q[2] = v[i].z; q[3] = v[i].w; }
    LDS_FENCE();
    const int c = lane & 7;
#pragma unroll
    for (int j = 0; j < 4; ++j) {
        const int n = (lane >> 3) + 8 * j; const float* s = scr + (8 * c) * 33 + n;
        u32x4 o; o.x = pk2(s[0 * 33], s[1 * 33]); o.y = pk2(s[2 * 33], s[3 * 33]); o.z = pk2(s[4 * 33], s[5 * 33]); o.w = pk2(s[6 * 33], s[7 * 33]);
        const int dr = d.drow0 + (n & 15) + (n >> 4) * d.dstep;
        __builtin_nontemporal_store(o, (u32x4*)(d.dst + (size_t)dr * d.ldt + d.k0 + 8 * c));
    }
    LDS_FENCE();
}

constexpr int CV_IN = 16 * 96, CV_OUT = 16 * 32, CV_GU = 65 * 256, CV_D = 65 * 128, CV_TOTAL = CV_IN + CV_OUT + CV_GU + CV_D;

__device__ __forceinline__ CvItem cv_decode(PRef p, int l, int it) {
    bf16* WIN = (bf16*)(p.ws + WS_WIN); bf16* WOUT = (bf16*)(p.ws + WS_WOUT); bf16* WGU = (bf16*)(p.ws + WS_WGU); bf16* WD = (bf16*)(p.ws + WS_WD);
    CvItem d; int r = it;
    if (r < CV_IN) { const int kb = r / 96, nb = r % 96, n0 = 32 * nb;
        d.src = p.in[10] + (size_t)l * D * NIN + n0 + (n0 >= 1536 ? 16 : 0); d.ldw = NIN; d.k0 = 64 * kb; d.dst = WIN; d.ldt = D; d.drow0 = n0; d.dstep = 16; return d; }
    r -= CV_IN;
    if (r < CV_OUT) { const int kb = r / 32, nb = r % 32;
        d.src = p.in[11] + (size_t)l * D * D + 32 * nb; d.ldw = D; d.k0 = 64 * kb; d.dst = WOUT; d.ldt = D; d.drow0 = 32 * nb; d.dstep = 16; return d; }
    r -= CV_OUT;
    if (r < CV_GU) { const int e = r >> 8, rem = r & 255, which = rem >> 7, it2 = rem & 127, kb = it2 >> 3, nb = it2 & 7, hc0 = 32 * nb;
        d.src = ((e < 64) ? (which ? p.in[21] : p.in[20]) + ((size_t)l * 64 + e) * D * DEXP : (which ? p.in[24] : p.in[23]) + (size_t)l * D * DEXP) + hc0;
        d.ldw = DEXP; d.k0 = 64 * kb; d.dst = WGU + (size_t)e * 512 * D; d.ldt = D;
        d.drow0 = 256 * (hc0 >> 7) + 128 * ((hc0 >> 6) & 1) + 32 * ((hc0 >> 4) & 3) + 16 * which; d.dstep = 32; return d; }
    r -= CV_GU;
    { const int e = r >> 7, it2 = r & 127, kb = it2 >> 5, nb = it2 & 31;
        d.src = ((e < 64) ? p.in[22] + ((size_t)l * 64 + e) * DEXP * D : p.in[25] + (size_t)l * DEXP * D) + 32 * nb;
        d.ldw = D; d.k0 = 64 * kb; d.dst = WD + (size_t)e * D * DEXP; d.ldt = DEXP; d.drow0 = 32 * nb; d.dstep = 16; return d; }
}

__device__ __forceinline__ void convert_weights(PRef p, int l, char* lds) {
    const int lane = tid_now() & 63, wave = tid_now() >> 6;
    float* scr = (float*)(lds + wave * 8704);
    const int gw = blockIdx.x * NWAVE + wave, NGW = gridDim.x * NWAVE;
    { bf16* WRH = (bf16*)(p.ws + WS_WRH); bf16* WRL = (bf16*)(p.ws + WS_WRL); const float* wrt = p.in[18] + (size_t)l * D * NEXP;
      for (int i = gw * 64 + lane; i < D * NEXP; i += NGW * 64) { const int k = i >> 6, e = i & 63; const float w = wrt[i]; const unsigned h = f2bf(w);
          WRH[e * D + k] = (bf16)h; WRL[e * D + k] = (bf16)f2bf(w - __builtin_bit_cast(float, h << 16)); } }
    { bf16* WLR = (bf16*)(p.ws + WS_WLR); bf16* GWP = (bf16*)(p.ws + WS_GWP);
      for (int i = gw * 64 + lane; i < 32 * D; i += NGW * 64) { const int n = i >> 10, k = i & 1023;
          WLR[i] = (bf16)(n < 16 ? f2bf(p.in[10][(size_t)l * D * NIN + (size_t)k * NIN + 1536 + n]) : 0u); }
      for (int i = gw * 64 + lane; i < 256 * 16; i += NGW * 64) { const int c = i >> 4, pos = i & 15, n = (pos & 3) | ((pos & 4) << 1) | ((pos & 8) >> 1);
          GWP[i] = (bf16)f2bf(p.in[13][l * 4096 + ((c >> 7) * 16 + n) * 128 + (c & 127)]); } }
    f32x4 va[8], vb[8];
    int it = gw;
    if (it >= CV_TOTAL) return;
    CvItem da = cv_decode(p, l, it), db = da;
    cv_load(da, va, lane);
#pragma unroll 1
    for (;;) {
        const int it1 = it + NGW; const bool more1 = it1 < CV_TOTAL;
        if (more1) { db = cv_decode(p, l, it1); cv_load(db, vb, lane); }
        cv_finish(da, va, scr, lane);
        if (!more1) break;
        const int it2 = it1 + NGW; const bool more2 = it2 < CV_TOTAL;
        if (more2) { da = cv_decode(p, l, it2); cv_load(da, va, lane); }
        cv_finish(db, vb, scr, lane);
        if (!more2) break;
        it = it2;
    }
}

__device__ __forceinline__ void sincos_exact(float ang, float& s, float& c) {
    const double x = (double)ang;
    const double k = rint(x * 0.15915494309189535);
    const double r = x - k * 6.283185307179586476925;
    const double r2 = r * r;
    double ts = r, ss = r, tc = 1.0, cs = 1.0;
#pragma unroll 1
    for (int n = 1; n <= 15; ++n) { ts *= -r2 / (double)((2 * n) * (2 * n + 1)); ss += ts; tc *= -r2 / (double)((2 * n - 1) * (2 * n)); cs += tc; }
    s = (float)ss; c = (float)cs;
}

__device__ __forceinline__ void phase_p0(PRef p, char* lds) {
    const int tid = tid_now();
    {
        float* cond = (float*)lds;
        float* red = (float*)(lds + 12288);
        for (int i = tid; i < 3 * D; i += NTHR) { const int r = i >> 10, k = i & 1023; const float v = (r < 2) ? p.in[1][r * D + k] : p.in[3][k]; cond[i] = silu_f(v); }
        __syncthreads();
        for (int item = blockIdx.x; item < 384; item += gridDim.x) {
            const int l = item / 192, n0 = (item % 192) * 32;
            const int cg = tid & 7, ks = tid >> 3;
            const float* W = p.in[4] + (size_t)l * D * 6144 + n0 + 4 * cg + (size_t)(ks * 16) * 6144;
            f32x4 w[16];
#pragma unroll
            for (int kk = 0; kk < 16; ++kk) w[kk] = *(const f32x4*)(W + (size_t)kk * 6144);
            f32x4 a0 = {0, 0, 0, 0}, a1 = a0, a2 = a0;
#pragma unroll
            for (int kk = 0; kk < 16; ++kk) { const int k = ks * 16 + kk; a0 += w[kk] * cond[k]; a1 += w[kk] * cond[D + k]; a2 += w[kk] * cond[2 * D + k]; }
#pragma unroll
            for (int i = 0; i < 4; ++i) { red[(ks * 3 + 0) * 32 + 4 * cg + i] = a0[i]; red[(ks * 3 + 1) * 32 + 4 * cg + i] = a1[i]; red[(ks * 3 + 2) * 32 + 4 * cg + i] = a2[i]; }
            __syncthreads();
            if (tid < 96) { const int r = tid >> 5, n = tid & 31; float sm = 0.f;
                for (int q = 0; q < 64; ++q) sm += red[(q * 3 + r) * 32 + n];
                ((float*)(p.ws + WS_MODS))[(l * 3 + r) * 6144 + n0 + n] = sm + p.in[5][l * 6144 + n0 + n]; }
            __syncthreads();
        }
    }
    if (blockIdx.x == gridDim.x - 1) {
        float* t8 = (float*)(p.ws + WS_TAB8); float* t16 = (float*)(p.ws + WS_TAB16);
        for (int i = tid; i < 128 * 8 + 128 * 16; i += NTHR) {
            int pos, fi, q; float* dst;
            if (i < 1024) { pos = i >> 3; fi = i & 7; q = 8; dst = t8 + 2 * i; } else { const int j = i - 1024; pos = j >> 4; fi = j & 15; q = 16; dst = t16 + 2 * j; }
            const float freq = (float)exp(-(double)fi / (double)q * 9.210340371976184);
            const float ang = (float)pos * freq; float s, c; sincos_exact(ang, s, c); dst[0] = c; dst[1] = s;
        }
        if (tid < 2) { const int l = tid; const float* lp = p.in[16] + l * 256; float s1 = 0.f, s2 = 0.f;
            for (int i = 0; i < 64; ++i) { s1 += lp[i] * lp[64 + i]; s2 += lp[128 + i] * lp[192 + i]; }
            const float lam_init = 0.8f - 0.6f * expf(-0.3f * (float)l);
            float* sc = (float*)(p.ws + WS_SCAL) + l * 16;
            sc[0] = expf(s1) - expf(s2) + lam_init; sc[1] = lam_init;
            for (int i = 0; i < 8; ++i) sc[2 + i] = logsig_f(p.in[12][l * 8 + i]); }
    }
    __syncthreads();
    convert_weights(p, 0, lds);
}

__device__ __forceinline__ const float* resid_row_ptr(PRef p, int l, int row) {
    const int b = row_b(row), pos = row - b * POSB;
    if (l == 0) return pos < CTX ? p.in[2] + ((size_t)b * CTX + pos) * D : p.in[0] + ((size_t)b * SEQ + pos - CTX) * D;
    return pos < CTX ? (const float*)(p.ws + WS_HCTX) + ((size_t)b * CTX + pos) * D : p.out + ((size_t)b * SEQ + pos - CTX) * D;
}
__device__ __forceinline__ float* resid_row_out(PRef p, int row) {
    const int b = row_b(row), pos = row - b * POSB;
    return pos < CTX ? (float*)(p.ws + WS_HCTX) + ((size_t)b * CTX + pos) * D : p.out + ((size_t)b * SEQ + pos - CTX) * D;
}

__device__ __forceinline__ void phase_a(PRef p, int l, char* lds, const bool st) {
    const int tid = tid_now(), lane = tid & 63, wave = tid >> 6;
    const float* mods = (const float*)(p.ws + WS_MODS) + (size_t)l * 3 * 6144;
    const float* gpre = p.in[6] + l * D;
    bf16* HL = (bf16*)(p.ws + WS_HL);
    for (int row = blockIdx.x * NWAVE + wave; row < R; row += gridDim.x * NWAVE) {
        const int b = row_b(row), pos = row - b * POSB, rt = pos < CTX ? 2 : b;
        const float* xr = resid_row_ptr(p, l, row);
        const float* sh = mods + rt * 6144; const float* sc = sh + D;
        f32x4 v[4]; float ss = 0.f;
#pragma unroll
        for (int j = 0; j < 4; ++j) { v[j] = *(const f32x4*)(xr + 4 * lane + 256 * j); ss += v[j].x * v[j].x + v[j].y * v[j].y + v[j].z * v[j].z + v[j].w * v[j].w; }
        const float rs = rsqrtf(wave_sum(ss) * (1.f / D) + EPS);
#pragma unroll
        for (int j = 0; j < 4; ++j) {
            const int k0 = 4 * lane + 256 * j;
            const f32x4 g = *(const f32x4*)(gpre + k0), s1 = *(const f32x4*)(sc + k0), s0 = *(const f32x4*)(sh + k0);
            const f32x4 h = v[j] * rs * g * (s1 + 1.f) + s0;
            u32x2 o; o.x = pk2(h.x, h.y); o.y = pk2(h.z, h.w);
            if (st) *(u32x2*)(HL + (size_t)row * D + k0) = o;
        }
    }
}

__device__ __forceinline__ float logsig_fast(float x) { return fminf(x, 0.f) - __logf(1.f + __expf(-fabsf(x))); }
__device__ __forceinline__ void lr_tasks(PRef p, int l, int first_blk) {
    if ((int)blockIdx.x < first_blk) return;
    const int tid = tid_now(), lane = tid & 63, wave = tid >> 6, li = lane & 31, hi = lane >> 5;
    const bf16* HL = (const bf16*)(p.ws + WS_HL); float* LA = (float*)(p.ws + WS_LA);
    const bf16* WLR = (const bf16*)(p.ws + WS_WLR); const bf16* GWP = (const bf16*)(p.ws + WS_GWP);
    const float* gb = p.in[14] + l * 256;
    const int nw = ((int)gridDim.x - first_blk) * NWAVE;
    for (int task = ((int)blockIdx.x - first_blk) * NWAVE + wave; task < R / 32; task += nw) {
        const int r0 = task * 32;
        const bf16* ap = WLR + (size_t)li * D + 8 * hi; const bf16* bp = HL + (size_t)(r0 + li) * D + 8 * hi;
        f32x16 lrT = {0};
#pragma unroll 8
        for (int s = 0; s < 64; ++s) lrT = __builtin_amdgcn_mfma_f32_32x32x16_bf16(*(const bf16x8*)(ap + 16 * s), *(const bf16x8*)(bp + 16 * s), lrT, 0, 0, 0);
        u32x4 w; w.x = pk2(lrT[0], lrT[1]); w.y = pk2(lrT[2], lrT[3]); w.z = pk2(lrT[4], lrT[5]); w.w = pk2(lrT[6], lrT[7]);
        const bf16x8 lrb = __builtin_bit_cast(bf16x8, w);
        float* orow = LA + (size_t)(r0 + li) * 256;
#pragma unroll 2
        for (int t = 0; t < 8; ++t) {
            const bf16x8 ga = *(const bf16x8*)(GWP + (size_t)(32 * t + li) * 16 + 8 * hi);
            f32x16 z = {0};
            z = __builtin_amdgcn_mfma_f32_32x32x16_bf16(ga, lrb, z, 0, 0, 0);
#pragma unroll
            for (int a = 0; a < 4; ++a) { const int c = 32 * t + 8 * a + 4 * hi;
                const f32x4 bb = *(const f32x4*)(gb + c);
                f32x4 la; la.x = logsig_fast(z[4 * a] + bb.x) * 0.0625f; la.y = logsig_fast(z[4 * a + 1] + bb.y) * 0.0625f;
                la.z = logsig_fast(z[4 * a + 2] + bb.z) * 0.0625f; la.w = logsig_fast(z[4 * a + 3] + bb.w) * 0.0625f;
                *(f32x4*)(orow + c) = la; }
        }
    }
}

namespace pg8 {
constexpr int BM = 256, BK = 64, HALF = 128, HTB = HALF * BK * 2;
__device__ __forceinline__ int lds_byte(int r, int c) { const int st = (r >> 4) * 2 + (c >> 5), rr = r & 15, cc = c & 31, ob = rr * 64 + cc * 2; return st * 1024 + (ob ^ (((ob >> 9) & 1) << 5)); }
__device__ __forceinline__ void stage_rc(int b, int& R, int& C) { const int st = b / 1024, sb = b % 1024, swz = sb ^ (((sb >> 9) & 1) << 5); R = (st >> 1) * 16 + swz / 64; C = (st & 1) * 32 + (swz % 64) / 2; }
struct Unit { int pm, pn, e, ti; };
typedef f32x4 Acc[2][2][4][2];

template <class Epi, class Sched, bool GATHER>
__device__ __forceinline__ void gemm_phase(LAS unsigned char* lds, const bf16* A, const bf16* Bt, const int K, const Sched& S, const Epi& E) {
    const int tid = tid_now(), wid = __builtin_amdgcn_readfirstlane(tid >> 6), lane = tid & 63, wr = wid >> 2, wc = wid & 3, fr = lane & 15, fq = lane >> 4;
    const int nt = K / BK;
    unsigned voffB[2]; int Rst[2], Cst[2];
#pragma unroll
    for (int i = 0; i < 2; ++i) { int Rr, Cc; stage_rc(tid * 16 + i * 8192, Rr, Cc); Rst[i] = Rr; Cst[i] = Cc; voffB[i] = (unsigned)(Rr * K + Cc) * 2u; }
    const size_t kstep = (size_t)(BK * 2), hstep = (size_t)HALF * K * 2, tstep = 2 * hstep;
    const unsigned ldsw = (unsigned)wid * 1024u;
    const int aoff = lds_byte(wr * 64 + fr, fq * 8), boff = lds_byte(wc * 32 + fr, fq * 8);
#define PG8_SA(b, h) (((b) * 2 + (h)) * HTB)
#define PG8_SB(b, h) ((4 + (b) * 2 + (h)) * HTB)
#define PG8_STAGE(bufoff, gbase, voff) do { _Pragma("unroll") for (int _i = 0; _i < 2; ++_i) \
        __builtin_amdgcn_global_load_lds((const unsigned*)((const char*)(gbase) + (voff)[_i]), (LAS unsigned*)(lds + (bufoff) + ldsw + _i * 8192), 16, 0, 0); } while (0)
#define PG8_LDA(dst, b, h) do { _Pragma("unroll") for (int m = 0; m < 4; ++m) _Pragma("unroll") for (int k = 0; k < 2; ++k) dst[m][k] = *(const LAS bf16x8*)(lds + PG8_SA(b, h) + aoff + m * 2048 + k * 1024); } while (0)
#define PG8_LDB(dst, b, h) do { _Pragma("unroll") for (int n = 0; n < 2; ++n) _Pragma("unroll") for (int k = 0; k < 2; ++k) dst[n][k] = *(const LAS bf16x8*)(lds + PG8_SB(b, h) + boff + n * 2048 + k * 1024); } while (0)
#define PG8_MMA(ai, bj, At, Bt_) do { __builtin_amdgcn_s_setprio(1); _Pragma("unroll") for (int m = 0; m < 4; ++m) _Pragma("unroll") for (int n = 0; n < 2; ++n) _Pragma("unroll") for (int k = 0; k < 2; ++k) \
        acc[ai][bj][m][n] = __builtin_amdgcn_mfma_f32_16x16x32_bf16(Bt_[n][k], At[m][k], acc[ai][bj][m][n], 0, 0, 0); __builtin_amdgcn_s_setprio(0); } while (0)
#define PG8_WAIT_V(n) asm volatile("s_waitcnt vmcnt(" #n ")" ::: "memory")
#define PG8_WAIT_L(n) asm volatile("s_waitcnt lgkmcnt(" #n ")" ::: "memory")
#define PG8_BAR __builtin_amdgcn_s_barrier()
#define PG8_SCHED __builtin_amdgcn_sched_barrier(0)
#define PG8_VA(dst, u) do { _Pragma("unroll") for (int _h = 0; _h < 2; ++_h) _Pragma("unroll") for (int _i = 0; _i < 2; ++_i) \
        dst[_h][_i] = GATHER ? (unsigned)(S.src_row(u, _h * HALF + Rst[_i]) * K + Cst[_i]) * 2u : (unsigned)((_h * HALF + Rst[_i]) * K + Cst[_i]) * 2u; } while (0)
    Unit cur, nxt; int ui = 0;
    if (!S.next(0, cur)) return;
    Acc acc;
#pragma unroll
    for (int a = 0; a < 2; ++a)
#pragma unroll
        for (int b = 0; b < 2; ++b)
#pragma unroll
            for (int m = 0; m < 4; ++m)
#pragma unroll
                for (int n = 0; n < 2; ++n) acc[a][b][m][n] = (f32x4){0.f, 0.f, 0.f, 0.f};
    bf16x8 At[4][2], B0[2][2], B1[2][2];
    unsigned vAc[2][2], vAn[2][2];
    PG8_VA(vAc, cur);
    const char* cA = (const char*)A + (GATHER ? (size_t)0 : (size_t)cur.pm * tstep); const char* cB = (const char*)Bt + (size_t)cur.pn * tstep;
    PG8_STAGE(PG8_SB(0, 0), cB, voffB); PG8_STAGE(PG8_SB(0, 1), cB + hstep, voffB); PG8_STAGE(PG8_SA(0, 0), cA, vAc[0]); PG8_STAGE(PG8_SA(0, 1), cA, vAc[1]);
    if (wr == 1) PG8_BAR;
    PG8_WAIT_V(2); PG8_BAR;
    PG8_STAGE(PG8_SB(1, 0), cB + kstep, voffB); PG8_STAGE(PG8_SA(1, 0), cA + kstep, vAc[0]); PG8_STAGE(PG8_SB(1, 1), cB + hstep + kstep, voffB);
    PG8_WAIT_V(6); PG8_BAR;
    for (;;) {
        const bool has_next = S.next(ui + 1, nxt);
        const char* nA = has_next ? (const char*)A + (GATHER ? (size_t)0 : (size_t)nxt.pm * tstep) : cA; const char* nB = has_next ? (const char*)Bt + (size_t)nxt.pn * tstep : cB;
        if (GATHER) { if (has_next) PG8_VA(vAn, nxt); else { vAn[0][0] = vAc[0][0]; vAn[0][1] = vAc[0][1]; vAn[1][0] = vAc[1][0]; vAn[1][1] = vAc[1][1]; } }
#pragma unroll 1
        for (int t = 0; t < nt; t += 2) {
            const bool last = (t == nt - 2);
            const char* a1 = cA + (size_t)(t + 1) * kstep;
            const char* a2 = last ? nA : cA + (size_t)(t + 2) * kstep; const char* b2 = last ? nB : cB + (size_t)(t + 2) * kstep;
            const char* a3 = a2 + kstep; const char* b3 = b2 + kstep;
            PG8_LDB(B0, 0, 0); PG8_LDB(B1, 0, 1); PG8_SCHED; PG8_LDA(At, 0, 0); PG8_STAGE(PG8_SA(1, 1), a1, vAc[1]);
            if (GATHER && last) { vAc[0][0] = vAn[0][0]; vAc[0][1] = vAn[0][1]; vAc[1][0] = vAn[1][0]; vAc[1][1] = vAn[1][1]; }
            PG8_WAIT_V(8); PG8_WAIT_L(0); PG8_BAR; PG8_MMA(0, 0, At, B0); PG8_MMA(0, 1, At, B1); PG8_BAR; PG8_SCHED;
            PG8_LDA(At, 0, 1); PG8_STAGE(PG8_SB(0, 0), b2, voffB); PG8_STAGE(PG8_SB(0, 1), b2 + hstep, voffB); PG8_STAGE(PG8_SA(0, 0), a2, vAc[0]);
            PG8_WAIT_V(8); PG8_WAIT_L(0); PG8_BAR; PG8_MMA(1, 0, At, B0); PG8_MMA(1, 1, At, B1); PG8_BAR; PG8_SCHED;
            PG8_LDB(B0, 1, 0); PG8_LDB(B1, 1, 1); PG8_SCHED; PG8_LDA(At, 1, 0); PG8_STAGE(PG8_SA(0, 1), a2, vAc[1]);
            PG8_WAIT_V(8); PG8_WAIT_L(0); PG8_BAR; PG8_MMA(0, 0, At, B0); PG8_MMA(0, 1, At, B1); PG8_BAR; PG8_SCHED;
            PG8_LDA(At, 1, 1); PG8_STAGE(PG8_SB(1, 0), b3, voffB); PG8_STAGE(PG8_SB(1, 1), b3 + hstep, voffB); PG8_STAGE(PG8_SA(1, 0), a3, vAc[0]);
            PG8_WAIT_V(8); PG8_WAIT_L(0); PG8_BAR; PG8_MMA(1, 0, At, B0); PG8_MMA(1, 1, At, B1); PG8_BAR; PG8_SCHED;
        }
        if (wr == 0) PG8_BAR;
        { unsigned long long g_t0 = PROBE_SUB == 31 ? __builtin_amdgcn_s_memrealtime() : 0ull;
          E(acc, cur, wr, wc, fr, fq);
          if (PROBE_SUB == 31) { asm volatile("s_waitcnt vmcnt(0)" ::: "memory"); const unsigned long long _t = __builtin_amdgcn_s_memrealtime(); if (tid == 0) *(volatile unsigned long long*)((char*)lds + LDS_MISC + 128) += _t - g_t0; } }
        if (!has_next) break;
#pragma unroll
        for (int a = 0; a < 2; ++a)
#pragma unroll
            for (int b = 0; b < 2; ++b)
#pragma unroll
                for (int m = 0; m < 4; ++m)
#pragma unroll
                    for (int n = 0; n < 2; ++n) acc[a][b][m][n] = (f32x4){0.f, 0.f, 0.f, 0.f};
        cur = nxt; cA = nA; cB = nB; ++ui;
        if (wr == 1) PG8_BAR;
    }
    PG8_WAIT_V(0);
    PG8_BAR;
#undef PG8_SA
#undef PG8_SB
#undef PG8_STAGE
#undef PG8_LDA
#undef PG8_LDB
#undef PG8_MMA
#undef PG8_WAIT_V
#undef PG8_WAIT_L
#undef PG8_BAR
#undef PG8_SCHED
#undef PG8_VA
}
}

__device__ __forceinline__ u32x4 pair16(const u32x2 o0, const u32x2 o1, const int fq, int& coloff) {
    const bool odd = fq & 1;
    const u32x2 send = odd ? o0 : o1, keep = odd ? o1 : o0;
    u32x2 got; got.x = (unsigned)__shfl_xor((int)send.x, 16); got.y = (unsigned)__shfl_xor((int)send.y, 16);
    coloff = (odd ? 16 : 0) + 4 * (fq & 2);
    return odd ? (u32x4){got.x, got.y, keep.x, keep.y} : (u32x4){keep.x, keep.y, got.x, got.y};
}
struct EpiInProj {
    bf16* P; const float* tab8; const float* tab16;
    __device__ __forceinline__ void operator()(pg8::Acc& acc, const pg8::Unit& u, int wr, int wc, int fr, int fq) const {
        const int row0 = u.pm * 256;
        const bool lat = (u.pm % 33) != 0;
#pragma unroll
        for (int bj = 0; bj < 2; ++bj) {
            const int c32 = u.pn * 8 + bj * 4 + wc, cb = c32 * 32;
            int kind = 0;
            float scale = 1.f;
            if (c32 < 8) { kind = 1; if (c32 >= 4) scale = 0.17677669529663687f; }
            else if (c32 >= 16 && c32 < 24) kind = 3;
            else if (c32 >= 24 && c32 < 28) scale = 0.17677669529663687f;
            else if (c32 >= 40 && c32 < 48) kind = 3;
            else if (c32 >= 48 && c32 < 80) { kind = 2; if (c32 < 64) scale = 0.18033688011112042f; }
#pragma unroll
            for (int ai = 0; ai < 2; ++ai)
#pragma unroll
                for (int m = 0; m < 4; ++m) {
                    const int row = row0 + 128 * ai + 64 * wr + 16 * m + fr;
                    const int pos = row >= POSB ? row - POSB : row, t = pos - CTX, prow = (t >> 6) & 127, pcol = t & 63;
                    f32x4 v0 = acc[ai][bj][m][0], v1 = acc[ai][bj][m][1];
                    if (kind == 1) {
                        if (lat) {
#pragma unroll
                            for (int n = 0; n < 2; ++n) {
                                const int pp = n ? pcol : prow;
                                const float* tb = tab8 + (pp * 8 + 4 * (fq & 1)) * 2;
                                const f32x4 t0 = *(const f32x4*)tb, t1 = *(const f32x4*)(tb + 4);
                                const float cs[4] = {t0.x, t0.z, t1.x, t1.z}, sn[4] = {t0.y, t0.w, t1.y, t1.w};
                                f32x4& v = n ? v1 : v0;
#pragma unroll
                                for (int i = 0; i < 4; ++i) { const float me = v[i], other = __shfl_xor(me, 32);
                                    v[i] = (fq < 2) ? me * cs[i] - other * sn[i] : other * sn[i] + me * cs[i]; }
                            }
                        }
                    } else if (kind == 2) {
                        if (lat) {
                            const int pp = (c32 & 1) ? pcol : prow;
                            const float* tb = tab16 + (pp * 16 + 4 * fq) * 2;
                            const f32x4 t0 = *(const f32x4*)tb, t1 = *(const f32x4*)(tb + 4);
                            const float cs[4] = {t0.x, t0.z, t1.x, t1.z}, sn[4] = {t0.y, t0.w, t1.y, t1.w};
#pragma unroll
                            for (int i = 0; i < 4; ++i) { const float a0 = v0[i], a1 = v1[i]; v0[i] = a0 * cs[i] - a1 * sn[i]; v1[i] = a0 * sn[i] + a1 * cs[i]; }
                        }
                    } else if (kind == 3) {
#pragma unroll
                        for (int i = 0; i < 4; ++i) { v0[i] = silu_f(v0[i]); v1[i] = silu_f(v1[i]); }
                    }
                    u32x2 o0, o1; o0.x = pk2(v0.x * scale, v0.y * scale); o0.y = pk2(v0.z * scale, v0.w * scale); o1.x = pk2(v1.x * scale, v1.y * scale); o1.y = pk2(v1.z * scale, v1.w * scale);
                    int co; const u32x4 o16 = pair16(o0, o1, fq, co);
                    *(u32x4*)(P + (size_t)row * NP + cb + co) = o16;
                }
        }
    }
};
struct EpiF32 {
    float* O; int ldo;
    __device__ __forceinline__ void operator()(pg8::Acc& acc, const pg8::Unit& u, int wr, int wc, int fr, int fq) const {
#pragma unroll
        for (int ai = 0; ai < 2; ++ai)
#pragma unroll
            for (int m = 0; m < 4; ++m) { float* rp = O + (size_t)(u.pm * 256 + 128 * ai + 64 * wr + 16 * m + fr) * ldo + (u.pn & 3) * 256 + 32 * wc + 4 * fq;
#pragma unroll
                for (int bj = 0; bj < 2; ++bj)
#pragma unroll
                    for (int n = 0; n < 2; ++n) *(f32x4*)(rp + 128 * bj + 16 * n) = acc[ai][bj][m][n]; }
    }
};
struct EpiBf16 {
    bf16* O; int ldo;
    __device__ __forceinline__ void operator()(pg8::Acc& acc, const pg8::Unit& u, int wr, int wc, int fr, int fq) const {
#pragma unroll
        for (int ai = 0; ai < 2; ++ai)
#pragma unroll
            for (int m = 0; m < 4; ++m) { bf16* rp0 = O + (size_t)(u.pm * 256 + 128 * ai + 64 * wr + 16 * m + fr) * ldo + (u.pn & 3) * 256 + 32 * wc;
#pragma unroll
                for (int bj = 0; bj < 2; ++bj) { const f32x4 v0 = acc[ai][bj][m][0], v1 = acc[ai][bj][m][1];
                    u32x2 o0, o1; o0.x = pk2(v0.x, v0.y); o0.y = pk2(v0.z, v0.w); o1.x = pk2(v1.x, v1.y); o1.y = pk2(v1.z, v1.w);
                    int co; const u32x4 o16 = pair16(o0, o1, fq, co);
                    *(u32x4*)(rp0 + 128 * bj + co) = o16; } }
    }
};
struct EpiFp8 {
    unsigned char* O;
    __device__ __forceinline__ void operator()(pg8::Acc& acc, const pg8::Unit& u, int wr, int wc, int fr, int fq) const {
        const int lane = fr + 16 * fq;
#pragma unroll
        for (int ai = 0; ai < 2; ++ai)
#pragma unroll
            for (int m = 0; m < 4; ++m) {
                unsigned wd[4];
#pragma unroll
                for (int q = 0; q < 4; ++q) { f32x4 v = acc[ai][q >> 1][m][q & 1] * 32.f;
#pragma unroll
                    for (int i = 0; i < 4; ++i) v[i] = fminf(fmaxf(v[i], -440.f), 440.f);
                    int w = 0; w = __builtin_amdgcn_cvt_pk_fp8_f32(v.x, v.y, w, false); w = __builtin_amdgcn_cvt_pk_fp8_f32(v.z, v.w, w, true); wd[q] = (unsigned)w; }
                unsigned ow[4];
#pragma unroll
                for (int s_ = 0; s_ < 4; ++s_) {
                    const int give = (fq - s_) & 3;
                    const unsigned val = give == 0 ? wd[0] : give == 1 ? wd[1] : give == 2 ? wd[2] : wd[3];
                    const int src = (fq + s_) & 3;
                    const unsigned got = (unsigned)__shfl((int)val, fr + 16 * src);
                    if (src == 0) ow[0] = got; if (src == 1) ow[1] = got; if (src == 2) ow[2] = got; if (src == 3) ow[3] = got;
                }
                unsigned char* rp = O + (size_t)(u.pm * 256 + 128 * ai + 64 * wr + 16 * m + fr) * D + (u.pn & 3) * 256 + 32 * wc + 128 * (fq >> 1) + 16 * (fq & 1);
                *(u32x4*)rp = (u32x4){ow[0], ow[1], ow[2], ow[3]};
                (void)lane;
            }
    }
};
struct EpiGateUp {
    bf16* H;
    __device__ __forceinline__ void operator()(pg8::Acc& acc, const pg8::Unit& u, int wr, int wc, int fr, int fq) const {
#pragma unroll
        for (int ai = 0; ai < 2; ++ai)
#pragma unroll
            for (int m = 0; m < 4; ++m) { bf16* rp = H + (size_t)(u.pm * 256 + 128 * ai + 64 * wr + 16 * m + fr) * DEXP + 128 * (u.pn & 1) + 16 * wc;
                u32x2 o[2];
#pragma unroll
                for (int bj = 0; bj < 2; ++bj) { const f32x4 g = acc[ai][bj][m][0], uu = acc[ai][bj][m][1];
                    o[bj].x = pk2(silu_f(g.x) * uu.x, silu_f(g.y) * uu.y); o[bj].y = pk2(silu_f(g.z) * uu.z, silu_f(g.w) * uu.w); }
                int co; const u32x4 o16 = pair16(o[0], o[1], fq, co);
                *(u32x4*)(rp + (co & 8) + ((co & 16) ? 64 : 0)) = o16; }
    }
};

__device__ __forceinline__ int virt_block() { const int G = (int)gridDim.x, bx = (int)blockIdx.x; return (G % 8 == 0) ? (bx % 8) * (G / 8) + bx / 8 : bx; }
struct DenseSched {
    int nM, nN, nunits, skipctx;
    __device__ __forceinline__ bool next(int i, pg8::Unit& u) const {
        const int L = i * (int)gridDim.x + (int)blockIdx.x; if (L >= nunits) return false;
        int wgid = L; { const int q = nunits / 8, r = nunits % 8, xcd = wgid % 8, off = wgid / 8; wgid = (xcd < r ? xcd * (q + 1) : r * (q + 1) + (xcd - r) * q) + off; }
        const int nig = 8 * nN, gid = wgid / nig, fm = gid * 8, gsz = (nM - fm) < 8 ? (nM - fm) : 8;
        int pm = fm + ((wgid % nig) % gsz); u.pn = (wgid % nig) / gsz;
        if (skipctx) pm = pm + 1 + (pm >= 32 ? 1 : 0); u.pm = pm; u.e = 0; u.ti = 0; return true;
    }
    __device__ __forceinline__ int src_row(const pg8::Unit&, int) const { return 0; }
};
__device__ __forceinline__ void phase_b(PRef p, int l, char* lds) {
    DenseSched S{66, 12, 66 * 12, 0};
    EpiInProj E{(bf16*)(p.ws + WS_P), (const float*)(p.ws + WS_TAB8), (const float*)(p.ws + WS_TAB16)};
    pg8::gemm_phase<EpiInProj, DenseSched, false>((LAS unsigned char*)lds, (const bf16*)(p.ws + WS_HL), (const bf16*)(p.ws + WS_WIN), D, S, E);
    lr_tasks(p, l, (66 * 12) % (int)gridDim.x);
}

constexpr int L_BF = 0;
constexpr int L_BS = 16896;
constexpr int L_SEG = 33792;
constexpr int L_A = 36864;
constexpr int LO_QF = 36864;
constexpr int LO_KF = LO_QF + 10240;
constexpr int LO_QB = LO_KF + 10240;
constexpr int LO_KB = LO_QB + 10240;
constexpr int LO_QI = LO_KB + 10240;
constexpr int LO_ST = LO_QI + 18432;
constexpr int LO_VT = LO_ST + 9216;
constexpr int LO_W = 0;
constexpr int LO_SS = LO_VT + 17408;
static_assert(34816 <= L_A, "W overlay");
static_assert(LO_SS + 1024 <= LDS_MISC, "lin LDS");

#define GSTAMP(k) do { if (PROBE_SUB) { const unsigned long long _t = __builtin_amdgcn_s_memrealtime(); if (PROBE_SUB == (k) && tid_now() == 0) *(volatile unsigned long long*)(lds + LDS_MISC + 128) += _t - g_t0; g_t0 = _t; } } while (0)
struct LinCfg { int type; int qcol, kcol, vcol, gcol, ocol; };

__device__ __forceinline__ void lin_prefix(PRef p, int l, int type, int h, int r0, bool already, char* lds, const bool st = true) {
    const int tid = tid_now();
    float* bf = (float*)(lds + L_BF); float* bs = (float*)(lds + L_BS); float* seg = (float*)(lds + L_SEG);
    if (type == 0) {
        const float* sc = (const float*)(p.ws + WS_SCAL) + l * 16;
        const float lgf = sc[2 + h], lgb = sc[6 + h];
        for (int i = tid; i < 128 * 32; i += NTHR) { const int j = i >> 5, kk = i & 31; bf[j * 33 + kk] = (float)(j + 1) * lgf; bs[j * 33 + kk] = (float)(128 - j) * lgb; }
        __syncthreads();
        return;
    }
    float* LA = (float*)(p.ws + WS_LA);
    if (already) {
        for (int i = tid; i < 128 * 32; i += NTHR) { const int j = i >> 5, kk = i & 31; const float* s = LA + (size_t)(r0 + j) * 256 + h * 32 + kk; bf[j * 33 + kk] = s[0]; bs[j * 33 + kk] = s[128]; }
        __syncthreads();
        return;
    }
    for (int i = tid; i < 128 * 32; i += NTHR) { const int j = i >> 5, kk = i & 31; const float* s = LA + (size_t)(r0 + j) * 256 + h * 32 + kk; bf[j * 33 + kk] = s[0]; bs[j * 33 + kk] = s[128]; }
    __syncthreads();
    const int chain = tid & 63, sg = tid >> 6, dir = chain >> 5, kk = chain & 31;
    float* arr = dir ? bs : bf;
    float tot = 0.f;
    for (int q = 0; q < 16; ++q) tot += arr[(sg * 16 + q) * 33 + kk];
    seg[chain * 8 + sg] = tot;
    __syncthreads();
    float off = 0.f;
    if (dir == 0) { for (int q = 0; q < sg; ++q) off += seg[chain * 8 + q];
        for (int q = 0; q < 16; ++q) { const int j = sg * 16 + q; off += arr[j * 33 + kk]; arr[j * 33 + kk] = off; } }
    else { for (int q = 7; q > sg; --q) off += seg[chain * 8 + q];
        for (int q = 15; q >= 0; --q) { const int j = sg * 16 + q; off += arr[j * 33 + kk]; arr[j * 33 + kk] = off; } }
    __syncthreads();
    if (st) for (int i = tid; i < 128 * 32; i += NTHR) { const int j = i >> 5, k2 = i & 31; float* s = LA + (size_t)(r0 + j) * 256 + h * 32 + k2; s[0] = bf[j * 33 + k2]; s[128] = bs[j * 33 + k2]; }
}

__device__ __forceinline__ LinCfg lin_cfg(int type, int h) {
    LinCfg c; c.type = type;
    if (type == 0) { c.qcol = h * 32; c.kcol = 128 + h * 32; c.vcol = 256 + h * 64; c.gcol = 512 + h * 64; c.ocol = h * 64; }
    else { c.qcol = 768 + h * 32; c.kcol = 896 + h * 32; c.vcol = 1024 + h * 64; c.gcol = 1280 + h * 64; c.ocol = 256 + h * 64; }
    return c;
}
__device__ __forceinline__ size_t us_index(int b, int h, int type, int dir, int c) { return ((((size_t)(b * 4 + h) * 2 + type) * 2 + dir) * NCH + c) * 2048; }

__device__ __forceinline__ void lin_u_item(PRef p, int l, int item, char* lds, const bool st) {
    unsigned long long g_t0 = PROBE_SUB ? __builtin_amdgcn_s_memrealtime() : 0ull;
    const int tid = tid_now();
    const int type = item & 1, h = (item >> 1) & 3, b = (item >> 3) & 1, c = item >> 4;
    const LinCfg cf = lin_cfg(type, h);
    const int r0 = b * POSB + c * 128;
    const bf16* P = (const bf16*)(p.ws + WS_P);
    const u32x4 kv4 = *(const u32x4*)(P + (size_t)(r0 + (tid >> 2)) * NP + cf.kcol + 8 * (tid & 3));
    u32x4 vpre[2];
#pragma unroll
    for (int i = 0; i < 2; ++i) { const int q = tid + 512 * i; vpre[i] = *(const u32x4*)(P + (size_t)(r0 + (q >> 3)) * NP + cf.vcol + 8 * (q & 7)); }
    lin_prefix(p, l, type, h, r0, false, lds, st);
    GSTAMP(12);
    const float* bf = (const float*)(lds + L_BF); const float* bs = (const float*)(lds + L_BS);
    bf16* kut = (bf16*)(lds + L_A);
    bf16* vt = kut + 2 * 32 * 136;
    { const int j = tid >> 2, c = tid & 3;
      const unsigned kw[4] = {kv4.x, kv4.y, kv4.z, kv4.w};
#pragma unroll
      for (int e = 0; e < 8; ++e) { const int kk = 8 * c + e; const float kv = (e & 1) ? bfhi(kw[e >> 1]) : bflo(kw[e >> 1]);
          kut[kk * 136 + j] = (bf16)f2bf(kv * __expf(bf[127 * 33 + kk] - bf[j * 33 + kk]));
          kut[(32 + kk) * 136 + j] = (bf16)f2bf(kv * __expf(bs[0 * 33 + kk] - bs[j * 33 + kk])); } }
#pragma unroll
    for (int i = 0; i < 2; ++i) { const int q = tid + 512 * i, j = q >> 3, c = q & 7;
        const unsigned vw[4] = {vpre[i].x, vpre[i].y, vpre[i].z, vpre[i].w};
#pragma unroll
        for (int e = 0; e < 4; ++e) { vt[(8 * c + 2 * e) * 136 + j] = (bf16)(vw[e] & 0xffff); vt[(8 * c + 2 * e + 1) * 136 + j] = (bf16)(vw[e] >> 16); } }
    if (st && type == 1 && tid < 64) { const int dir = tid >> 5, kk = tid & 31;
        ((float*)(p.ws + WS_DEC))[(((size_t)(b * 4 + h) * 2 + dir) * NCH + c) * 32 + kk] = __expf(dir ? bs[kk] : bf[127 * 33 + kk]); }
    __syncthreads();
    GSTAMP(13);
    { const int lane = tid & 63, wid = tid >> 6, li = lane & 31, hi = lane >> 5;
      if (wid < 4) {
          const int dir = wid >> 1, bd = wid & 1;
          f32x16 u = {0};
#pragma unroll
          for (int s = 0; s < 8; ++s) {
              const bf16x8 ka = *(const bf16x8*)(kut + (dir * 32 + li) * 136 + 16 * s + 8 * hi), vb = *(const bf16x8*)(vt + (bd * 32 + li) * 136 + 16 * s + 8 * hi);
              u = __builtin_amdgcn_mfma_f32_32x32x16_bf16(ka, vb, u, 0, 0, 0);
          }
          float* U = (float*)(p.ws + WS_US) + us_index(b, h, type, dir, c) + bd * 32 + li;
          if (st) {
#pragma unroll
              for (int r = 0; r < 16; ++r) U[((r & 3) + 8 * (r >> 2) + 4 * hi) * 64] = u[r]; }
      } }
    __syncthreads();
    GSTAMP(14);
}

__device__ __forceinline__ void vt_item(PRef p, int l, int item, char* lds, const bool st) {
    unsigned long long g_t0 = PROBE_SUB ? __builtin_amdgcn_s_memrealtime() : 0ull;
    const int tid = tid_now();
    const int g64 = item % 132, h = (item / 132) & 3, b = item / 528;
    const bf16* P = (const bf16*)(p.ws + WS_P); bf16* VT = (bf16*)(p.ws + WS_VT);
    bf16* t = (bf16*)lds;
#pragma unroll
    for (int i = 0; i < 2; ++i) { const int q = tid + 512 * i, j = q >> 4, ch = q & 15;
        const u32x4 v = *(const u32x4*)(P + (size_t)(b * POSB + g64 * 64 + j) * NP + 2560 + h * 128 + ch * 8);
        const int jp = (j & ~12) | ((j & 4) << 1) | ((j & 8) >> 1);
        const unsigned w[4] = {v.x, v.y, v.z, v.w};
#pragma unroll
        for (int e = 0; e < 4; ++e) { t[(ch * 8 + 2 * e) * 72 + jp] = (bf16)(w[e] & 0xffff); t[(ch * 8 + 2 * e + 1) * 72 + jp] = (bf16)(w[e] >> 16); } }
    { const int key = tid >> 3, part = tid & 7;
      const bf16* kr = P + (size_t)(b * POSB + g64 * 64 + key) * NP + 2048 + h * 128 + part * 8;
      const u32x4 k0 = *(const u32x4*)kr, k1 = *(const u32x4*)(kr + 64);
      const unsigned w0[4] = {k0.x, k0.y, k0.z, k0.w}, w1[4] = {k1.x, k1.y, k1.z, k1.w};
      float s0 = 0.f, s1 = 0.f;
#pragma unroll
      for (int e = 0; e < 4; ++e) { s0 += bflo(w0[e]) * bflo(w0[e]) + bfhi(w0[e]) * bfhi(w0[e]); s1 += bflo(w1[e]) * bflo(w1[e]) + bfhi(w1[e]) * bfhi(w1[e]); }
      s0 += __shfl_xor(s0, 1); s0 += __shfl_xor(s0, 2); s0 += __shfl_xor(s0, 4); s1 += __shfl_xor(s1, 1); s1 += __shfl_xor(s1, 2); s1 += __shfl_xor(s1, 4);
      s0 = wave_max(s0); s1 = wave_max(s1);
      float* kred = (float*)(lds + 32768);
      if ((tid & 63) == 0) { kred[(tid >> 6) * 2] = s0; kred[(tid >> 6) * 2 + 1] = s1; } }
    __syncthreads();
    if (st && tid < 2) { const float* kred = (const float*)(lds + 32768); float mxk = kred[tid];
        for (int w = 1; w < 8; ++w) mxk = fmaxf(mxk, kred[2 * w + tid]);
        atomicMax((unsigned*)(p.ws + WS_CTL) + CW_KMAX + (((l * 2 + b) * 4 + h) * 2 + tid) * 64, __builtin_bit_cast(unsigned, mxk)); }
#pragma unroll
    for (int i = 0; i < 2; ++i) { const int q = tid + 512 * i, dv = q >> 3, ch = q & 7;
        if (st) *(u32x4*)(VT + ((size_t)(b * 4 + h) * 128 + dv) * POSB + g64 * 64 + ch * 8) = *(const u32x4*)(t + dv * 72 + ch * 8); }
    __syncthreads();
    GSTAMP(11);
}

__device__ __forceinline__ void phase_c(PRef p, int l, char* lds, const bool st) {
    constexpr int NU = NCH * 16, NV = 2 * 4 * 132;
    for (int it = blockIdx.x; it < NU + NV; it += gridDim.x) {
        if (it < NV) vt_item(p, l, it, lds, st);
        else { const int u = it - NV, c = u % NCH, rest = u / NCH; lin_u_item(p, l, (c << 4) | rest, lds, st); }
    }
}

__device__ __forceinline__ void phase_d(PRef p, int l, const bool st) {
    const int gt = blockIdx.x * NTHR + tid_now();
    if (gt >= 32 * 2048) return;
    const int e = gt & 2047, chain = gt >> 11;
    const int dir = chain & 1, type = (chain >> 1) & 1, h = (chain >> 2) & 3, b = chain >> 4;
    float* U = (float*)(p.ws + WS_US) + (size_t)chain * NCH * 2048 + e;
    const float* DEC = (const float*)(p.ws + WS_DEC) + ((size_t)(b * 4 + h) * 2 + dir) * NCH * 32 + (e >> 6);
    const float* sc = (const float*)(p.ws + WS_SCAL) + l * 16;
    const float dret = __expf(128.f * sc[2 + dir * 4 + h]);
    float S = 0.f;
#pragma unroll 1
    for (int s0 = 0; s0 < NCH; s0 += 22) {
        float u[22], dd[22];
#pragma unroll
        for (int q = 0; q < 22; ++q) { const int s = s0 + q, c = dir == 0 ? s : (s < 2 ? 1 - s : 67 - s); u[q] = U[(size_t)c * 2048]; dd[q] = type ? DEC[c * 32] : dret; }
#pragma unroll
        for (int q = 0; q < 22; ++q) { const int s = s0 + q, c = dir == 0 ? s : (s < 2 ? 1 - s : 67 - s); if (st) U[(size_t)c * 2048] = S; S = dd[q] * S + u[q]; }
        if (!st && S == 12345.678f) U[0] = S;
    }
}

__device__ __forceinline__ void lin_out_item(PRef p, int l, int item, char* lds) {
    unsigned long long g_t0 = PROBE_SUB ? __builtin_amdgcn_s_memrealtime() : 0ull;
    const int tid = tid_now(), lane = tid & 63, wid = tid >> 6;
    const int type = item & 1, h = (item >> 1) & 3, b = (item >> 3) & 1, c = item >> 4;
    const LinCfg cf = lin_cfg(type, h);
    const int r0 = b * POSB + c * 128;
    lin_prefix(p, l, type, h, r0, true, lds);
    GSTAMP(21);
    const float* bf = (const float*)(lds + L_BF); const float* bs = (const float*)(lds + L_BS);
    bf16* qf = (bf16*)(lds + LO_QF); bf16* kf = (bf16*)(lds + LO_KF); bf16* qb = (bf16*)(lds + LO_QB); bf16* kb = (bf16*)(lds + LO_KB);
    bf16* qi = (bf16*)(lds + LO_QI); bf16* st = (bf16*)(lds + LO_ST); bf16* vt = (bf16*)(lds + LO_VT); bf16* W = (bf16*)(lds + LO_W);
    float* ssq = (float*)(lds + LO_SS);
    const bf16* P = (const bf16*)(p.ws + WS_P);
    { const int j = tid >> 2, c = tid & 3;
      const u32x4 q4 = *(const u32x4*)(P + (size_t)(r0 + j) * NP + cf.qcol + 8 * c), k4 = *(const u32x4*)(P + (size_t)(r0 + j) * NP + cf.kcol + 8 * c);
      const unsigned qw[4] = {q4.x, q4.y, q4.z, q4.w}, kw[4] = {k4.x, k4.y, k4.z, k4.w};
      unsigned oqf[4], okf[4], oqb[4], okb[4], oqi[4], oqj[4];
#pragma unroll
      for (int e2 = 0; e2 < 4; ++e2) {
          float vqf[2], vkf[2], vqb[2], vkb[2], vqi[2], vqj[2];
#pragma unroll
          for (int z = 0; z < 2; ++z) { const int kk = 8 * c + 2 * e2 + z;
              const float qv = z ? bfhi(qw[e2]) : bflo(qw[e2]), kv = z ? bfhi(kw[e2]) : bflo(kw[e2]);
              const float f = bf[j * 33 + kk], fm = bf[63 * 33 + kk], sx = bs[j * 33 + kk], sm = bs[64 * 33 + kk];
              vqf[z] = qv * __expf(f - fm); vkf[z] = kv * __expf(fm - f); vqb[z] = qv * __expf(sx - sm); vkb[z] = kv * __expf(sm - sx);
              vqi[z] = qv * __expf(f); vqj[z] = qv * __expf(sx); }
          oqf[e2] = pk2(vqf[0], vqf[1]); okf[e2] = pk2(vkf[0], vkf[1]); oqb[e2] = pk2(vqb[0], vqb[1]); okb[e2] = pk2(vkb[0], vkb[1]);
          oqi[e2] = pk2(vqi[0], vqi[1]); oqj[e2] = pk2(vqj[0], vqj[1]); }
      *(u32x4*)(qf + j * 40 + 8 * c) = (u32x4){oqf[0], oqf[1], oqf[2], oqf[3]}; *(u32x4*)(kf + j * 40 + 8 * c) = (u32x4){okf[0], okf[1], okf[2], okf[3]};
      *(u32x4*)(qb + j * 40 + 8 * c) = (u32x4){oqb[0], oqb[1], oqb[2], oqb[3]}; *(u32x4*)(kb + j * 40 + 8 * c) = (u32x4){okb[0], okb[1], okb[2], okb[3]};
      *(u32x4*)(qi + j * 72 + 8 * c) = (u32x4){oqi[0], oqi[1], oqi[2], oqi[3]}; *(u32x4*)(qi + j * 72 + 32 + 8 * c) = (u32x4){oqj[0], oqj[1], oqj[2], oqj[3]}; }
#pragma unroll
    for (int i = 0; i < 2; ++i) { const int q = tid + 512 * i, j = q >> 3, c = q & 7;
        const u32x4 v4 = *(const u32x4*)(P + (size_t)(r0 + j) * NP + cf.vcol + 8 * c);
        const unsigned vw[4] = {v4.x, v4.y, v4.z, v4.w};
#pragma unroll
        for (int e = 0; e < 4; ++e) { vt[(8 * c + 2 * e) * 136 + j] = (bf16)(vw[e] & 0xffff); vt[(8 * c + 2 * e + 1) * 136 + j] = (bf16)(vw[e] >> 16); } }
    { const float* Sf = (const float*)(p.ws + WS_US) + us_index(b, h, type, 0, c); const float* Sb = (const float*)(p.ws + WS_US) + us_index(b, h, type, 1, c);
      const f32x4 sf4 = *(const f32x4*)(Sf + 4 * tid), sb4 = *(const f32x4*)(Sb + 4 * tid);
      const int kk = (4 * tid) >> 6, dv = (4 * tid) & 63;
#pragma unroll
      for (int e = 0; e < 4; ++e) { st[(dv + e) * 72 + kk] = (bf16)f2bf(sf4[e]); st[(dv + e) * 72 + 32 + kk] = (bf16)f2bf(sb4[e]); } }
    __syncthreads();
    GSTAMP(22);
    const int li = lane & 31, hi = lane >> 5;
    {
        const int bi = wid >> 1;
#pragma unroll
        for (int jj = 0; jj < 2; ++jj) {
            const int bj = (wid & 1) * 2 + jj;
            f32x16 af = {0}, ab = {0};
#pragma unroll
            for (int s = 0; s < 2; ++s) {
                const bf16x8 kfa = *(const bf16x8*)(kf + (bj * 32 + li) * 40 + 16 * s + 8 * hi), qfb = *(const bf16x8*)(qf + (bi * 32 + li) * 40 + 16 * s + 8 * hi);
                const bf16x8 kba = *(const bf16x8*)(kb + (bj * 32 + li) * 40 + 16 * s + 8 * hi), qbb = *(const bf16x8*)(qb + (bi * 32 + li) * 40 + 16 * s + 8 * hi);
                af = __builtin_amdgcn_mfma_f32_32x32x16_bf16(kfa, qfb, af, 0, 0, 0);
                ab = __builtin_amdgcn_mfma_f32_32x32x16_bf16(kba, qbb, ab, 0, 0, 0);
            }
            const int i = bi * 32 + li;
#pragma unroll
            for (int a = 0; a < 4; ++a) {
                float w[4];
#pragma unroll
                for (int q = 0; q < 4; ++q) { const int j = bj * 32 + 8 * a + 4 * hi + q; w[q] = (i >= j ? af[4 * a + q] : 0.f) + (j >= i ? ab[4 * a + q] : 0.f); }
                u32x2 o; o.x = pk2(w[0], w[1]); o.y = pk2(w[2], w[3]);
                *(u32x2*)(W + i * 136 + bj * 32 + 8 * a + 4 * hi) = o;
            }
        }
    }
    __syncthreads();
    GSTAMP(23);
    const int bi = wid >> 1, bd = wid & 1;
    f32x16 o = {0};
#pragma unroll
    for (int s = 0; s < 8; ++s) {
        const bf16x8 va = *(const bf16x8*)(vt + (bd * 32 + li) * 136 + 16 * s + 8 * hi), wb = *(const bf16x8*)(W + (bi * 32 + li) * 136 + 16 * s + 8 * hi);
        o = __builtin_amdgcn_mfma_f32_32x32x16_bf16(va, wb, o, 0, 0, 0);
    }
#pragma unroll
    for (int s = 0; s < 4; ++s) {
        const bf16x8 sa = *(const bf16x8*)(st + (bd * 32 + li) * 72 + 16 * s + 8 * hi), qq = *(const bf16x8*)(qi + (bi * 32 + li) * 72 + 16 * s + 8 * hi);
        o = __builtin_amdgcn_mfma_f32_32x32x16_bf16(sa, qq, o, 0, 0, 0);
    }
    float ss = 0.f;
#pragma unroll
    for (int r = 0; r < 16; ++r) ss += o[r] * o[r];
    ss += __shfl_xor(ss, 32);
    const int tok = bi * 32 + li;
    if (hi == 0) ssq[tok * 2 + bd] = ss;
    __syncthreads();
    const bool need = (l == 0) || (c >= 2);
    if (need) {
        const float rn = rsqrtf((ssq[tok * 2] + ssq[tok * 2 + 1]) * (1.f / 64.f) + EPS);
        bf16* CAT = (bf16*)(p.ws + WS_CAT);
        const float* gg = p.in[15] + l * 64;
#pragma unroll
        for (int a = 0; a < 4; ++a) {
            const int dv = bd * 32 + 8 * a + 4 * hi;
            const u32x2 gt = *(const u32x2*)(P + (size_t)(r0 + tok) * NP + cf.gcol + dv);
            f32x4 g4 = {1.f, 1.f, 1.f, 1.f};
            if (type == 1) g4 = *(const f32x4*)(gg + dv);
            u32x2 ov; ov.x = pk2(o[4 * a] * rn * g4.x * bflo(gt.x), o[4 * a + 1] * rn * g4.y * bfhi(gt.x));
            ov.y = pk2(o[4 * a + 2] * rn * g4.z * bflo(gt.y), o[4 * a + 3] * rn * g4.w * bfhi(gt.y));
            *(u32x2*)(CAT + (size_t)(r0 + tok) * D + cf.ocol + dv) = ov;
        }
    }
    __syncthreads();
    GSTAMP(24);
}

constexpr int AT_STAGE = 32768, AT_K0 = 0, AT_K1 = 8192, AT_V = 16384, AT_X = 0;
#ifndef ATT_SETPRIO
#define ATT_SETPRIO 0
#endif
#define AT_PRIO(x) do { if (ATT_SETPRIO) __builtin_amdgcn_s_setprio(x); } while (0)
#define AT_SB() __builtin_amdgcn_sched_barrier(0)
#define AT_LDK(kfv, Kl) do { _Pragma("unroll") for (int kb = 0; kb < 2; ++kb) _Pragma("unroll") for (int s_ = 0; s_ < 4; ++s_) { const int krow = kb * 32 + qi; \
        kfv[kb][s_] = *(const bf16x8*)((Kl) + krow * 128 + (((2 * s_ + hi) ^ ((krow >> 1) & 7)) << 4)); } } while (0)
#define AT_LDV(vfv, Vl, t) do { const int vrow = 32 * (t) + qi; _Pragma("unroll") for (int c_ = 0; c_ < 4; ++c_) \
        vfv[c_] = *(const bf16x8*)((Vl) + vrow * 128 + (((2 * c_ + hi) ^ ((vrow >> 1) & 7)) << 4)); } while (0)
#define AT_QKM(sTv, kfv) do { AT_PRIO(1); \
        sTv[0] = __builtin_amdgcn_mfma_f32_32x32x16_bf16(kfv[0][0], qf[0], negm, 0, 0, 0); sTv[1] = __builtin_amdgcn_mfma_f32_32x32x16_bf16(kfv[1][0], qf[0], negm, 0, 0, 0); \
        _Pragma("unroll") for (int s_ = 1; s_ < 4; ++s_) { sTv[0] = __builtin_amdgcn_mfma_f32_32x32x16_bf16(kfv[0][s_], qf[s_], sTv[0], 0, 0, 0); \
            sTv[1] = __builtin_amdgcn_mfma_f32_32x32x16_bf16(kfv[1][s_], qf[s_], sTv[1], 0, 0, 0); } \
        AT_PRIO(0); } while (0)
#define AT_SOFTMAX(sTv, pfv) do { float _ls = 0.f; \
        _Pragma("unroll") for (int kb = 0; kb < 2; ++kb) _Pragma("unroll") for (int r = 0; r < 16; ++r) { const float pv = __builtin_amdgcn_exp2f(sTv[kb][r]); sTv[kb][r] = pv; _ls += pv; } \
        lrun += _ls; \
        _Pragma("unroll") for (int kb = 0; kb < 2; ++kb) _Pragma("unroll") for (int ks = 0; ks < 2; ++ks) { \
            u32x4 w; w.x = pk2(sTv[kb][8 * ks + 0], sTv[kb][8 * ks + 1]); w.y = pk2(sTv[kb][8 * ks + 2], sTv[kb][8 * ks + 3]); \
            w.z = pk2(sTv[kb][8 * ks + 4], sTv[kb][8 * ks + 5]); w.w = pk2(sTv[kb][8 * ks + 6], sTv[kb][8 * ks + 7]); pfv[kb][ks] = __builtin_bit_cast(bf16x8, w); } } while (0)
#define AT_PVM(pfv, vfv, t) do { AT_PRIO(1); \
        _Pragma("unroll") for (int c_ = 0; c_ < 4; ++c_) oacc[t] = __builtin_amdgcn_mfma_f32_32x32x16_bf16(vfv[c_], pfv[c_ >> 1][c_ & 1], oacc[t], 0, 0, 0); \
        AT_PRIO(0); } while (0)
__device__ __forceinline__ void attn_finish(PRef p, int l, int b, int h, int qpos0, char* lds, f32x16 (&oacc)[4], const float inv);
__device__ __forceinline__ void attn_unit(PRef p, int l, int b, int h, int qpos0, int nkeys, char* lds) {
    const int tid = tid_now(), lane = tid & 63, wid = __builtin_amdgcn_readfirstlane(tid >> 6), m = wid >> 2, qr = (wid & 3) * 32, qi = lane & 31, hi = lane >> 5;
    const bf16* P = (const bf16*)(p.ws + WS_P); const bf16* VT = (const bf16*)(p.ws + WS_VT);
    const size_t rowb = (size_t)b * POSB;
    LAS unsigned char* l3 = (LAS unsigned char*)lds;
    const bf16* gbase = wid < 4 ? P + rowb * NP + 2048 + h * 128 : VT + (size_t)(b * 4 + h) * 128 * POSB;
    const unsigned ginc = wid < 4 ? 64u * NP : 64u;
    unsigned go[4]; unsigned ldst[4];
#pragma unroll
    for (int j = 0; j < 4; ++j) {
        const int g = wid * 4 + j;
        const int r = 8 * (g & 7) + (g >= 16 ? 64 * ((g >> 3) & 1) : 0) + (lane >> 3);
        const int c = (lane & 7) ^ ((r >> 1) & 7);
        if (g < 16) { go[j] = (unsigned)r * NP + (g >> 3) * 64 + c * 8; ldst[j] = (g < 8 ? AT_K0 : AT_K1) + (8 * (g & 7)) * 128; }
        else { go[j] = (unsigned)r * POSB + c * 8; ldst[j] = AT_V + (8 * (g & 7) + 64 * ((g >> 3) & 1)) * 128; }
    }
#define AT_ISSUE(stage, kt) do { const bf16* _gb = gbase + (size_t)(kt) * ginc; _Pragma("unroll") for (int _j = 0; _j < 4; ++_j) \
        __builtin_amdgcn_global_load_lds((const unsigned*)(_gb + go[_j]), (LAS unsigned*)(l3 + (stage) * AT_STAGE + ldst[_j]), 16, 0, 0); } while (0)
    bf16x8 qf[4]; float q2 = 0.f;
    { const bf16* qp = P + (rowb + qpos0 + qr + qi) * NP + 1536 + h * 128 + m * 64 + 8 * hi;
#pragma unroll
      for (int s = 0; s < 4; ++s) { const u32x4 w = *(const u32x4*)(qp + 16 * s); qf[s] = __builtin_bit_cast(bf16x8, w);
          q2 += bflo(w.x) * bflo(w.x) + bfhi(w.x) * bfhi(w.x) + bflo(w.y) * bflo(w.y) + bfhi(w.y) * bfhi(w.y) + bflo(w.z) * bflo(w.z) + bfhi(w.z) * bfhi(w.z) + bflo(w.w) * bflo(w.w) + bfhi(w.w) * bfhi(w.w); } }
    q2 += __shfl_xor(q2, 32);
    const float k2 = __builtin_bit_cast(float, __hip_atomic_load((const unsigned*)(p.ws + WS_CTL) + CW_KMAX + (((l * 2 + b) * 4 + h) * 2 + m) * 64, __ATOMIC_RELAXED, __HIP_MEMORY_SCOPE_AGENT));
    const float mq = sqrtf(q2 * k2) * 1.002f + 1e-6f;
    f32x16 negm;
#pragma unroll
    for (int r = 0; r < 16; ++r) negm[r] = -mq;
    asm volatile("" : "+v"(negm));
    asm volatile("s_waitcnt vmcnt(0)" ::: "memory");
    const int nt = nkeys >> 6;
    AT_ISSUE(0, 0);
    if (nt > 1) AT_ISSUE(1, 1);
    f32x16 oacc[4];
#pragma unroll
    for (int t = 0; t < 4; ++t) oacc[t] = (f32x16){0};
    float lrun = 0.f;
    bf16x8 pf[2][2];
#pragma unroll
    for (int i = 0; i < 2; ++i)
#pragma unroll
        for (int j = 0; j < 2; ++j) pf[i][j] = (bf16x8){0, 0, 0, 0, 0, 0, 0, 0};
    int stage = 0;
#pragma unroll 1
    for (int kt = 0; kt < nt; ++kt) {
        if (kt + 1 < nt) asm volatile("s_waitcnt vmcnt(4)" ::: "memory"); else asm volatile("s_waitcnt vmcnt(0)" ::: "memory");
        __builtin_amdgcn_s_barrier();
        if (kt + 2 < nt) AT_ISSUE((stage + 2) & 3, kt + 2);
        const char* Kl = lds + stage * AT_STAGE + (m ? AT_K1 : AT_K0);
        f32x16 sT[2]; bf16x8 kf[2][4];
        {
            const char* Vc = lds + stage * AT_STAGE + AT_V;
            bf16x8 va[4], vb[4];
            AT_LDK(kf, Kl); AT_SB();
            AT_QKM(sT, kf); AT_SB();
            AT_LDV(va, Vc, 0); AT_LDV(vb, Vc, 1); AT_SB();
            AT_SOFTMAX(sT, pf); AT_SB();
            AT_PVM(pf, va, 0); AT_SB(); AT_LDV(va, Vc, 2); AT_SB(); AT_PVM(pf, vb, 1); AT_SB(); AT_LDV(vb, Vc, 3); AT_SB(); AT_PVM(pf, va, 2); AT_SB(); AT_PVM(pf, vb, 3); AT_SB();
        }
        stage = (stage + 1) & 3;
    }
#undef AT_ISSUE
    const float ltot = lrun + __shfl_xor(lrun, 32);
    const float inv = 1.f / ltot;
    __syncthreads();
    return attn_finish(p, l, b, h, qpos0, lds, oacc, inv);
}
__device__ __forceinline__ void attn_finish(PRef p, int l, int b, int h, int qpos0, char* lds, f32x16 (&oacc)[4], const float inv) {
    const int tid = tid_now(), lane = tid & 63, wid = __builtin_amdgcn_readfirstlane(tid >> 6), m = wid >> 2, qr = (wid & 3) * 32, qi = lane & 31, hi = lane >> 5;
    const size_t rowb = (size_t)b * POSB;
    float* X = (float*)(lds + AT_X) + (wid & 3) * 4096;
    if (m == 1) {
#pragma unroll
        for (int t = 0; t < 4; ++t)
#pragma unroll
            for (int r = 0; r < 16; ++r) X[(t * 16 + r) * 64 + lane] = oacc[t][r] * inv;
    }
    __syncthreads();
    if (m == 0) {
        const float* sc = (const float*)(p.ws + WS_SCAL) + l * 16;
        const float lam = sc[0], post = 1.f - sc[1];
        float ss = 0.f;
#pragma unroll
        for (int t = 0; t < 4; ++t)
#pragma unroll
            for (int r = 0; r < 16; ++r) { const float v = oacc[t][r] * inv - lam * X[(t * 16 + r) * 64 + lane]; oacc[t][r] = v; ss += v * v; }
        ss += __shfl_xor(ss, 32);
        const float rn = rsqrtf(ss * (1.f / 128.f) + EPS) * post;
        bf16* CAT = (bf16*)(p.ws + WS_CAT) + (rowb + qpos0 + qr + qi) * D + 512 + h * 128;
        const float* dg = p.in[17] + l * 128;
#pragma unroll
        for (int t = 0; t < 4; ++t)
#pragma unroll
            for (int a = 0; a < 4; ++a) {
                const int dv = 32 * t + 8 * a + 4 * hi;
                const f32x4 g4 = *(const f32x4*)(dg + dv);
                u32x2 ov; ov.x = pk2(oacc[t][4 * a] * rn * g4.x, oacc[t][4 * a + 1] * rn * g4.y); ov.y = pk2(oacc[t][4 * a + 2] * rn * g4.z, oacc[t][4 * a + 3] * rn * g4.w);
                *(u32x2*)(CAT + dv) = ov;
            }
    }
    __syncthreads();
}

__device__ __forceinline__ void phase_e(PRef p, int l, char* lds) {
    const int n_att = 512 + (l == 0 ? 16 : 0);
    const int n_lin = NCH * 16;
    for (int it = blockIdx.x; it < n_att + n_lin; it += gridDim.x) {
        if (it < 512) { const int bh = it & 7, qb = it >> 3; attn_unit(p, l, bh >> 2, bh & 3, CTX + qb * 128, POSB, lds); }
        else if (it < n_att) { const int u = it - 512, bh = u & 7, qb = u >> 3; attn_unit(p, l, bh >> 2, bh & 3, qb * 128, CTX, lds); }
        else { const int item = it - n_att; if (l == 0 || (item >> 4) >= 2) lin_out_item(p, l, item, lds); }
    }
}

__device__ __forceinline__ void phase_f(PRef p, int l, char* lds) {
    DenseSched S{(l == 0) ? 66 : 64, 4, ((l == 0) ? 66 : 64) * 4, l != 0};
    EpiBf16 E{(bf16*)(p.ws + WS_MO), D};
    pg8::gemm_phase<EpiBf16, DenseSched, false>((LAS unsigned char*)lds, (const bf16*)(p.ws + WS_CAT), (const bf16*)(p.ws + WS_WOUT), D, S, E);
}

__device__ __forceinline__ int ffn_row(int l, int idx) {
    if (l == 0) return idx;
    const int b = idx >> 13, t = idx & 8191; return b * POSB + CTX + t;
}
constexpr int GR_STRIDE = 2064, GR_HI = 0, GR_LO = 32 * GR_STRIDE, GR_LG = 64 * GR_STRIDE;
constexpr int GR_HIST = GR_LG + 8192, GR_BASE = GR_HIST + 256, GR_PAIR = GR_BASE + 256;
static_assert(GR_PAIR + 2048 <= LDS_MISC, "router LDS");
__device__ __forceinline__ void phase_g(PRef p, int l, char* lds, const bool st) {
    unsigned long long g_t0 = PROBE_SUB ? __builtin_amdgcn_s_memrealtime() : 0ull;
    const int tid = tid_now(), lane = tid & 63, wave = __builtin_amdgcn_readfirstlane(tid >> 6);
    const int ntok = (l == 0) ? R : BATCH * SEQ;
    const float* mods = (const float*)(p.ws + WS_MODS) + (size_t)l * 3 * 6144;
    const float* gpost = p.in[7] + l * D; const float* gpre = p.in[8] + l * D;
    const float bias = p.in[19][l * NEXP + lane];
    const bf16* MO = (const bf16*)(p.ws + WS_MO); bf16* HL = (bf16*)(p.ws + WS_HL);
    const bf16* WRH = (const bf16*)(p.ws + WS_WRH); const bf16* WRL = (const bf16*)(p.ws + WS_WRL);
    float* LG = (float*)(lds + GR_LG);
    unsigned* cnt = (unsigned*)(p.ws + WS_CTL) + CW_CNT + l * 4096;
    int* rowtok = (int*)(p.ws + WS_ROWTOK); int* pslot = (int*)(p.ws + WS_PSLOT); float* pw = (float*)(p.ws + WS_PW);
    int* hist = (int*)(lds + GR_HIST); int* base = (int*)(lds + GR_BASE); int* pair_i = (int*)(lds + GR_PAIR); float* pair_w = (float*)(lds + GR_PAIR + 1024);
    for (int g0 = blockIdx.x * 32; g0 < ntok; g0 += gridDim.x * 32) {
#pragma unroll 1
        for (int hf = 0; hf < 2; ++hf) {
            const float* gpost_ = gpost; const float* gpre_ = gpre; asm volatile("" : "+s"(gpost_), "+s"(gpre_));
            f32x4 mv[2][4], xv[2][4];
            int rowv[2]; const float* mdv[2];
#pragma unroll
            for (int rr = 0; rr < 2; ++rr) {
                const int row = ffn_row(l, g0 + 4 * wave + 2 * hf + rr); rowv[rr] = row;
                const int b = row_b(row), pos = row - b * POSB, rt = pos < CTX ? 2 : b; mdv[rr] = mods + rt * 6144;
                const float* xr = resid_row_ptr(p, l, row); const bf16* mr = MO + (size_t)row * D;
#pragma unroll
                for (int j = 0; j < 4; ++j) { const u32x2 mb = *(const u32x2*)(mr + 4 * lane + 256 * j); mv[rr][j] = (f32x4){bflo(mb.x), bfhi(mb.x), bflo(mb.y), bfhi(mb.y)}; xv[rr][j] = *(const f32x4*)(xr + 4 * lane + 256 * j); }
            }
            f32x4 gp4[4], gq4[4];
#pragma unroll
            for (int j = 0; j < 4; ++j) { gp4[j] = *(const f32x4*)(gpost_ + 4 * lane + 256 * j); gq4[j] = *(const f32x4*)(gpre_ + 4 * lane + 256 * j); }
            float ss[2], ss2[2];
#pragma unroll
            for (int rr = 0; rr < 2; ++rr) { ss[rr] = 0.f;
#pragma unroll
                for (int j = 0; j < 4; ++j) ss[rr] += mv[rr][j].x * mv[rr][j].x + mv[rr][j].y * mv[rr][j].y + mv[rr][j].z * mv[rr][j].z + mv[rr][j].w * mv[rr][j].w; }
#pragma unroll
            for (int o = 1; o < 64; o <<= 1) {
#pragma unroll
                for (int rr = 0; rr < 2; ++rr) ss[rr] += __shfl_xor(ss[rr], o); }
#pragma unroll
            for (int rr = 0; rr < 2; ++rr) {
                const float* md = mdv[rr]; float* xo = resid_row_out(p, rowv[rr]);
                const float r1 = rsqrtf(ss[rr] * (1.f / D) + EPS);
                ss2[rr] = 0.f;
#pragma unroll
                for (int j = 0; j < 4; ++j) { const int k0 = 4 * lane + 256 * j;
                    const f32x4 gt = *(const f32x4*)(md + 2 * D + k0);
                    xv[rr][j] = xv[rr][j] + gt * (mv[rr][j] * r1 * gp4[j]);
                    if (st) *(f32x4*)(xo + k0) = xv[rr][j];
                    ss2[rr] += xv[rr][j].x * xv[rr][j].x + xv[rr][j].y * xv[rr][j].y + xv[rr][j].z * xv[rr][j].z + xv[rr][j].w * xv[rr][j].w; }
            }
#pragma unroll
            for (int o = 1; o < 64; o <<= 1) {
#pragma unroll
                for (int rr = 0; rr < 2; ++rr) ss2[rr] += __shfl_xor(ss2[rr], o); }
#pragma unroll
            for (int rr = 0; rr < 2; ++rr) {
                const int lr = 4 * wave + 2 * hf + rr;
                const int row = rowv[rr];
                const float* md = mdv[rr];
                const float r2 = rsqrtf(ss2[rr] * (1.f / D) + EPS);
#pragma unroll
                for (int j = 0; j < 4; ++j) { const int k0 = 4 * lane + 256 * j;
                    const f32x4 s1 = *(const f32x4*)(md + 4 * D + k0), s0 = *(const f32x4*)(md + 3 * D + k0);
                    const f32x4 hv = xv[rr][j] * r2 * gq4[j] * (s1 + 1.f) + s0;
                    unsigned hb[4], lb[4];
#pragma unroll
                    for (int i = 0; i < 4; ++i) { hb[i] = f2bf(hv[i]); lb[i] = f2bf(hv[i] - __builtin_bit_cast(float, hb[i] << 16)); }
                    u32x2 oh; oh.x = hb[0] | (hb[1] << 16); oh.y = hb[2] | (hb[3] << 16);
                    u32x2 ol; ol.x = lb[0] | (lb[1] << 16); ol.y = lb[2] | (lb[3] << 16);
                    if (st) *(u32x2*)(HL + (size_t)row * D + k0) = oh;
                    *(u32x2*)(lds + GR_HI + lr * GR_STRIDE + 2 * k0) = oh;
                    *(u32x2*)(lds + GR_LO + lr * GR_STRIDE + 2 * k0) = ol; }
            }
        }
        if (tid < 64) hist[tid] = 0;
        __syncthreads();
        GSTAMP(1);
        {
            const int et = wave & 3, tt = wave >> 2, fr = lane & 15, fq = lane >> 4;
            const bf16* wh = WRH + (size_t)(et * 16 + fr) * D + 8 * fq; const bf16* wl = WRL + (size_t)(et * 16 + fr) * D + 8 * fq;
            const char* hh = lds + GR_HI + (tt * 16 + fr) * GR_STRIDE + 16 * fq; const char* hl2 = lds + GR_LO + (tt * 16 + fr) * GR_STRIDE + 16 * fq;
            f32x4 acc = {0.f, 0.f, 0.f, 0.f};
#pragma unroll 1
            for (int s0 = 0; s0 < 32; s0 += 8) {
                bf16x8 whi[8], wlo[8];
#pragma unroll
                for (int i = 0; i < 8; ++i) { whi[i] = *(const bf16x8*)(wh + 32 * (s0 + i)); wlo[i] = *(const bf16x8*)(wl + 32 * (s0 + i)); }
                __builtin_amdgcn_sched_barrier(0);
#pragma unroll
                for (int i = 0; i < 8; ++i) {
                    const bf16x8 hhi = *(const bf16x8*)(hh + 64 * (s0 + i)), hlo = *(const bf16x8*)(hl2 + 64 * (s0 + i));
                    acc = __builtin_amdgcn_mfma_f32_16x16x32_bf16(whi[i], hhi, acc, 0, 0, 0);
                    acc = __builtin_amdgcn_mfma_f32_16x16x32_bf16(whi[i], hlo, acc, 0, 0, 0);
                    acc = __builtin_amdgcn_mfma_f32_16x16x32_bf16(wlo[i], hhi, acc, 0, 0, 0);
                }
                __builtin_amdgcn_sched_barrier(0);
            }
            *(f32x4*)(LG + (tt * 16 + fr) * 64 + et * 16 + 4 * fq) = acc;
        }
        __syncthreads();
        GSTAMP(2);
#pragma unroll
        for (int rr = 0; rr < 4; ++rr) {
            const int lr = 4 * wave + rr;
            const int row = ffn_row(l, g0 + lr);
            const float score = 1.f / (1.f + __expf(-LG[lr * 64 + lane]));
            const float sel = score + bias;
            const int grp = lane >> 3;
            float m1 = sel; m1 = fmaxf(m1, __shfl_xor(m1, 1)); m1 = fmaxf(m1, __shfl_xor(m1, 2)); m1 = fmaxf(m1, __shfl_xor(m1, 4));
            const unsigned long long bm = __ballot(sel == m1);
            const int first = __builtin_ctz((unsigned)((bm >> (8 * grp)) & 0xffull)) + 8 * grp;
            float m2 = (lane == first) ? -INFINITY : sel; m2 = fmaxf(m2, __shfl_xor(m2, 1)); m2 = fmaxf(m2, __shfl_xor(m2, 2)); m2 = fmaxf(m2, __shfl_xor(m2, 4));
            const float gs = m1 + m2;
            int rank = 0;
#pragma unroll
            for (int g2 = 0; g2 < 8; ++g2) { const float o = __shfl(gs, 8 * g2); rank += (o > gs || (o == gs && g2 < grp)) ? 1 : 0; }
            float mv = rank < 4 ? sel : -INFINITY;
            float wsum = 0.f; float myw = 0.f; int mye = 0;
#pragma unroll
            for (int k = 0; k < 6; ++k) {
                const float mx = wave_max(mv);
                const unsigned long long b2 = __ballot(mv == mx);
                const int e = __builtin_ctzll(b2);
                const float sce = __shfl(score, e);
                wsum += sce;
                if (lane == k) { myw = sce; mye = e; }
                if (lane == e) mv = -INFINITY;
            }
            if (lane < 6) { const int lrk = atomicAdd(hist + mye, 1); pair_i[lr * 8 + lane] = (mye << 16) | lrk; pair_w[lr * 8 + lane] = myw / wsum * 2.5f; }
        }
        __syncthreads();
        GSTAMP(3);
        if (st && tid < 64) { const int hc = hist[tid]; if (hc > 0) base[tid] = (int)atomicAdd(cnt + tid * 64, (unsigned)hc); }
        __syncthreads();
        if (st && tid < 192) { const int lr = tid / 6, k = tid - lr * 6; const int row = ffn_row(l, g0 + lr);
            const int pi = pair_i[lr * 8 + k], e = pi >> 16, rk = base[e] + (pi & 0xffff);
            rowtok[e * CAP + rk] = row; pslot[row * 8 + k] = (e << 16) | rk; pw[row * 8 + k] = pair_w[lr * 8 + k]; }
        GSTAMP(4);
    }
}

constexpr int M_TBL = 133120;
__device__ __forceinline__ void moe_table(PRef p, int l, char* lds) {
    int* tb = (int*)(lds + M_TBL);
    const unsigned* cnt = (const unsigned*)(p.ws + WS_CTL) + CW_CNT + l * 4096;
    const int t = tid_now();
    if (t < 65) tb[128 + t] = t < 64 ? (int)__hip_atomic_load(cnt + t * 64, __ATOMIC_RELAXED, __HIP_MEMORY_SCOPE_AGENT) : (l == 0 ? R : BATCH * SEQ);
    __syncthreads();
    if (t == 0) {
        int acc = 0;
        for (int e = 0; e < 65; ++e) { const int c = tb[128 + e]; tb[e] = acc; acc += (c + 255) >> 8; }
        tb[65] = acc;
    }
    __syncthreads();
    if (t < 65) { unsigned char* te = (unsigned char*)(tb + 512); for (int i = tb[t]; i < tb[t + 1]; ++i) te[i] = (unsigned char)t; }
    __syncthreads();
}
__device__ __forceinline__ int moe_find(const int* tb, int tile) { return ((const unsigned char*)(tb + 512))[tile]; }

struct MoeSched {
    const int* tb; const int* rowtok; int nsub, nunits, l;
    __device__ __forceinline__ bool next(int i, pg8::Unit& u) const {
        const int L = i * (int)gridDim.x + virt_block(); if (L >= nunits) return false;
        const int tile = L / nsub, sub = L - tile * nsub, e = moe_find(tb, tile);
        u.pm = tile; u.pn = e * nsub + sub; u.e = e; u.ti = tile - tb[e]; return true;
    }
    __device__ __forceinline__ int src_row(const pg8::Unit& u, int r) const {
        const int idx = u.ti * 256 + r; if (idx >= tb[128 + u.e]) return 0;
        return u.e < 64 ? rowtok[u.e * CAP + idx] : ffn_row(l, idx);
    }
};
__device__ __forceinline__ void phase_h(PRef p, int l, char* lds) {
    moe_table(p, l, lds);
    const int* tb = (const int*)(lds + M_TBL);
    MoeSched S{tb, (const int*)(p.ws + WS_ROWTOK), 2, tb[65] * 2, l};
    EpiGateUp E{(bf16*)(p.ws + WS_HB)};
    pg8::gemm_phase<EpiGateUp, MoeSched, true>((LAS unsigned char*)lds, (const bf16*)(p.ws + WS_HL), (const bf16*)(p.ws + WS_WGU), D, S, E);
}
__device__ __forceinline__ void phase_i(PRef p, int l, char* lds) {
    moe_table(p, l, lds);
    const int* tb = (const int*)(lds + M_TBL);
    MoeSched S{tb, (const int*)(p.ws + WS_ROWTOK), 4, tb[65] * 4, l};
    EpiFp8 E{(unsigned char*)(p.ws + WS_Y)};
    pg8::gemm_phase<EpiFp8, MoeSched, false>((LAS unsigned char*)lds, (const bf16*)(p.ws + WS_HB), (const bf16*)(p.ws + WS_WD), DEXP, S, E);
}
__device__ __forceinline__ void phase_j(PRef p, int l, char* lds, const bool st) {
    moe_table(p, l, lds);
    const int* tb = (const int*)(lds + M_TBL);
    const int tid = tid_now(), lane = tid & 63, wave = tid >> 6;
    const int ntok = (l == 0) ? R : BATCH * SEQ;
    const float* mods = (const float*)(p.ws + WS_MODS) + (size_t)l * 3 * 6144;
    const float* gpost = p.in[9] + l * D;
    const unsigned char* Y = (const unsigned char*)(p.ws + WS_Y);
    const int* pslot = (const int*)(p.ws + WS_PSLOT); const float* pw = (const float*)(p.ws + WS_PW);
    const int wstride = (int)gridDim.x * NWAVE;
    for (int base = blockIdx.x * NWAVE + wave; base < ntok; base += 2 * wstride) {
        int idx[2]; bool ok[2]; idx[0] = base; idx[1] = base + wstride; ok[0] = true; ok[1] = idx[1] < ntok; if (!ok[1]) idx[1] = idx[0];
        int ps[2][6]; float pwv[2][6]; int rowv[2];
#pragma unroll
        for (int tk = 0; tk < 2; ++tk) { rowv[tk] = ffn_row(l, idx[tk]);
#pragma unroll
            for (int k = 0; k < 6; ++k) { ps[tk][k] = pslot[rowv[tk] * 8 + k]; pwv[tk][k] = pw[rowv[tk] * 8 + k]; } }
        f32x4 f[2][4];
#pragma unroll
        for (int tk = 0; tk < 2; ++tk) { const unsigned char* yr = Y + ((size_t)tb[64] * 256 + idx[tk]) * D;
#pragma unroll
            for (int j = 0; j < 4; ++j) { const int v = *(const int*)(yr + 4 * lane + 256 * j);
                const f32x2_t lo = __builtin_amdgcn_cvt_pk_f32_fp8(v, false), hi2 = __builtin_amdgcn_cvt_pk_f32_fp8(v, true);
                f[tk][j] = (f32x4){lo.x, lo.y, hi2.x, hi2.y} * 0.03125f; } }
#pragma unroll
        for (int k = 0; k < 6; ++k) {
#pragma unroll
            for (int tk = 0; tk < 2; ++tk) {
                const int e = ps[tk][k] >> 16, rk = ps[tk][k] & 0xffff; const float w = pwv[tk][k] * 0.03125f;
                const unsigned char* yr = Y + ((size_t)tb[e] * 256 + rk) * D;
#pragma unroll
                for (int j = 0; j < 4; ++j) { const int v = *(const int*)(yr + 4 * lane + 256 * j);
                    const f32x2_t lo = __builtin_amdgcn_cvt_pk_f32_fp8(v, false), hi2 = __builtin_amdgcn_cvt_pk_f32_fp8(v, true);
                    f[tk][j].x += w * lo.x; f[tk][j].y += w * lo.y; f[tk][j].z += w * hi2.x; f[tk][j].w += w * hi2.y; }
            }
        }
        float ss[2];
#pragma unroll
        for (int tk = 0; tk < 2; ++tk) { ss[tk] = 0.f;
#pragma unroll
            for (int j = 0; j < 4; ++j) ss[tk] += f[tk][j].x * f[tk][j].x + f[tk][j].y * f[tk][j].y + f[tk][j].z * f[tk][j].z + f[tk][j].w * f[tk][j].w; }
#pragma unroll
        for (int o = 1; o < 64; o <<= 1) { ss[0] += __shfl_xor(ss[0], o); ss[1] += __shfl_xor(ss[1], o); }
        float s2[2];
#pragma unroll
        for (int tk = 0; tk < 2; ++tk) {
            const int row = rowv[tk];
            const int b = row_b(row), pos = row - b * POSB, rt = pos < CTX ? 2 : b;
            const float* md = mods + rt * 6144;
            float* xo = resid_row_out(p, row);
            const float rn = rsqrtf(ss[tk] * (1.f / D) + EPS);
            s2[tk] = 0.f;
#pragma unroll
            for (int j = 0; j < 4; ++j) { const int k0 = 4 * lane + 256 * j;
                const f32x4 gp = *(const f32x4*)(gpost + k0), gt = *(const f32x4*)(md + 5 * D + k0);
                const f32x4 xv = *(const f32x4*)(xo + k0);
                f[tk][j] = xv + gt * (f[tk][j] * rn * gp);
                if (st && ok[tk]) *(f32x4*)(xo + k0) = f[tk][j];
                s2[tk] += f[tk][j].x * f[tk][j].x + f[tk][j].y * f[tk][j].y + f[tk][j].z * f[tk][j].z + f[tk][j].w * f[tk][j].w; }
        }
        if (l == 0) {
#pragma unroll
            for (int o = 1; o < 64; o <<= 1) { s2[0] += __shfl_xor(s2[0], o); s2[1] += __shfl_xor(s2[1], o); }
            const float* gpre1 = p.in[6] + D; bf16* HL = (bf16*)(p.ws + WS_HL); asm volatile("" : "+s"(gpre1), "+s"(HL));
#pragma unroll
            for (int tk = 0; tk < 2; ++tk) {
                const int row = rowv[tk];
                const int b = row_b(row), pos = row - b * POSB, rt = pos < CTX ? 2 : b;
                const float* md1 = mods + rt * 6144 + 3 * 6144;
                const float rs = rsqrtf(s2[tk] * (1.f / D) + EPS);
#pragma unroll
                for (int j = 0; j < 4; ++j) { const int k0 = 4 * lane + 256 * j;
                    const f32x4 g = *(const f32x4*)(gpre1 + k0), s1 = *(const f32x4*)(md1 + D + k0), s0 = *(const f32x4*)(md1 + k0);
                    const f32x4 h = f[tk][j] * rs * g * (s1 + 1.f) + s0;
                    u32x2 o; o.x = pk2(h.x, h.y); o.y = pk2(h.z, h.w);
                    if (st && ok[tk]) *(u32x2*)(HL + (size_t)row * D + k0) = o; }
            }
        }
    }
    if (st && l == 0) { __syncthreads(); convert_weights(p, 1, lds); }
}

__global__ void __launch_bounds__(NTHR, 2) mk_fwd(Params p_arg) {
    extern __shared__ __attribute__((aligned(16))) unsigned char lds_raw[];
    char* lds = (char*)lds_raw;
    volatile unsigned* misc = (volatile unsigned*)(lds + LDS_MISC);
    if (threadIdx.x < 64) misc[threadIdx.x] = 0u;
    __syncthreads();
    XcdBarrier bar; bar.bar = (unsigned*)(p_arg.ws + WS_CTL) + CW_BAR; bar.x = 0; bar.st = misc;
    const int ph_lo = p_arg.ph_lo, ph_hi = p_arg.ph_hi;
    if (ph_hi - ph_lo > 1) bar = xcd_barrier_post((unsigned*)(p_arg.ws + WS_CTL) + CW_BAR, misc);
#ifndef PROBE_MASK
#define PROBE_MASK 0
#endif
#define PROBE_MULT 2
#ifndef ONLY_PHASE
#define ONLY_PHASE -1
#endif
#define PH_ON(k) (ONLY_PHASE < 0 || ((ONLY_PHASE >> (k)) & 1))
#ifndef DBL_MASK
#define DBL_MASK 0
#endif
    unsigned long long t_prev = PROBE_MASK ? __builtin_amdgcn_s_memrealtime() : 0ull, t_acc = 0ull;
#define KARGS() const __attribute__((address_space(4))) Params* pk = (const __attribute__((address_space(4))) Params*)__builtin_amdgcn_kernarg_segment_ptr(); \
        asm volatile("" : "+s"(pk) :: "memory"); PRef p = *pk
#define RUN(ph, ty, call) do { if (ph_lo <= (ph) && (ph) < ph_hi) { { KARGS(); call; } if ((ph) + 1 < ph_hi) xcd_barrier(bar); \
        if (PROBE_MASK) { const unsigned long long t_now = __builtin_amdgcn_s_memrealtime(); if ((PROBE_MASK >> (ty)) & 1) t_acc += t_now - t_prev; t_prev = t_now; } } } while (0)
    RUN(0, 10, if (PH_ON(0)) phase_p0(p, lds));
    RUN(1, 0, if (PH_ON(1)) phase_a(p, 0, lds, true));
    RUN(2, 1, if (PH_ON(2)) phase_b(p, 0, lds));
    RUN(3, 2, if (PH_ON(3)) phase_c(p, 0, lds, true));
    RUN(4, 3, if (PH_ON(4)) phase_d(p, 0, true));
    RUN(5, 4, if (PH_ON(5)) phase_e(p, 0, lds));
    RUN(6, 5, if (PH_ON(6)) phase_f(p, 0, lds));
    RUN(7, 6, if (PH_ON(7)) phase_g(p, 0, lds, true));
    RUN(8, 7, if (PH_ON(8)) phase_h(p, 0, lds));
    RUN(9, 8, if (PH_ON(9)) phase_i(p, 0, lds));
    RUN(10, 9, if (PH_ON(10)) phase_j(p, 0, lds, true));
    RUN(12, 1, if (PH_ON(2)) phase_b(p, 1, lds));
    RUN(13, 2, if (PH_ON(3)) phase_c(p, 1, lds, true));
    RUN(14, 3, if (PH_ON(4)) phase_d(p, 1, true));
    RUN(15, 4, if (PH_ON(5)) phase_e(p, 1, lds));
    RUN(16, 5, if (PH_ON(6)) phase_f(p, 1, lds));
    RUN(17, 6, if (PH_ON(7)) phase_g(p, 1, lds, true));
    RUN(18, 7, if (PH_ON(8)) phase_h(p, 1, lds));
    RUN(19, 8, if (PH_ON(9)) phase_i(p, 1, lds));
    RUN(20, 9, if (PH_ON(10)) phase_j(p, 1, lds, true));
    if (PROBE_SUB && blockIdx.x == 0) { const unsigned long long acc2 = *(volatile unsigned long long*)(lds + LDS_MISC + 128); const unsigned long long t0 = __builtin_amdgcn_s_memrealtime(); while (__builtin_amdgcn_s_memrealtime() - t0 < 4ull * acc2) __builtin_amdgcn_s_sleep(8); }
    if (PROBE_MASK && blockIdx.x == 0) { const unsigned long long t0 = __builtin_amdgcn_s_memrealtime(); while (__builtin_amdgcn_s_memrealtime() - t0 < PROBE_MULT * t_acc) __builtin_amdgcn_s_sleep(8); }
}
}

extern "C" void kernel_launch(void* const* d_in, const int* in_sizes, int n_in, void* d_out, int out_size, void* d_ws, size_t ws_size, hipStream_t stream) {
    static int grid = 0;
    if (grid == 0) {
        if (n_in != 26 || ws_size < WS_END) { fprintf(stderr, "kernel_launch: unexpected n_in %d / ws_size %zu\n", n_in, ws_size); grid = -1; return; }
        int dev = 0, cus = 0, per_cu = 0;
        (void)hipGetDevice(&dev); (void)hipDeviceGetAttribute(&cus, hipDeviceAttributeMultiprocessorCount, dev);
        (void)hipFuncSetAttribute((const void*)mk_fwd, hipFuncAttributeMaxDynamicSharedMemorySize, LDS_BYTES);
        (void)hipOccupancyMaxActiveBlocksPerMultiprocessor(&per_cu, (const void*)mk_fwd, NTHR, LDS_BYTES);
        (void)hipGetLastError();
        if (per_cu < 1) fprintf(stderr, "kernel_launch: occupancy query says %d blocks per CU\n", per_cu);
        grid = cus;
    }
    if (grid < 0) return;
    (void)hipMemsetAsync((char*)d_ws + WS_CTL, 0, 1 * MiB, stream);
    Params p{};
    for (int i = 0; i < 26; ++i) p.in[i] = (const float*)d_in[i];
    p.out = (float*)d_out; p.ws = (unsigned char*)d_ws;
#if MK_LAUNCHES == 1
    p.ph_lo = 0; p.ph_hi = NPHASE;
    hipLaunchKernelGGL(mk_fwd, dim3(grid), dim3(NTHR), LDS_BYTES, stream, p);
#else
    for (int ph = 0; ph < NPHASE; ++ph) { p.ph_lo = ph; p.ph_hi = ph + 1; hipLaunchKernelGGL(mk_fwd, dim3(grid), dim3(NTHR), LDS_BYTES, stream, p); }
#endif
}
```

```cpp
#include <hip/hip_runtime.h>
#include <cstdio>
#include <cstdint>

#ifndef MK_LAUNCHES
#define MK_LAUNCHES 1
#endif

namespace {
typedef unsigned short bf16;
typedef short bf16x8 __attribute__((ext_vector_type(8)));
typedef float f32x4 __attribute__((ext_vector_type(4)));
typedef float f32x16 __attribute__((ext_vector_type(16)));
typedef unsigned u32x4 __attribute__((ext_vector_type(4)));
typedef unsigned u32x2 __attribute__((ext_vector_type(2)));
#define LAS __attribute__((address_space(3)))

constexpr int D = 1024, BATCH = 2, SEQ = 8192, CTX = 256, POSB = SEQ + CTX  , R = BATCH * POSB  ;
constexpr int NIN = 3088, NP = 3072;
constexpr int NEXP = 64, DEXP = 256, CAP = R;
constexpr int NCH = POSB / 128;
constexpr float EPS = 1e-6f;
constexpr int NTHR = 512, NWAVE = 8;
constexpr int NPHASE = 21;
constexpr int HB_ROWS = 134912;

constexpr size_t MiB = 1u << 20;
constexpr size_t WS_CTL = 0;
constexpr size_t WS_MODS = 1 * MiB;
constexpr size_t WS_TAB8 = WS_MODS + 192 * 1024;
constexpr size_t WS_TAB16 = WS_TAB8 + 8192;
constexpr size_t WS_SCAL = WS_TAB16 + 16384;
constexpr size_t WS_WRH = WS_MODS + 256 * 1024;
constexpr size_t WS_WRL = WS_MODS + 384 * 1024;
constexpr size_t WS_WLR = WS_MODS + 512 * 1024;
constexpr size_t WS_GWP = WS_MODS + 576 * 1024;
constexpr size_t WS_HCTX = 2 * MiB;
constexpr size_t WS_ROWTOK = 4 * MiB;
constexpr size_t WS_PSLOT = 9 * MiB;
constexpr size_t WS_PW = 10 * MiB;
constexpr size_t WS_DEC = 11 * MiB;
constexpr size_t WS_WIN = 12 * MiB;
constexpr size_t WS_WOUT = 18 * MiB;
constexpr size_t WS_WGU = 20 * MiB;
constexpr size_t WS_WD = 85 * MiB;
constexpr size_t WS_HL = 118 * MiB;
constexpr size_t WS_HB = 151 * MiB;
constexpr size_t WS_X = 217 * MiB;
constexpr size_t WS_P = WS_X;
constexpr size_t WS_VT = 316 * MiB;
constexpr size_t WS_US = 333 * MiB;
constexpr size_t WS_CAT = 366 * MiB;
constexpr size_t WS_MO = 399 * MiB;
constexpr size_t WS_LA = 465 * MiB;
constexpr size_t WS_Y = WS_X;
constexpr size_t WS_WD1 = 482 * MiB;
constexpr size_t WS_END = 515 * MiB;
static_assert(WS_Y + (size_t)HB_ROWS * 2048 <= WS_END, "Y fits");
static_assert(WS_HB + (size_t)HB_ROWS * 512 <= WS_X, "HB fits");

constexpr int CW_BAR = 4096;
constexpr int CW_CNT = 16384;
constexpr int CW_SCAN = 40960;
constexpr int CW_KMAX = 32768;

constexpr int LDS_BYTES = 147456;
constexpr int LDS_MISC = 147456 - 256;

struct Params { const float* in[26]; float* out; unsigned char* ws; int ph_lo, ph_hi; };
typedef const __attribute__((address_space(4))) Params& PRef;

__device__ __forceinline__ unsigned f2bf(float f) { unsigned u = __builtin_bit_cast(unsigned, f); return (u + 0x7fffu + ((u >> 16) & 1u)) >> 16; }
typedef float f32x2_t __attribute__((ext_vector_type(2)));
typedef __bf16 bf16x2_t __attribute__((ext_vector_type(2)));
__device__ __forceinline__ unsigned pk2(float lo, float hi) { f32x2_t v = {lo, hi}; bf16x2_t b = __builtin_convertvector(v, bf16x2_t); return __builtin_bit_cast(unsigned, b); }
__device__ __forceinline__ float bf2f(unsigned short b) { return __builtin_bit_cast(float, (unsigned)b << 16); }
__device__ __forceinline__ float bflo(unsigned u) { return __builtin_bit_cast(float, u << 16); }
__device__ __forceinline__ float bfhi(unsigned u) { return __builtin_bit_cast(float, u & 0xffff0000u); }
__device__ __forceinline__ float wave_sum(float v) {
#pragma unroll
    for (int o = 1; o < 64; o <<= 1) v += __shfl_xor(v, o);
    return v;
}
__device__ __forceinline__ float wave_max(float v) {
#pragma unroll
    for (int o = 1; o < 64; o <<= 1) v = fmaxf(v, __shfl_xor(v, o));
    return v;
}
template <int CTRL> __device__ __forceinline__ float dpp_f(float v) { return __builtin_bit_cast(float, __builtin_amdgcn_update_dpp(0, __builtin_bit_cast(int, v), CTRL, 0xf, 0xf, true)); }
__device__ __forceinline__ float fmx(float a, float b) { return a > b ? a : b; }
__device__ __forceinline__ float grp8_max(float v) { v = fmx(v, dpp_f<0xB1>(v)); v = fmx(v, dpp_f<0x4E>(v)); return fmx(v, dpp_f<0x141>(v)); }
__device__ __forceinline__ float lane_bcast(float v, int l) { return __builtin_bit_cast(float, __builtin_amdgcn_readlane(__builtin_bit_cast(int, v), l)); }
__device__ __forceinline__ float wave_max_u(float v) {
    v = fmx(grp8_max(v), dpp_f<0x140>(grp8_max(v)));
    return fmx(fmx(lane_bcast(v, 0), lane_bcast(v, 16)), fmx(lane_bcast(v, 32), lane_bcast(v, 48)));
}
__device__ __forceinline__ float wave_sum_u(float v) {
    v += dpp_f<0xB1>(v); v += dpp_f<0x4E>(v); v += dpp_f<0x141>(v); v += dpp_f<0x140>(v);
    return (lane_bcast(v, 0) + lane_bcast(v, 16)) + (lane_bcast(v, 32) + lane_bcast(v, 48));
}
__device__ __forceinline__ float silu_f(float x) { return x * __builtin_amdgcn_rcpf(1.f + __expf(-x)); }
__device__ __forceinline__ float logsig_f(float x) { return fminf(x, 0.f) - log1pf(__expf(-fabsf(x))); }
#define LDS_FENCE() asm volatile("s_waitcnt lgkmcnt(0)" ::: "memory")
#ifndef PROBE_SUB
#define PROBE_SUB 0
#endif

__device__ __forceinline__ int tid_now() { int t = threadIdx.x; asm volatile("" : "+v"(t)); return t; }

#define XB_TMO      128
#define XB_XCNT(j)  (256  + 64 * (j))
#define XB_XSUB(j)  (1280 + 64 * (j))
#define XB_XGEN(j)  (2304 + 64 * (j))
#define XB_TOP      3328
#define XB_TOPGEN   3392
#define XCD_BAR_WORDS 3456
#define XB_SPIN_CAP (1u << 20)
__device__ __forceinline__ unsigned xb_ld(unsigned* p)              { return __hip_atomic_load(p, __ATOMIC_RELAXED, __HIP_MEMORY_SCOPE_AGENT); }
__device__ __forceinline__ unsigned xb_add(unsigned* p, unsigned v) { return __hip_atomic_fetch_add(p, v, __ATOMIC_RELAXED, __HIP_MEMORY_SCOPE_AGENT); }
__device__ __forceinline__ unsigned xb_xcc_id() { return (unsigned)__builtin_amdgcn_s_getreg((3 << 11) | 20) & 0xFu; }
#define XB_SPIN(cond, bar) do { unsigned _sp = 0; while (cond) { __builtin_amdgcn_s_sleep(1); \
    if ((++_sp & 255u) == 0u) { if (xb_ld(&(bar)[XB_TMO])) break; if (_sp > XB_SPIN_CAP) { atomicAdd(&(bar)[XB_TMO], 1u); break; } } } } while (0)
struct XcdBarrier { unsigned* bar; unsigned x; volatile unsigned* st; };
__device__ __forceinline__ XcdBarrier xcd_barrier_post(unsigned* bar, volatile unsigned* st) {
    XcdBarrier b; b.bar = bar; b.x = xb_xcc_id(); b.st = st;
    if (threadIdx.x == 0) (void)xb_add(&bar[XB_XCNT(b.x)], 1u);
    return b;
}
__device__ __forceinline__ void xcd_barrier_complete(unsigned* bar, unsigned x, unsigned& nloc, unsigned& nx) {
    const unsigned G = gridDim.x;
    unsigned sum, cnt, mine, sp = 0u;
    for (;;) {
        sum = 0u; cnt = 0u; mine = 0u;
#pragma unroll
        for (unsigned j = 0; j < 16; ++j) { const unsigned c = xb_ld(&bar[XB_XCNT(j)]); sum += c; cnt += (c > 0u) ? 1u : 0u; mine = (j == x) ? c : mine; }
        if (sum == G) break;
        __builtin_amdgcn_s_sleep(1);
        if ((++sp & 255u) == 0u) { if (xb_ld(&bar[XB_TMO])) break; if (sp > XB_SPIN_CAP) { atomicAdd(&bar[XB_TMO], 1u); break; } }
    }
    nloc = mine > 0u ? mine : 1u; nx = cnt > 0u ? cnt : 1u;
}
__device__ __forceinline__ void xcd_barrier(const XcdBarrier& b) {
    asm volatile("s_waitcnt vmcnt(0)" ::: "memory");
    __syncthreads();
    if (threadIdx.x == 0) {
        unsigned* bar = b.bar;
        __builtin_amdgcn_s_waitcnt(0);
        unsigned nloc = b.st[0], nx = b.st[1];
        if (nloc == 0u) { xcd_barrier_complete(bar, b.x, nloc, nx); b.st[0] = nloc; b.st[1] = nx; }
        const unsigned old = xb_add(&bar[XB_XSUB(b.x)], 1u);
        const unsigned gen = old / nloc;
        if (old + 1u == (gen + 1u) * nloc) {
            __builtin_amdgcn_fence(__ATOMIC_RELEASE, "agent");
            asm volatile("s_waitcnt vmcnt(0)" ::: "memory");
            const unsigned og = xb_add(&bar[XB_TOP], 1u);
            const unsigned tg = og / nx;
            if (og + 1u == (tg + 1u) * nx) xb_add(&bar[XB_TOPGEN], 1u);
            else XB_SPIN(xb_ld(&bar[XB_TOPGEN]) == tg, bar);
            __builtin_amdgcn_fence(__ATOMIC_ACQUIRE, "agent");
            asm volatile("s_waitcnt vmcnt(0)" ::: "memory");
        } else {
            XB_SPIN(xb_ld(&bar[XB_TOPGEN]) == gen, bar);
            __builtin_amdgcn_fence(__ATOMIC_ACQUIRE, "agent");
            asm volatile("s_waitcnt vmcnt(0)" ::: "memory");
        }
    }
    __syncthreads();
}

__device__ __forceinline__ int row_b(int row) { return row >= POSB ? 1 : 0; }

#ifndef CV_GRP
#define CV_GRP 4
#endif
struct CvItem { const float* src; bf16* dst; int ldw, ldt, k0, drow0, dstep; };
__device__ __forceinline__ void cv_item(const CvItem& d, float* scr, int lane) {
    const int kr = lane >> 3, c4 = lane & 7;
#pragma unroll
    for (int g = 0; g < 16; g += CV_GRP) {
        f32x4 v[CV_GRP];
#pragma unroll
        for (int i = 0; i < CV_GRP; ++i) v[i] = __builtin_nontemporal_load((const f32x4*)(d.src + (size_t)(d.k0 + 8 * (g + i) + kr) * d.ldw + 4 * c4));
#pragma unroll
        for (int i = 0; i < CV_GRP; ++i) { float* q = scr + (8 * (g + i) + kr) * 33 + 4 * c4; q[0] = v[i].x; q[1] = v[i].y; q[2] = v[i].z; q[3] = v[i].w; }
        if (CV_GRP < 16) __builtin_amdgcn_sched_barrier(0);
    }
    LDS_FENCE();
    const int c = lane & 15;
#pragma unroll
    for (int j = 0; j < 8; ++j) {
        const int n = (lane >> 4) + 4 * j; const float* s = scr + (8 * c) * 33 + n;
        u32x4 o; o.x = pk2(s[0 * 33], s[1 * 33]); o.y = pk2(s[2 * 33], s[3 * 33]); o.z = pk2(s[4 * 33], s[5 * 33]); o.w = pk2(s[6 * 33], s[7 * 33]);
        const int dr = d.drow0 + (n & 15) + (n >> 4) * d.dstep;
        __builtin_nontemporal_store(o, (u32x4*)(d.dst + (size_t)dr * d.ldt + d.k0 + 8 * c));
    }
    LDS_FENCE();
}

constexpr int CV_IN = 8 * 96, CV_OUT = 8 * 32, CV_GU = 65 * 128, CV_D = 65 * 64, CV_TOTAL = CV_IN + CV_OUT + CV_GU + CV_D;

__device__ __forceinline__ CvItem cv_decode(PRef p, int l, int it) {
    bf16* WIN = (bf16*)(p.ws + WS_WIN); bf16* WOUT = (bf16*)(p.ws + WS_WOUT); bf16* WGU = (bf16*)(p.ws + WS_WGU); bf16* WD = (bf16*)(p.ws + WS_WD);
    CvItem d; int r = it;
    if (r < CV_IN) { const int kb = r / 96, nb = r % 96, n0 = 32 * nb;
        d.src = p.in[10] + (size_t)l * D * NIN + n0 + (n0 >= 1536 ? 16 : 0); d.ldw = NIN; d.k0 = 128 * kb; d.dst = WIN; d.ldt = D; d.drow0 = n0; d.dstep = 16; return d; }
    r -= CV_IN;
    if (r < CV_OUT) { const int kb = r / 32, nb = r % 32;
        d.src = p.in[11] + (size_t)l * D * D + 32 * nb; d.ldw = D; d.k0 = 128 * kb; d.dst = WOUT; d.ldt = D; d.drow0 = 32 * nb; d.dstep = 16; return d; }
    r -= CV_OUT;
    if (r < CV_GU) { const int e = r >> 7, rem = r & 127, which = rem >> 6, it2 = rem & 63, kb = it2 >> 3, nb = it2 & 7, hc0 = 32 * nb;
        d.src = ((e < 64) ? (which ? p.in[21] : p.in[20]) + ((size_t)l * 64 + e) * D * DEXP : (which ? p.in[24] : p.in[23]) + (size_t)l * D * DEXP) + hc0;
        d.ldw = DEXP; d.k0 = 128 * kb; d.dst = WGU + (size_t)e * 512 * D; d.ldt = D;
        d.drow0 = 256 * (hc0 >> 7) + 128 * ((hc0 >> 6) & 1) + 32 * ((hc0 >> 4) & 3) + 16 * which; d.dstep = 32; return d; }
    r -= CV_GU;
    { const int e = r >> 6, it2 = r & 63, kb = it2 >> 5, nb = it2 & 31;
        d.src = ((e < 64) ? p.in[22] + ((size_t)l * 64 + e) * DEXP * D : p.in[25] + (size_t)l * DEXP * D) + 32 * nb;
        d.ldw = D; d.k0 = 128 * kb; d.dst = (l ? (bf16*)(p.ws + WS_WD1) : WD) + (size_t)e * D * DEXP; d.ldt = DEXP; d.drow0 = 32 * nb; d.dstep = 16; return d; }
}

__device__ __forceinline__ void convert_small(PRef p, int l) {
    const int lane = tid_now() & 63, wave = tid_now() >> 6;
    const int gw = blockIdx.x * NWAVE + wave, NGW = gridDim.x * NWAVE;
    { bf16* WRH = (bf16*)(p.ws + WS_WRH); bf16* WRL = (bf16*)(p.ws + WS_WRL); const float* wrt = p.in[18] + (size_t)l * D * NEXP;
      for (int i = gw * 64 + lane; i < D * NEXP; i += NGW * 64) { const int k = i >> 6, e = i & 63; const float w = wrt[i]; const unsigned h = f2bf(w);
          WRH[e * D + k] = (bf16)h; WRL[e * D + k] = (bf16)f2bf(w - __builtin_bit_cast(float, h << 16)); } }
    { bf16* WLR = (bf16*)(p.ws + WS_WLR); bf16* GWP = (bf16*)(p.ws + WS_GWP);
      for (int i = gw * 64 + lane; i < 32 * D; i += NGW * 64) { const int n = i >> 10, k = i & 1023;
          WLR[i] = (bf16)(n < 16 ? f2bf(p.in[10][(size_t)l * D * NIN + (size_t)k * NIN + 1536 + n]) : 0u); }
      for (int i = gw * 64 + lane; i < 256 * 16; i += NGW * 64) { const int c = i >> 4, pos = i & 15, n = (pos & 3) | ((pos & 4) << 1) | ((pos & 8) >> 1);
          GWP[i] = (bf16)f2bf(p.in[13][l * 4096 + ((c >> 7) * 16 + n) * 128 + (c & 127)]); } }
}

constexpr int CB_GU = CV_GU / 8, CB_D = CV_D / 8, CB_IO = (CV_IN + CV_OUT) / 8;
constexpr int CQ_IO1 = CB_GU + CB_D, CQ_D1 = CQ_IO1 + CB_IO, CQ_GU1 = CQ_D1 + CB_D, CQ_END = CQ_GU1 + CB_GU;
#ifndef CP_B0
#define CP_B0 580
#endif
#ifndef CP_F0
#define CP_F0 1192
#endif
#ifndef CP_G0
#define CP_G0 2208
#endif
#ifndef CP_B1
#define CP_B1 2788
#endif
static_assert(CP_B0 <= CQ_IO1 && CP_F0 <= CQ_IO1 + CV_IN / 8 && CP_G0 >= CQ_D1 && CP_G0 <= CQ_GU1 && CP_B1 >= CP_G0 && CP_B1 <= CQ_END, "background ranges");
__device__ __forceinline__ CvItem cq_decode(PRef p, int g) {
    if (g < 8 * CQ_IO1) return cv_decode(p, 0, CV_IN + CV_OUT + g);
    if (g < 8 * CQ_D1) return cv_decode(p, 1, g - 8 * CQ_IO1);
    if (g < 8 * CQ_GU1) return cv_decode(p, 1, CV_IN + CV_OUT + CV_GU + (g - 8 * CQ_D1));
    return cv_decode(p, 1, CV_IN + CV_OUT + (g - 8 * CQ_GU1));
}
__device__ __forceinline__ void cv_pool(PRef p, char* lds, int lo, int hi, int r, int n) {
    const int lane = tid_now() & 63, wave = tid_now() >> 6;
    float* scr = (float*)(lds + wave * 16896);
    __syncthreads();
#pragma unroll 1
    for (int b = lo + r; b < hi; b += n) { const CvItem d = cq_decode(p, b * 8 + wave); cv_item(d, scr, lane); }
}
__device__ __forceinline__ void cv_pool_idle(PRef p, char* lds, int lo, int hi, int rem) {
    if ((int)blockIdx.x >= rem) cv_pool(p, lds, lo, hi, (int)blockIdx.x - rem, (int)gridDim.x - rem);
}

__device__ __forceinline__ void sincos_exact(float ang, float& s, float& c) {
    const double x = (double)ang;
    const double k = rint(x * 0.15915494309189535);
    const double r = x - k * 6.283185307179586476925;
    const double r2 = r * r;
    double ts = r, ss = r, tc = 1.0, cs = 1.0;
#pragma unroll 1
    for (int n = 1; n <= 15; ++n) { ts *= -r2 / (double)((2 * n) * (2 * n + 1)); ss += ts; tc *= -r2 / (double)((2 * n - 1) * (2 * n)); cs += tc; }
    s = (float)ss; c = (float)cs;
}

__device__ __forceinline__ void mods_items(PRef p, char* lds, int first, int last, int rank, int nblk) {
    const int tid = tid_now();
    float* cond = (float*)lds;
    float* red = (float*)(lds + 12288);
    if (rank < 0 || first + rank >= last) return;
    for (int i = tid; i < 3 * D; i += NTHR) { const int r = i >> 10, k = i & 1023; const float v = (r < 2) ? p.in[1][r * D + k] : p.in[3][k]; cond[i] = silu_f(v); }
    __syncthreads();
    for (int item = first + rank; item < last; item += nblk) {
        const int l = item / 192, n0 = (item % 192) * 32;
        const int cg = tid & 7, ks = tid >> 3;
        const float* W = p.in[4] + (size_t)l * D * 6144 + n0 + 4 * cg + (size_t)(ks * 16) * 6144;
        f32x4 w[16];
#pragma unroll
        for (int kk = 0; kk < 16; ++kk) w[kk] = __builtin_nontemporal_load((const f32x4*)(W + (size_t)kk * 6144));
        __builtin_amdgcn_sched_barrier(0);
        f32x4 a0 = {0, 0, 0, 0}, a1 = a0, a2 = a0;
#pragma unroll
        for (int kk = 0; kk < 16; ++kk) { const int k = ks * 16 + kk; a0 += w[kk] * cond[k]; a1 += w[kk] * cond[D + k]; a2 += w[kk] * cond[2 * D + k]; }
#pragma unroll
        for (int i = 0; i < 4; ++i) { red[(ks * 3 + 0) * 32 + 4 * cg + i] = a0[i]; red[(ks * 3 + 1) * 32 + 4 * cg + i] = a1[i]; red[(ks * 3 + 2) * 32 + 4 * cg + i] = a2[i]; }
        __syncthreads();
        if (tid < 96) { const int r = tid >> 5, n = tid & 31; float sm = 0.f;
            for (int q = 0; q < 64; ++q) sm += red[(q * 3 + r) * 32 + n];
            ((float*)(p.ws + WS_MODS))[(l * 3 + r) * 6144 + n0 + n] = sm + p.in[5][l * 6144 + n0 + n]; }
        __syncthreads();
    }
}
__device__ __forceinline__ void tables_item(PRef p) {
    const int tid = tid_now();
    float* t8 = (float*)(p.ws + WS_TAB8); float* t16 = (float*)(p.ws + WS_TAB16);
    const int per = (128 * 8 + 128 * 16 + (int)gridDim.x - 1) / (int)gridDim.x;
    const int i = (int)blockIdx.x * per + tid;
    if (tid < per && i < 128 * 8 + 128 * 16) {
        int pos, fi, q; float* dst;
        if (i < 1024) { pos = i >> 3; fi = i & 7; q = 8; dst = t8 + 2 * i; } else { const int j = i - 1024; pos = j >> 4; fi = j & 15; q = 16; dst = t16 + 2 * j; }
        const float freq = (float)exp(-(double)fi / (double)q * 9.210340371976184);
        const float ang = (float)pos * freq; float s, c; sincos_exact(ang, s, c); dst[0] = c; dst[1] = s;
    }
    if (blockIdx.x == 0 && tid >= 64 && tid < 66) { const int l = tid - 64; const float* lp = p.in[16] + l * 256; float s1 = 0.f, s2 = 0.f;
        for (int i = 0; i < 64; ++i) { s1 += lp[i] * lp[64 + i]; s2 += lp[128 + i] * lp[192 + i]; }
        const float lam_init = 0.8f - 0.6f * expf(-0.3f * (float)l);
        float* sc = (float*)(p.ws + WS_SCAL) + l * 16;
        sc[0] = expf(s1) - expf(s2) + lam_init; sc[1] = lam_init;
        for (int i = 0; i < 8; ++i) sc[2 + i] = logsig_f(p.in[12][l * 8 + i]); }
}
constexpr int MODS_EARLY = 64;
__device__ __forceinline__ void phase_p0(PRef p, char* lds) {
    const int tid = tid_now();
    mods_items(p, lds, 0, MODS_EARLY, (int)blockIdx.x, (int)gridDim.x);
    __syncthreads();
    convert_small(p, 0);
    {
        const int lane = tid & 63, wave = tid >> 6; float* scr = (float*)(lds + wave * 16896);
        const int nb = (int)gridDim.x > 2 * MODS_EARLY ? (int)gridDim.x - MODS_EARLY : (int)gridDim.x, b0 = (int)gridDim.x - nb;
        if ((int)blockIdx.x >= b0) {
#pragma unroll 1
            for (int it = ((int)blockIdx.x - b0) * NWAVE + wave; it < CV_IN + CV_OUT; it += nb * NWAVE) { const CvItem d = cv_decode(p, 0, it); cv_item(d, scr, lane); }
        }
    }
}

__device__ __forceinline__ const float* resid_row_ptr(PRef p, int l, int row) {
    const int b = row_b(row), pos = row - b * POSB;
    if (l == 0) return pos < CTX ? p.in[2] + ((size_t)b * CTX + pos) * D : p.in[0] + ((size_t)b * SEQ + pos - CTX) * D;
    return pos < CTX ? (const float*)(p.ws + WS_HCTX) + ((size_t)b * CTX + pos) * D : p.out + ((size_t)b * SEQ + pos - CTX) * D;
}
__device__ __forceinline__ float* resid_row_out(PRef p, int row) {
    const int b = row_b(row), pos = row - b * POSB;
    return pos < CTX ? (float*)(p.ws + WS_HCTX) + ((size_t)b * CTX + pos) * D : p.out + ((size_t)b * SEQ + pos - CTX) * D;
}

__device__ __forceinline__ void phase_a(PRef p, int l, char* lds, const bool st) {
    if (st) tables_item(p);
    const int tid = tid_now(), lane = tid & 63, wave = tid >> 6;
    const float* mods = (const float*)(p.ws + WS_MODS) + (size_t)l * 3 * 6144;
    const float* gpre = p.in[6] + l * D;
    bf16* HL = (bf16*)(p.ws + WS_HL);
    const int wstride = (int)gridDim.x * NWAVE;
#pragma unroll 1
    for (int base = blockIdx.x * NWAVE + wave; base < R; base += 4 * wstride) {
        f32x4 v[4][4]; int rowv[4]; bool ok[4];
#pragma unroll
        for (int rr = 0; rr < 4; ++rr) { int row = base + rr * wstride; ok[rr] = row < R; if (!ok[rr]) row = base; rowv[rr] = row;
            const float* xr = resid_row_ptr(p, l, row);
#pragma unroll
            for (int j = 0; j < 4; ++j) v[rr][j] = __builtin_nontemporal_load((const f32x4*)(xr + 4 * lane + 256 * j)); }
        f32x4 g[4];
#pragma unroll
        for (int j = 0; j < 4; ++j) g[j] = *(const f32x4*)(gpre + 4 * lane + 256 * j);
        float ss[4];
#pragma unroll
        for (int rr = 0; rr < 4; ++rr) { ss[rr] = 0.f;
#pragma unroll
            for (int j = 0; j < 4; ++j) ss[rr] += v[rr][j].x * v[rr][j].x + v[rr][j].y * v[rr][j].y + v[rr][j].z * v[rr][j].z + v[rr][j].w * v[rr][j].w; }
        f32x4 s1v[4][4], s0v[4][4];
#pragma unroll
        for (int rr = 0; rr < 4; ++rr) { const int row = rowv[rr]; const int b = row_b(row), pos = row - b * POSB, rt = pos < CTX ? 2 : b; const float* sh = mods + rt * 6144;
#pragma unroll
            for (int j = 0; j < 4; ++j) { s1v[rr][j] = *(const f32x4*)(sh + D + 4 * lane + 256 * j); s0v[rr][j] = *(const f32x4*)(sh + 4 * lane + 256 * j); } }
        __builtin_amdgcn_sched_barrier(0);
#pragma unroll
        for (int rr = 0; rr < 4; ++rr) ss[rr] = wave_sum_u(ss[rr]);
#pragma unroll
        for (int rr = 0; rr < 4; ++rr) {
            const int row = rowv[rr];
            const float rs = rsqrtf(ss[rr] * (1.f / D) + EPS);
#pragma unroll
            for (int j = 0; j < 4; ++j) {
                const int k0 = 4 * lane + 256 * j;
                const f32x4 s1 = s1v[rr][j], s0 = s0v[rr][j];
                const f32x4 h = v[rr][j] * rs * g[j] * (s1 + 1.f) + s0;
                u32x2 o; o.x = pk2(h.x, h.y); o.y = pk2(h.z, h.w);
                if (st && ok[rr]) *(u32x2*)(HL + (size_t)row * D + k0) = o;
            }
        }
    }
}

__device__ __forceinline__ float logsig_fast(float x) { return fminf(x, 0.f) - __logf(1.f + __expf(-fabsf(x))); }
__device__ __forceinline__ void lr_tasks(PRef p, int l, int first_blk) {
    if ((int)blockIdx.x < first_blk) return;
    const int tid = tid_now(), lane = tid & 63, wave = tid >> 6, li = lane & 31, hi = lane >> 5;
    const bf16* HL = (const bf16*)(p.ws + WS_HL); float* LA = (float*)(p.ws + WS_LA);
    const bf16* WLR = (const bf16*)(p.ws + WS_WLR); const bf16* GWP = (const bf16*)(p.ws + WS_GWP);
    const float* gb = p.in[14] + l * 256;
    const int nw = ((int)gridDim.x - first_blk) * NWAVE;
    for (int task = ((int)blockIdx.x - first_blk) * NWAVE + wave; task < R / 32; task += nw) {
        const int r0 = task * 32;
        const bf16* ap = WLR + (size_t)li * D + 8 * hi; const bf16* bp = HL + (size_t)(r0 + li) * D + 8 * hi;
        f32x16 lrT = {0};
#pragma unroll 8
        for (int s = 0; s < 64; ++s) lrT = __builtin_amdgcn_mfma_f32_32x32x16_bf16(*(const bf16x8*)(ap + 16 * s), *(const bf16x8*)(bp + 16 * s), lrT, 0, 0, 0);
        u32x4 w; w.x = pk2(lrT[0], lrT[1]); w.y = pk2(lrT[2], lrT[3]); w.z = pk2(lrT[4], lrT[5]); w.w = pk2(lrT[6], lrT[7]);
        const bf16x8 lrb = __builtin_bit_cast(bf16x8, w);
        float* orow = LA + (size_t)(r0 + li) * 256;
        bf16x8 gav[8];
#pragma unroll
        for (int t = 0; t < 8; ++t) gav[t] = *(const bf16x8*)(GWP + (size_t)(32 * t + li) * 16 + 8 * hi);
        f32x4 bball[8][4];
#pragma unroll
        for (int t = 0; t < 8; ++t)
#pragma unroll
            for (int a = 0; a < 4; ++a) bball[t][a] = *(const f32x4*)(gb + 32 * t + 8 * a + 4 * hi);
        __builtin_amdgcn_sched_barrier(0);
#pragma unroll
        for (int t = 0; t < 8; ++t) {
            const bf16x8 ga = gav[t];
            f32x4 bbv[4];
#pragma unroll
            for (int a = 0; a < 4; ++a) bbv[a] = bball[t][a];
            f32x16 z = {0};
            z = __builtin_amdgcn_mfma_f32_32x32x16_bf16(ga, lrb, z, 0, 0, 0);
#pragma unroll
            for (int a = 0; a < 4; ++a) { const int c = 32 * t + 8 * a + 4 * hi;
                const f32x4 bb = bbv[a];
                f32x4 la; la.x = logsig_fast(z[4 * a] + bb.x) * 0.0625f; la.y = logsig_fast(z[4 * a + 1] + bb.y) * 0.0625f;
                la.z = logsig_fast(z[4 * a + 2] + bb.z) * 0.0625f; la.w = logsig_fast(z[4 * a + 3] + bb.w) * 0.0625f;
                *(f32x4*)(orow + c) = la; }
        }
    }
}

namespace pg8 {
constexpr int BM = 256, BK = 64, HALF = 128, HTB = HALF * BK * 2;
__device__ __forceinline__ int lds_byte(int r, int c) { const int st = (r >> 4) * 2 + (c >> 5), rr = r & 15, cc = c & 31, ob = rr * 64 + cc * 2; return st * 1024 + (ob ^ (((ob >> 9) & 1) << 5)); }
__device__ __forceinline__ void stage_rc(int b, int& R, int& C) { const int st = b / 1024, sb = b % 1024, swz = sb ^ (((sb >> 9) & 1) << 5); R = (st >> 1) * 16 + swz / 64; C = (st & 1) * 32 + (swz % 64) / 2; }
struct Unit { int pm, pn, e, ti; };
typedef f32x4 Acc[2][2][4][2];

template <class Epi, class Sched, bool GATHER>
__device__ __forceinline__ void gemm_phase(LAS unsigned char* lds, const bf16* A, const bf16* Bt, const int K, const Sched& S, const Epi& E) {
    const int tid = tid_now(), wid = __builtin_amdgcn_readfirstlane(tid >> 6), lane = tid & 63, wr = wid >> 2, wc = wid & 3, fr = lane & 15, fq = lane >> 4;
    const int nt = K / BK;
    unsigned voffB[2]; int Rst[2], Cst[2];
#pragma unroll
    for (int i = 0; i < 2; ++i) { int Rr, Cc; stage_rc(tid * 16 + i * 8192, Rr, Cc); Rst[i] = Rr; Cst[i] = Cc; voffB[i] = (unsigned)(Rr * K + Cc) * 2u; }
    const size_t kstep = (size_t)(BK * 2), hstep = (size_t)HALF * K * 2, tstep = 2 * hstep;
    const unsigned ldsw = (unsigned)wid * 1024u;
    const int aoff = lds_byte(wr * 64 + fr, fq * 8), boff = lds_byte(wc * 32 + fr, fq * 8);
#define PG8_SA(b, h) (((b) * 2 + (h)) * HTB)
#define PG8_SB(b, h) ((4 + (b) * 2 + (h)) * HTB)
#define PG8_STAGE(bufoff, gbase, voff) do { _Pragma("unroll") for (int _i = 0; _i < 2; ++_i) \
        __builtin_amdgcn_global_load_lds((const unsigned*)((const char*)(gbase) + (voff)[_i]), (LAS unsigned*)(lds + (bufoff) + ldsw + _i * 8192), 16, 0, 0); } while (0)
#define PG8_LDA(dst, b, h) do { _Pragma("unroll") for (int m = 0; m < 4; ++m) _Pragma("unroll") for (int k = 0; k < 2; ++k) dst[m][k] = *(const LAS bf16x8*)(lds + PG8_SA(b, h) + aoff + m * 2048 + k * 1024); } while (0)
#define PG8_LDB(dst, b, h) do { _Pragma("unroll") for (int n = 0; n < 2; ++n) _Pragma("unroll") for (int k = 0; k < 2; ++k) dst[n][k] = *(const LAS bf16x8*)(lds + PG8_SB(b, h) + boff + n * 2048 + k * 1024); } while (0)
#define PG8_MMA(ai, bj, At, Bt_) do { __builtin_amdgcn_s_setprio(1); _Pragma("unroll") for (int m = 0; m < 4; ++m) _Pragma("unroll") for (int n = 0; n < 2; ++n) _Pragma("unroll") for (int k = 0; k < 2; ++k) \
        acc[ai][bj][m][n] = __builtin_amdgcn_mfma_f32_16x16x32_bf16(Bt_[n][k], At[m][k], acc[ai][bj][m][n], 0, 0, 0); __builtin_amdgcn_s_setprio(0); } while (0)
#define PG8_WAIT_V(n) asm volatile("s_waitcnt vmcnt(" #n ")" ::: "memory")
#define PG8_WAIT_L(n) asm volatile("s_waitcnt lgkmcnt(" #n ")" ::: "memory")
#define PG8_BAR __builtin_amdgcn_s_barrier()
#define PG8_SCHED __builtin_amdgcn_sched_barrier(0)
#define PG8_VA(dst, u) do { _Pragma("unroll") for (int _h = 0; _h < 2; ++_h) _Pragma("unroll") for (int _i = 0; _i < 2; ++_i) \
        dst[_h][_i] = GATHER ? (unsigned)(S.src_row(u, _h * HALF + Rst[_i]) * K + Cst[_i]) * 2u : (unsigned)((_h * HALF + Rst[_i]) * K + Cst[_i]) * 2u; } while (0)
    Unit cur, nxt; int ui = 0;
    if (!S.next(0, cur)) return;
    Acc acc;
#pragma unroll
    for (int a = 0; a < 2; ++a)
#pragma unroll
        for (int b = 0; b < 2; ++b)
#pragma unroll
            for (int m = 0; m < 4; ++m)
#pragma unroll
                for (int n = 0; n < 2; ++n) acc[a][b][m][n] = (f32x4){0.f, 0.f, 0.f, 0.f};
    bf16x8 At[4][2], B0[2][2], B1[2][2];
    unsigned vAc[2][2], vAn[2][2];
    PG8_VA(vAc, cur);
    const char* cA = (const char*)A + (GATHER ? (size_t)0 : (size_t)cur.pm * tstep); const char* cB = (const char*)Bt + (size_t)cur.pn * tstep;
    PG8_STAGE(PG8_SB(0, 0), cB, voffB); PG8_STAGE(PG8_SB(0, 1), cB + hstep, voffB); PG8_STAGE(PG8_SA(0, 0), cA, vAc[0]); PG8_STAGE(PG8_SA(0, 1), cA, vAc[1]);
    if (wr == 1) PG8_BAR;
    PG8_WAIT_V(2); PG8_BAR;
    PG8_STAGE(PG8_SB(1, 0), cB + kstep, voffB); PG8_STAGE(PG8_SA(1, 0), cA + kstep, vAc[0]); PG8_STAGE(PG8_SB(1, 1), cB + hstep + kstep, voffB);
    PG8_WAIT_V(6); PG8_BAR;
    for (;;) {
        const bool has_next = S.next(ui + 1, nxt);
        const char* nA = has_next ? (const char*)A + (GATHER ? (size_t)0 : (size_t)nxt.pm * tstep) : cA; const char* nB = has_next ? (const char*)Bt + (size_t)nxt.pn * tstep : cB;
        if (GATHER) { if (has_next) PG8_VA(vAn, nxt); else { vAn[0][0] = vAc[0][0]; vAn[0][1] = vAc[0][1]; vAn[1][0] = vAc[1][0]; vAn[1][1] = vAc[1][1]; } }
#pragma unroll 1
        for (int t = 0; t < nt; t += 2) {
            const bool last = (t == nt - 2);
            const char* a1 = cA + (size_t)(t + 1) * kstep;
            const char* a2 = last ? nA : cA + (size_t)(t + 2) * kstep; const char* b2 = last ? nB : cB + (size_t)(t + 2) * kstep;
            const char* a3 = a2 + kstep; const char* b3 = b2 + kstep;
            PG8_LDB(B0, 0, 0); PG8_LDB(B1, 0, 1); PG8_SCHED; PG8_LDA(At, 0, 0); PG8_STAGE(PG8_SA(1, 1), a1, vAc[1]);
            if (GATHER && last) { vAc[0][0] = vAn[0][0]; vAc[0][1] = vAn[0][1]; vAc[1][0] = vAn[1][0]; vAc[1][1] = vAn[1][1]; }
            PG8_WAIT_V(8); PG8_WAIT_L(0); PG8_BAR; PG8_MMA(0, 0, At, B0); PG8_MMA(0, 1, At, B1); PG8_BAR; PG8_SCHED;
            PG8_LDA(At, 0, 1); PG8_STAGE(PG8_SB(0, 0), b2, voffB); PG8_STAGE(PG8_SB(0, 1), b2 + hstep, voffB); PG8_STAGE(PG8_SA(0, 0), a2, vAc[0]);
            PG8_WAIT_V(8); PG8_WAIT_L(0); PG8_BAR; PG8_MMA(1, 0, At, B0); PG8_MMA(1, 1, At, B1); PG8_BAR; PG8_SCHED;
            PG8_LDB(B0, 1, 0); PG8_LDB(B1, 1, 1); PG8_SCHED; PG8_LDA(At, 1, 0); PG8_STAGE(PG8_SA(0, 1), a2, vAc[1]);
            PG8_WAIT_V(8); PG8_WAIT_L(0); PG8_BAR; PG8_MMA(0, 0, At, B0); PG8_MMA(0, 1, At, B1); PG8_BAR; PG8_SCHED;
            PG8_LDA(At, 1, 1); PG8_STAGE(PG8_SB(1, 0), b3, voffB); PG8_STAGE(PG8_SB(1, 1), b3 + hstep, voffB); PG8_STAGE(PG8_SA(1, 0), a3, vAc[0]);
            PG8_WAIT_V(8); PG8_WAIT_L(0); PG8_BAR; PG8_MMA(1, 0, At, B0); PG8_MMA(1, 1, At, B1); PG8_BAR; PG8_SCHED;
        }
        if (wr == 0) PG8_BAR;
        { unsigned long long g_t0 = PROBE_SUB == 31 ? __builtin_amdgcn_s_memrealtime() : 0ull;
          E(acc, cur, wr, wc, fr, fq);
          if (PROBE_SUB == 31) { asm volatile("s_waitcnt vmcnt(0)" ::: "memory"); const unsigned long long _t = __builtin_amdgcn_s_memrealtime(); if (tid == 0) *(volatile unsigned long long*)((char*)lds + LDS_MISC + 128) += _t - g_t0; } }
        if (!has_next) break;
#pragma unroll
        for (int a = 0; a < 2; ++a)
#pragma unroll
            for (int b = 0; b < 2; ++b)
#pragma unroll
                for (int m = 0; m < 4; ++m)
#pragma unroll
                    for (int n = 0; n < 2; ++n) acc[a][b][m][n] = (f32x4){0.f, 0.f, 0.f, 0.f};
        cur = nxt; cA = nA; cB = nB; ++ui;
        if (wr == 1) PG8_BAR;
    }
    PG8_WAIT_V(0);
    PG8_BAR;
#undef PG8_SA
#undef PG8_SB
#undef PG8_STAGE
#undef PG8_LDA
#undef PG8_LDB
#undef PG8_MMA
#undef PG8_WAIT_V
#undef PG8_WAIT_L
#undef PG8_BAR
#undef PG8_SCHED
#undef PG8_VA
}
}

__device__ __forceinline__ u32x4 pair16(const u32x2 o0, const u32x2 o1, const int fq, int& coloff) {
    const bool odd = fq & 1;
    const auto rx = __builtin_amdgcn_permlane16_swap(o0.x, o1.x, false, false);
    const auto ry = __builtin_amdgcn_permlane16_swap(o0.y, o1.y, false, false);
    coloff = (odd ? 16 : 0) + 4 * (fq & 2);
    return (u32x4){rx[0], ry[0], rx[1], ry[1]};
}
struct EpiInProj {
    bf16* P; const float* tab8; const float* tab16;
    __device__ __forceinline__ void operator()(pg8::Acc& acc, const pg8::Unit& u, int wr, int wc, int fr, int fq) const {
        const int row0 = u.pm * 256;
        const bool lat = (u.pm % 33) != 0;
#pragma unroll
        for (int bj = 0; bj < 2; ++bj) {
            const int c32 = u.pn * 8 + bj * 4 + wc, cb = c32 * 32;
            int kind = 0;
            float scale = 1.f;
            if (c32 < 8) { kind = 1; if (c32 >= 4) scale = 0.17677669529663687f; }
            else if (c32 >= 16 && c32 < 24) kind = 3;
            else if (c32 >= 24 && c32 < 28) scale = 0.17677669529663687f;
            else if (c32 >= 40 && c32 < 48) kind = 3;
            else if (c32 >= 48 && c32 < 80) { kind = 2; if (c32 < 64) scale = 0.18033688011112042f; }
#define EPI_ROWPOS(ai_, m_) const int row = row0 + 128 * (ai_) + 64 * wr + 16 * (m_) + fr; \
            const int pos = row >= POSB ? row - POSB : row, t = pos - CTX, prow = (t >> 6) & 127, pcol = t & 63; (void)prow; (void)pcol
#define EPI_FINISH() do { u32x2 o0, o1; o0.x = pk2(v0.x * scale, v0.y * scale); o0.y = pk2(v0.z * scale, v0.w * scale); o1.x = pk2(v1.x * scale, v1.y * scale); o1.y = pk2(v1.z * scale, v1.w * scale); \
            int co; const u32x4 o16 = pair16(o0, o1, fq, co); *(u32x4*)(P + (size_t)row * NP + cb + co) = o16; } while (0)
            if (kind == 2 && lat) {
                f32x4 T0a[2][4], T1a[2][4];
#pragma unroll
                for (int ai = 0; ai < 2; ++ai)
#pragma unroll
                    for (int m = 0; m < 4; ++m) { EPI_ROWPOS(ai, m); const int pp = (c32 & 1) ? pcol : prow; const float* tb = tab16 + (pp * 16 + 4 * fq) * 2; T0a[ai][m] = *(const f32x4*)tb; T1a[ai][m] = *(const f32x4*)(tb + 4); }
                __builtin_amdgcn_sched_barrier(0);
#pragma unroll
                for (int ai = 0; ai < 2; ++ai) {
#pragma unroll
                    for (int m = 0; m < 4; ++m) { EPI_ROWPOS(ai, m);
                        f32x4 v0 = acc[ai][bj][m][0], v1 = acc[ai][bj][m][1];
                        const f32x4 T0m = T0a[ai][m], T1m = T1a[ai][m];
                        const float cs[4] = {T0m.x, T0m.z, T1m.x, T1m.z}, sn[4] = {T0m.y, T0m.w, T1m.y, T1m.w};
#pragma unroll
                        for (int i = 0; i < 4; ++i) { const float a0 = v0[i], a1 = v1[i]; v0[i] = a0 * cs[i] - a1 * sn[i]; v1[i] = a0 * sn[i] + a1 * cs[i]; }
                        EPI_FINISH(); }
                }
            } else if (kind == 1 && lat) {
#pragma unroll
                for (int ai = 0; ai < 2; ++ai) {
                    f32x4 T0[4][2], T1[4][2];
#pragma unroll
                    for (int m = 0; m < 4; ++m) { EPI_ROWPOS(ai, m);
#pragma unroll
                        for (int n = 0; n < 2; ++n) { const int pp = n ? pcol : prow; const float* tb = tab8 + (pp * 8 + 4 * (fq & 1)) * 2; T0[m][n] = *(const f32x4*)tb; T1[m][n] = *(const f32x4*)(tb + 4); } }
                    __builtin_amdgcn_sched_barrier(0);
#pragma unroll
                    for (int m = 0; m < 4; ++m) { EPI_ROWPOS(ai, m);
                        f32x4 v0 = acc[ai][bj][m][0], v1 = acc[ai][bj][m][1];
#pragma unroll
                        for (int n = 0; n < 2; ++n) {
                            const f32x4 t0 = T0[m][n], t1 = T1[m][n];
                            const float cs[4] = {t0.x, t0.z, t1.x, t1.z}, sn[4] = {t0.y, t0.w, t1.y, t1.w};
                            f32x4& v = n ? v1 : v0;
#pragma unroll
                            for (int i = 0; i < 4; ++i) { const float me = v[i], other = __shfl_xor(me, 32);
                                v[i] = (fq < 2) ? me * cs[i] - other * sn[i] : other * sn[i] + me * cs[i]; }
                        }
                        EPI_FINISH(); }
                }
            } else {
#pragma unroll
                for (int ai = 0; ai < 2; ++ai)
#pragma unroll
                    for (int m = 0; m < 4; ++m) { EPI_ROWPOS(ai, m);
                        f32x4 v0 = acc[ai][bj][m][0], v1 = acc[ai][bj][m][1];
                        if (kind == 3) {
#pragma unroll
                            for (int i = 0; i < 4; ++i) { v0[i] = silu_f(v0[i]); v1[i] = silu_f(v1[i]); }
                        }
                        EPI_FINISH(); }
            }
#undef EPI_ROWPOS
#undef EPI_FINISH
        }
    }
};
struct EpiF32 {
    float* O; int ldo;
    __device__ __forceinline__ void operator()(pg8::Acc& acc, const pg8::Unit& u, int wr, int wc, int fr, int fq) const {
#pragma unroll
        for (int ai = 0; ai < 2; ++ai)
#pragma unroll
            for (int m = 0; m < 4; ++m) { float* rp = O + (size_t)(u.pm * 256 + 128 * ai + 64 * wr + 16 * m + fr) * ldo + (u.pn & 3) * 256 + 32 * wc + 4 * fq;
#pragma unroll
                for (int bj = 0; bj < 2; ++bj)
#pragma unroll
                    for (int n = 0; n < 2; ++n) *(f32x4*)(rp + 128 * bj + 16 * n) = acc[ai][bj][m][n]; }
    }
};
struct EpiBf16 {
    bf16* O; int ldo;
    __device__ __forceinline__ void operator()(pg8::Acc& acc, const pg8::Unit& u, int wr, int wc, int fr, int fq) const {
#pragma unroll
        for (int ai = 0; ai < 2; ++ai)
#pragma unroll
            for (int m = 0; m < 4; ++m) { bf16* rp0 = O + (size_t)(u.pm * 256 + 128 * ai + 64 * wr + 16 * m + fr) * ldo + (u.pn & 3) * 256 + 32 * wc;
#pragma unroll
                for (int bj = 0; bj < 2; ++bj) { const f32x4 v0 = acc[ai][bj][m][0], v1 = acc[ai][bj][m][1];
                    u32x2 o0, o1; o0.x = pk2(v0.x, v0.y); o0.y = pk2(v0.z, v0.w); o1.x = pk2(v1.x, v1.y); o1.y = pk2(v1.z, v1.w);
                    int co; const u32x4 o16 = pair16(o0, o1, fq, co);
                    *(u32x4*)(rp0 + 128 * bj + co) = o16; } }
    }
};
struct EpiFp8 {
    unsigned char* O;
    __device__ __forceinline__ void operator()(pg8::Acc& acc, const pg8::Unit& u, int wr, int wc, int fr, int fq) const {
        const int lane = fr + 16 * fq;
#pragma unroll
        for (int ai = 0; ai < 2; ++ai)
#pragma unroll
            for (int m = 0; m < 4; ++m) {
                unsigned wd[4];
#pragma unroll
                for (int q = 0; q < 4; ++q) { f32x4 v = acc[ai][q >> 1][m][q & 1] * 32.f;
#pragma unroll
                    for (int i = 0; i < 4; ++i) v[i] = fminf(fmaxf(v[i], -440.f), 440.f);
                    int w = 0; w = __builtin_amdgcn_cvt_pk_fp8_f32(v.x, v.y, w, false); w = __builtin_amdgcn_cvt_pk_fp8_f32(v.z, v.w, w, true); wd[q] = (unsigned)w; }
                unsigned ow[4];
                { const auto a01 = __builtin_amdgcn_permlane16_swap(wd[0], wd[1], false, false); const auto a23 = __builtin_amdgcn_permlane16_swap(wd[2], wd[3], false, false);
                  const auto b02 = __builtin_amdgcn_permlane32_swap(a01[0], a23[0], false, false); const auto b13 = __builtin_amdgcn_permlane32_swap(a01[1], a23[1], false, false);
                  ow[0] = b02[0]; ow[2] = b02[1]; ow[1] = b13[0]; ow[3] = b13[1]; }
                unsigned char* rp = O + (size_t)(u.pm * 256 + 128 * ai + 64 * wr + 16 * m + fr) * D + (u.pn & 3) * 256 + 32 * wc + 128 * (fq >> 1) + 16 * (fq & 1);
                *(u32x4*)rp = (u32x4){ow[0], ow[1], ow[2], ow[3]};
                (void)lane;
            }
    }
};
struct EpiGateUp {
    bf16* H;
    __device__ __forceinline__ void operator()(pg8::Acc& acc, const pg8::Unit& u, int wr, int wc, int fr, int fq) const {
#pragma unroll
        for (int ai = 0; ai < 2; ++ai)
#pragma unroll
            for (int m = 0; m < 4; ++m) { bf16* rp = H + (size_t)(u.pm * 256 + 128 * ai + 64 * wr + 16 * m + fr) * DEXP + 128 * (u.pn & 1) + 16 * wc;
                u32x2 o[2];
#pragma unroll
                for (int bj = 0; bj < 2; ++bj) { const f32x4 g = acc[ai][bj][m][0], uu = acc[ai][bj][m][1];
                    o[bj].x = pk2(silu_f(g.x) * uu.x, silu_f(g.y) * uu.y); o[bj].y = pk2(silu_f(g.z) * uu.z, silu_f(g.w) * uu.w); }
                int co; const u32x4 o16 = pair16(o[0], o[1], fq, co);
                *(u32x4*)(rp + (co & 8) + ((co & 16) ? 64 : 0)) = o16; }
    }
};

__device__ __forceinline__ int virt_block() { const int G = (int)gridDim.x, bx = (int)blockIdx.x; return (G % 8 == 0) ? (bx % 8) * (G / 8) + bx / 8 : bx; }
struct DenseSched {
    int nM, nN, nunits, skipctx;
    __device__ __forceinline__ bool next(int i, pg8::Unit& u) const {
        const int L = i * (int)gridDim.x + (int)blockIdx.x; if (L >= nunits) return false;
        int wgid = L; { const int q = nunits / 8, r = nunits % 8, xcd = wgid % 8, off = wgid / 8; wgid = (xcd < r ? xcd * (q + 1) : r * (q + 1) + (xcd - r) * q) + off; }
        const int nig = 8 * nN, gid = wgid / nig, fm = gid * 8, gsz = (nM - fm) < 8 ? (nM - fm) : 8;
        int pm = fm + ((wgid % nig) % gsz); u.pn = (wgid % nig) / gsz;
        if (skipctx) pm = pm + 1 + (pm >= 32 ? 1 : 0); u.pm = pm; u.e = 0; u.ti = 0; return true;
    }
    __device__ __forceinline__ int src_row(const pg8::Unit&, int) const { return 0; }
};
__device__ __forceinline__ void phase_b(PRef p, int l, char* lds) {
    DenseSched S{66, 12, 66 * 12, 0};
    EpiInProj E{(bf16*)(p.ws + WS_P), (const float*)(p.ws + WS_TAB8), (const float*)(p.ws + WS_TAB16)};
    pg8::gemm_phase<EpiInProj, DenseSched, false>((LAS unsigned char*)lds, (const bf16*)(p.ws + WS_HL), (const bf16*)(p.ws + WS_WIN), D, S, E);
    lr_tasks(p, l, (66 * 12) % (int)gridDim.x);
    { const int rem = (66 * 12) % (int)gridDim.x;
      if (l == 0) { __syncthreads(); mods_items(p, lds, MODS_EARLY, 192, (int)blockIdx.x - rem, (int)gridDim.x - rem); }
      cv_pool_idle(p, lds, l ? CP_G0 : 0, l ? CP_B1 : CP_B0, rem); }
}

constexpr int L_BF = 0;
constexpr int L_BS = 16896;
constexpr int L_SEG = 33792;
constexpr int L_A = 36864;
constexpr int LO_QF = 36864;
constexpr int LO_KF = LO_QF + 10240;
constexpr int LO_QB = LO_KF + 10240;
constexpr int LO_KB = LO_QB + 10240;
constexpr int LO_QI = LO_KB + 10240;
constexpr int LO_ST = LO_QI + 18432;
constexpr int LO_VT = LO_ST + 9216;
constexpr int LO_W = 0;
constexpr int LO_SS = LO_VT + 17408;
static_assert(34816 <= L_A, "W overlay");
static_assert(LO_SS + 1024 <= LDS_MISC, "lin LDS");

#define GSTAMP(k) do { if (PROBE_SUB) { const unsigned long long _t = __builtin_amdgcn_s_memrealtime(); if ((PROBE_SUB == (k) || (PROBE_SUB == 20 && (k) >= 21 && (k) <= 24)) && tid_now() == 0) *(volatile unsigned long long*)(lds + LDS_MISC + 128) += _t - g_t0; g_t0 = _t; } } while (0)
struct LinCfg { int type; int qcol, kcol, vcol, gcol, ocol; };

__device__ __forceinline__ void lin_prefix(PRef p, int l, int type, int h, int r0, bool already, char* lds, const bool st = true, const float* pre_la = nullptr) {
    const int tid = tid_now();
    float* bf = (float*)(lds + L_BF); float* bs = (float*)(lds + L_BS); float* seg = (float*)(lds + L_SEG);
    if (type == 0) {
        const float* sc = (const float*)(p.ws + WS_SCAL) + l * 16;
        const float lgf = sc[2 + h], lgb = sc[6 + h];
        for (int i = tid; i < 128 * 32; i += NTHR) { const int j = i >> 5, kk = i & 31; bf[j * 33 + kk] = (float)(j + 1) * lgf; bs[j * 33 + kk] = (float)(128 - j) * lgb; }
        __syncthreads();
        return;
    }
    float* LA = (float*)(p.ws + WS_LA);
    if (already) {
        if (pre_la) {
#pragma unroll
            for (int q = 0; q < 8; ++q) { const int i = tid + NTHR * q, j = i >> 5, kk = i & 31; bf[j * 33 + kk] = pre_la[2 * q]; bs[j * 33 + kk] = pre_la[2 * q + 1]; }
        } else
        for (int i = tid; i < 128 * 32; i += NTHR) { const int j = i >> 5, kk = i & 31; const float* s = LA + (size_t)(r0 + j) * 256 + h * 32 + kk; bf[j * 33 + kk] = s[0]; bs[j * 33 + kk] = s[128]; }
        __syncthreads();
        return;
    }
    if (pre_la) {
#pragma unroll
        for (int q = 0; q < 8; ++q) { const int i = tid + NTHR * q, j = i >> 5, kk = i & 31; bf[j * 33 + kk] = pre_la[2 * q]; bs[j * 33 + kk] = pre_la[2 * q + 1]; }
    } else
    for (int i = tid; i < 128 * 32; i += NTHR) { const int j = i >> 5, kk = i & 31; const float* s = LA + (size_t)(r0 + j) * 256 + h * 32 + kk; bf[j * 33 + kk] = s[0]; bs[j * 33 + kk] = s[128]; }
    __syncthreads();
    const int chain = tid & 63, sg = tid >> 6, dir = chain >> 5, kk = chain & 31;
    float* arr = dir ? bs : bf;
    float tot = 0.f;
    for (int q = 0; q < 16; ++q) tot += arr[(sg * 16 + q) * 33 + kk];
    seg[chain * 8 + sg] = tot;
    __syncthreads();
    float off = 0.f;
    if (dir == 0) { for (int q = 0; q < sg; ++q) off += seg[chain * 8 + q];
        for (int q = 0; q < 16; ++q) { const int j = sg * 16 + q; off += arr[j * 33 + kk]; arr[j * 33 + kk] = off; } }
    else { for (int q = 7; q > sg; --q) off += seg[chain * 8 + q];
        for (int q = 15; q >= 0; --q) { const int j = sg * 16 + q; off += arr[j * 33 + kk]; arr[j * 33 + kk] = off; } }
    __syncthreads();
    if (st) for (int i = tid; i < 128 * 32; i += NTHR) { const int j = i >> 5, k2 = i & 31; float* s = LA + (size_t)(r0 + j) * 256 + h * 32 + k2; s[0] = bf[j * 33 + k2]; s[128] = bs[j * 33 + k2]; }
}

__device__ __forceinline__ LinCfg lin_cfg(int type, int h) {
    LinCfg c; c.type = type;
    if (type == 0) { c.qcol = h * 32; c.kcol = 128 + h * 32; c.vcol = 256 + h * 64; c.gcol = 512 + h * 64; c.ocol = h * 64; }
    else { c.qcol = 768 + h * 32; c.kcol = 896 + h * 32; c.vcol = 1024 + h * 64; c.gcol = 1280 + h * 64; c.ocol = 256 + h * 64; }
    return c;
}
__device__ __forceinline__ size_t us_index(int b, int h, int type, int dir, int c) { return ((((size_t)(b * 4 + h) * 2 + type) * 2 + dir) * NCH + c) * 2048; }

struct UPre { u32x4 kv4, v[2]; float la[16]; };
__device__ __forceinline__ UPre u_load(PRef p, int item) {
    const int tid = tid_now();
    const int type = item & 1, h = (item >> 1) & 3, b = (item >> 3) & 1, c = item >> 4;
    const LinCfg cf = lin_cfg(type, h);
    const int r0 = b * POSB + c * 128;
    const bf16* P = (const bf16*)(p.ws + WS_P);
    UPre r;
    r.kv4 = *(const u32x4*)(P + (size_t)(r0 + (tid >> 2)) * NP + cf.kcol + 8 * (tid & 3));
#pragma unroll
    for (int i = 0; i < 2; ++i) { const int q = tid + 512 * i; r.v[i] = *(const u32x4*)(P + (size_t)(r0 + (q >> 3)) * NP + cf.vcol + 8 * (q & 7)); }
    const float* LA = (const float*)(p.ws + WS_LA);
#pragma unroll
    for (int q = 0; q < 8; ++q) { const int i = tid + NTHR * q, j = i >> 5, kk = i & 31; const float* s = LA + (size_t)(r0 + j) * 256 + h * 32 + kk;
        r.la[2 * q] = type ? s[0] : 0.f; r.la[2 * q + 1] = type ? s[128] : 0.f; }
    return r;
}
__device__ __forceinline__ void lin_u_item(PRef p, int l, int item, const UPre& pre, char* lds, const bool st) {
    unsigned long long g_t0 = PROBE_SUB ? __builtin_amdgcn_s_memrealtime() : 0ull;
    const int tid = tid_now();
    const int type = item & 1, h = (item >> 1) & 3, b = (item >> 3) & 1, c = item >> 4;
    const int r0 = b * POSB + c * 128;
    const u32x4 kv4 = pre.kv4;
    u32x4 vpre[2]; vpre[0] = pre.v[0]; vpre[1] = pre.v[1];
    lin_prefix(p, l, type, h, r0, false, lds, st, pre.la);
    GSTAMP(12);
    const float* bf = (const float*)(lds + L_BF); const float* bs = (const float*)(lds + L_BS);
    bf16* kut = (bf16*)(lds + L_A);
    bf16* vt = kut + 2 * 32 * 136;
    { const int j = tid >> 2, c = tid & 3;
      const unsigned kw[4] = {kv4.x, kv4.y, kv4.z, kv4.w};
#pragma unroll
      for (int e = 0; e < 8; ++e) { const int kk = 8 * c + e; const float kv = (e & 1) ? bfhi(kw[e >> 1]) : bflo(kw[e >> 1]);
          kut[kk * 136 + j] = (bf16)f2bf(kv * __expf(bf[127 * 33 + kk] - bf[j * 33 + kk]));
          kut[(32 + kk) * 136 + j] = (bf16)f2bf(kv * __expf(bs[0 * 33 + kk] - bs[j * 33 + kk])); } }
#pragma unroll
    for (int i = 0; i < 2; ++i) { const int q = tid + 512 * i, j = q >> 3, c = q & 7;
        const unsigned vw[4] = {vpre[i].x, vpre[i].y, vpre[i].z, vpre[i].w};
#pragma unroll
        for (int e = 0; e < 4; ++e) { vt[(8 * c + 2 * e) * 136 + j] = (bf16)(vw[e] & 0xffff); vt[(8 * c + 2 * e + 1) * 136 + j] = (bf16)(vw[e] >> 16); } }
    if (st && type == 1 && tid < 64) { const int dir = tid >> 5, kk = tid & 31;
        ((float*)(p.ws + WS_DEC))[(((size_t)(b * 4 + h) * 2 + dir) * NCH + c) * 32 + kk] = __expf(dir ? bs[kk] : bf[127 * 33 + kk]); }
    __syncthreads();
    GSTAMP(13);
    { const int lane = tid & 63, wid = tid >> 6, li = lane & 31, hi = lane >> 5;
      if (wid < 4) {
          const int dir = wid >> 1, bd = wid & 1;
          f32x16 u = {0};
#pragma unroll
          for (int s = 0; s < 8; ++s) {
              const bf16x8 ka = *(const bf16x8*)(kut + (dir * 32 + li) * 136 + 16 * s + 8 * hi), vb = *(const bf16x8*)(vt + (bd * 32 + li) * 136 + 16 * s + 8 * hi);
              u = __builtin_amdgcn_mfma_f32_32x32x16_bf16(ka, vb, u, 0, 0, 0);
          }
          float* U = (float*)(p.ws + WS_US) + us_index(b, h, type, dir, c) + bd * 32 + li;
          if (st) {
#pragma unroll
              for (int r = 0; r < 16; ++r) U[((r & 3) + 8 * (r >> 2) + 4 * hi) * 64] = u[r]; }
      } }
    __syncthreads();
    GSTAMP(14);
}

struct VtPre { u32x4 v[2], k0, k1; };
__device__ __forceinline__ VtPre vt_load(PRef p, int item) {
    const int tid = tid_now();
    const int g64 = item % 132, h = (item / 132) & 3, b = item / 528;
    const bf16* P = (const bf16*)(p.ws + WS_P);
    VtPre r;
#pragma unroll
    for (int i = 0; i < 2; ++i) { const int q = tid + 512 * i, j = q >> 4, ch = q & 15;
        r.v[i] = *(const u32x4*)(P + (size_t)(b * POSB + g64 * 64 + j) * NP + 2560 + h * 128 + ch * 8); }
    { const int key = tid >> 3, part = tid & 7;
      const bf16* kr = P + (size_t)(b * POSB + g64 * 64 + key) * NP + 2048 + h * 128 + part * 8;
      r.k0 = *(const u32x4*)kr; r.k1 = *(const u32x4*)(kr + 64); }
    return r;
}
__device__ __forceinline__ void vt_item(PRef p, int l, int item, const VtPre& pre, char* lds, const bool st) {
    unsigned long long g_t0 = PROBE_SUB ? __builtin_amdgcn_s_memrealtime() : 0ull;
    const int tid = tid_now();
    const int g64 = item % 132, h = (item / 132) & 3, b = item / 528;
    bf16* VT = (bf16*)(p.ws + WS_VT);
    bf16* t = (bf16*)lds;
#pragma unroll
    for (int i = 0; i < 2; ++i) { const int q = tid + 512 * i, j = q >> 4, ch = q & 15;
        const u32x4 v = pre.v[i];
        const int jp = (j & ~12) | ((j & 4) << 1) | ((j & 8) >> 1);
        const unsigned w[4] = {v.x, v.y, v.z, v.w};
#pragma unroll
        for (int e = 0; e < 4; ++e) { t[(ch * 8 + 2 * e) * 72 + jp] = (bf16)(w[e] & 0xffff); t[(ch * 8 + 2 * e + 1) * 72 + jp] = (bf16)(w[e] >> 16); } }
    { const u32x4 k0 = pre.k0, k1 = pre.k1;
      const unsigned w0[4] = {k0.x, k0.y, k0.z, k0.w}, w1[4] = {k1.x, k1.y, k1.z, k1.w};
      float s0 = 0.f, s1 = 0.f;
#pragma unroll
      for (int e = 0; e < 4; ++e) { s0 += bflo(w0[e]) * bflo(w0[e]) + bfhi(w0[e]) * bfhi(w0[e]); s1 += bflo(w1[e]) * bflo(w1[e]) + bfhi(w1[e]) * bfhi(w1[e]); }
      s0 += dpp_f<0xB1>(s0); s0 += dpp_f<0x4E>(s0); s0 += dpp_f<0x141>(s0); s1 += dpp_f<0xB1>(s1); s1 += dpp_f<0x4E>(s1); s1 += dpp_f<0x141>(s1);
      s0 = wave_max_u(s0); s1 = wave_max_u(s1);
      float* kred = (float*)(lds + 32768);
      if ((tid & 63) == 0) { kred[(tid >> 6) * 2] = s0; kred[(tid >> 6) * 2 + 1] = s1; } }
    __syncthreads();
    if (st && tid < 2) { const float* kred = (const float*)(lds + 32768); float mxk = kred[tid];
        for (int w = 1; w < 8; ++w) mxk = fmaxf(mxk, kred[2 * w + tid]);
        atomicMax((unsigned*)(p.ws + WS_CTL) + CW_KMAX + (((l * 2 + b) * 4 + h) * 2 + tid) * 64, __builtin_bit_cast(unsigned, mxk)); }
#pragma unroll
    for (int i = 0; i < 2; ++i) { const int q = tid + 512 * i, dv = q >> 3, ch = q & 7;
        if (st) *(u32x4*)(VT + ((size_t)(b * 4 + h) * 128 + dv) * POSB + g64 * 64 + ch * 8) = *(const u32x4*)(t + dv * 72 + ch * 8); }
    __syncthreads();
    GSTAMP(11);
}

__device__ __forceinline__ void phase_c(PRef p, int l, char* lds, const bool st) {
    constexpr int NU = NCH * 16, NV = 2 * 4 * 132;
    int it = blockIdx.x;
    if (it < NV) {
        VtPre cur = vt_load(p, it);
#pragma unroll 1
        for (; it < NV; it += gridDim.x) {
            const int nx = it + (int)gridDim.x;
            const VtPre nxt = vt_load(p, nx < NV ? nx : it);
            __builtin_amdgcn_sched_barrier(0);
            vt_item(p, l, it, cur, lds, st);
            cur = nxt;
        }
    }
    if (it < NU + NV) {
#define U_ITEM_OF(it_) ((((it_) - NV) % NCH) << 4 | (((it_) - NV) / NCH))
        UPre cur = u_load(p, U_ITEM_OF(it));
#pragma unroll 1
        for (; it < NU + NV; it += gridDim.x) {
            const int nx = it + (int)gridDim.x;
            const UPre nxt = u_load(p, U_ITEM_OF(nx < NU + NV ? nx : it));
            __builtin_amdgcn_sched_barrier(0);
            lin_u_item(p, l, U_ITEM_OF(it), cur, lds, st);
            cur = nxt;
        }
#undef U_ITEM_OF
    }
}

constexpr int SCAN_WGS = 32 * 2048 / NTHR;
__device__ __forceinline__ void scan_part(PRef p, int l, int rank, const bool st) {
    const int gt = rank * NTHR + tid_now();
    const int e = gt & 2047, chain = gt >> 11;
    const int dir = chain & 1, type = (chain >> 1) & 1, h = (chain >> 2) & 3, b = chain >> 4;
    float* U = (float*)(p.ws + WS_US) + (size_t)chain * NCH * 2048 + e;
    const float* DEC = (const float*)(p.ws + WS_DEC) + ((size_t)(b * 4 + h) * 2 + dir) * NCH * 32 + (e >> 6);
    const float* sc = (const float*)(p.ws + WS_SCAL) + l * 16;
    const float dret = __expf(128.f * sc[2 + dir * 4 + h]);
    float S = 0.f;
#pragma unroll 1
    for (int s0 = 0; s0 < NCH; s0 += 22) {
        float u[22], dd[22];
#pragma unroll
        for (int q = 0; q < 22; ++q) { const int s = s0 + q, c = dir == 0 ? s : (s < 2 ? 1 - s : 67 - s); u[q] = U[(size_t)c * 2048]; dd[q] = type ? DEC[c * 32] : dret; }
#pragma unroll
        for (int q = 0; q < 22; ++q) { const int s = s0 + q, c = dir == 0 ? s : (s < 2 ? 1 - s : 67 - s); if (st) U[(size_t)c * 2048] = S; S = dd[q] * S + u[q]; }
        if (!st && S == 12345.678f) U[0] = S;
    }
}

struct OPre { u32x4 q4, k4, v[2]; f32x4 sf4, sb4; u32x2 g[4]; float la[16]; };
__device__ __forceinline__ OPre out_load(PRef p, int item) {
    const int tid = tid_now(), lane = tid & 63, wid = tid >> 6;
    const int type = item & 1, h = (item >> 1) & 3, b = (item >> 3) & 1, c = item >> 4;
    const LinCfg cf = lin_cfg(type, h);
    const int r0 = b * POSB + c * 128;
    const bf16* P = (const bf16*)(p.ws + WS_P);
    OPre r;
    r.q4 = *(const u32x4*)(P + (size_t)(r0 + (tid >> 2)) * NP + cf.qcol + 8 * (tid & 3)); r.k4 = *(const u32x4*)(P + (size_t)(r0 + (tid >> 2)) * NP + cf.kcol + 8 * (tid & 3));
#pragma unroll
    for (int i = 0; i < 2; ++i) { const int q = tid + 512 * i; r.v[i] = *(const u32x4*)(P + (size_t)(r0 + (q >> 3)) * NP + cf.vcol + 8 * (q & 7)); }
    r.sf4 = *(const f32x4*)((const float*)(p.ws + WS_US) + us_index(b, h, type, 0, c) + 4 * tid); r.sb4 = *(const f32x4*)((const float*)(p.ws + WS_US) + us_index(b, h, type, 1, c) + 4 * tid);
    { const int tok_ = (wid >> 1) * 32 + (lane & 31);
#pragma unroll
      for (int a = 0; a < 4; ++a) r.g[a] = *(const u32x2*)(P + (size_t)(r0 + tok_) * NP + cf.gcol + (wid & 1) * 32 + 8 * a + 4 * (lane >> 5)); }
    const float* LA = (const float*)(p.ws + WS_LA);
#pragma unroll
    for (int q = 0; q < 8; ++q) { const int i = tid + NTHR * q, j = i >> 5, kk = i & 31; const float* s = LA + (size_t)(r0 + j) * 256 + h * 32 + kk;
        r.la[2 * q] = type ? s[0] : 0.f; r.la[2 * q + 1] = type ? s[128] : 0.f; }
    return r;
}
__device__ __forceinline__ void lin_out_item(PRef p, int l, int item, const OPre& pre, char* lds) {
    unsigned long long g_t0 = PROBE_SUB ? __builtin_amdgcn_s_memrealtime() : 0ull;
    const int tid = tid_now(), lane = tid & 63, wid = tid >> 6;
    const int type = item & 1, h = (item >> 1) & 3, b = (item >> 3) & 1, c = item >> 4;
    const LinCfg cf = lin_cfg(type, h);
    const int r0 = b * POSB + c * 128;
    const u32x4 q4 = pre.q4, k4 = pre.k4;
    u32x4 vpre[2]; vpre[0] = pre.v[0]; vpre[1] = pre.v[1];
    const f32x4 sf4 = pre.sf4, sb4 = pre.sb4;
    u32x2 gpre[4]; gpre[0] = pre.g[0]; gpre[1] = pre.g[1]; gpre[2] = pre.g[2]; gpre[3] = pre.g[3];
    lin_prefix(p, l, type, h, r0, true, lds, true, pre.la);
    GSTAMP(21);
    const float* bf = (const float*)(lds + L_BF); const float* bs = (const float*)(lds + L_BS);
    bf16* qf = (bf16*)(lds + LO_QF); bf16* kf = (bf16*)(lds + LO_KF); bf16* qb = (bf16*)(lds + LO_QB); bf16* kb = (bf16*)(lds + LO_KB);
    bf16* qi = (bf16*)(lds + LO_QI); bf16* st = (bf16*)(lds + LO_ST); bf16* vt = (bf16*)(lds + LO_VT); bf16* W = (bf16*)(lds + LO_W);
    float* ssq = (float*)(lds + LO_SS);
    { const int j = tid >> 2, c = tid & 3;
      const unsigned qw[4] = {q4.x, q4.y, q4.z, q4.w}, kw[4] = {k4.x, k4.y, k4.z, k4.w};
      unsigned oqf[4], okf[4], oqb[4], okb[4], oqi[4], oqj[4];
#pragma unroll
      for (int e2 = 0; e2 < 4; ++e2) {
          float vqf[2], vkf[2], vqb[2], vkb[2], vqi[2], vqj[2];
#pragma unroll
          for (int z = 0; z < 2; ++z) { const int kk = 8 * c + 2 * e2 + z;
              const float qv = z ? bfhi(qw[e2]) : bflo(qw[e2]), kv = z ? bfhi(kw[e2]) : bflo(kw[e2]);
              const float f = bf[j * 33 + kk], fm = bf[63 * 33 + kk], sx = bs[j * 33 + kk], sm = bs[64 * 33 + kk];
              vqf[z] = qv * __expf(f - fm); vkf[z] = kv * __expf(fm - f); vqb[z] = qv * __expf(sx - sm); vkb[z] = kv * __expf(sm - sx);
              vqi[z] = qv * __expf(f); vqj[z] = qv * __expf(sx); }
          oqf[e2] = pk2(vqf[0], vqf[1]); okf[e2] = pk2(vkf[0], vkf[1]); oqb[e2] = pk2(vqb[0], vqb[1]); okb[e2] = pk2(vkb[0], vkb[1]);
          oqi[e2] = pk2(vqi[0], vqi[1]); oqj[e2] = pk2(vqj[0], vqj[1]); }
      *(u32x4*)(qf + j * 40 + 8 * c) = (u32x4){oqf[0], oqf[1], oqf[2], oqf[3]}; *(u32x4*)(kf + j * 40 + 8 * c) = (u32x4){okf[0], okf[1], okf[2], okf[3]};
      *(u32x4*)(qb + j * 40 + 8 * c) = (u32x4){oqb[0], oqb[1], oqb[2], oqb[3]}; *(u32x4*)(kb + j * 40 + 8 * c) = (u32x4){okb[0], okb[1], okb[2], okb[3]};
      *(u32x4*)(qi + j * 72 + 8 * c) = (u32x4){oqi[0], oqi[1], oqi[2], oqi[3]}; *(u32x4*)(qi + j * 72 + 32 + 8 * c) = (u32x4){oqj[0], oqj[1], oqj[2], oqj[3]}; }
#pragma unroll
    for (int i = 0; i < 2; ++i) { const int q = tid + 512 * i, j = q >> 3, c = q & 7;
        const u32x4 v4 = vpre[i];
        const unsigned vw[4] = {v4.x, v4.y, v4.z, v4.w};
#pragma unroll
        for (int e = 0; e < 4; ++e) { vt[(8 * c + 2 * e) * 136 + j] = (bf16)(vw[e] & 0xffff); vt[(8 * c + 2 * e + 1) * 136 + j] = (bf16)(vw[e] >> 16); } }
    { const int kk = (4 * tid) >> 6, dv = (4 * tid) & 63;
#pragma unroll
      for (int e = 0; e < 4; ++e) { st[(dv + e) * 72 + kk] = (bf16)f2bf(sf4[e]); st[(dv + e) * 72 + 32 + kk] = (bf16)f2bf(sb4[e]); } }
    __syncthreads();
    GSTAMP(22);
    const int li = lane & 31, hi = lane >> 5;
    {
        const int bi = wid >> 1;
#pragma unroll
        for (int jj = 0; jj < 2; ++jj) {
            const int bj = (wid & 1) * 2 + jj;
            f32x16 af = {0}, ab = {0};
#pragma unroll
            for (int s = 0; s < 2; ++s) {
                const bf16x8 kfa = *(const bf16x8*)(kf + (bj * 32 + li) * 40 + 16 * s + 8 * hi), qfb = *(const bf16x8*)(qf + (bi * 32 + li) * 40 + 16 * s + 8 * hi);
                const bf16x8 kba = *(const bf16x8*)(kb + (bj * 32 + li) * 40 + 16 * s + 8 * hi), qbb = *(const bf16x8*)(qb + (bi * 32 + li) * 40 + 16 * s + 8 * hi);
                af = __builtin_amdgcn_mfma_f32_32x32x16_bf16(kfa, qfb, af, 0, 0, 0);
                ab = __builtin_amdgcn_mfma_f32_32x32x16_bf16(kba, qbb, ab, 0, 0, 0);
            }
            const int i = bi * 32 + li;
#pragma unroll
            for (int a = 0; a < 4; ++a) {
                float w[4];
#pragma unroll
                for (int q = 0; q < 4; ++q) { const int j = bj * 32 + 8 * a + 4 * hi + q; w[q] = (i >= j ? af[4 * a + q] : 0.f) + (j >= i ? ab[4 * a + q] : 0.f); }
                u32x2 o; o.x = pk2(w[0], w[1]); o.y = pk2(w[2], w[3]);
                *(u32x2*)(W + i * 136 + bj * 32 + 8 * a + 4 * hi) = o;
            }
        }
    }
    __syncthreads();
    GSTAMP(23);
    const int bi = wid >> 1, bd = wid & 1;
    f32x16 o = {0};
#pragma unroll
    for (int s = 0; s < 8; ++s) {
        const bf16x8 va = *(const bf16x8*)(vt + (bd * 32 + li) * 136 + 16 * s + 8 * hi), wb = *(const bf16x8*)(W + (bi * 32 + li) * 136 + 16 * s + 8 * hi);
        o = __builtin_amdgcn_mfma_f32_32x32x16_bf16(va, wb, o, 0, 0, 0);
    }
#pragma unroll
    for (int s = 0; s < 4; ++s) {
        const bf16x8 sa = *(const bf16x8*)(st + (bd * 32 + li) * 72 + 16 * s + 8 * hi), qq = *(const bf16x8*)(qi + (bi * 32 + li) * 72 + 16 * s + 8 * hi);
        o = __builtin_amdgcn_mfma_f32_32x32x16_bf16(sa, qq, o, 0, 0, 0);
    }
    float ss = 0.f;
#pragma unroll
    for (int r = 0; r < 16; ++r) ss += o[r] * o[r];
    ss += __shfl_xor(ss, 32);
    const int tok = bi * 32 + li;
    if (hi == 0) ssq[tok * 2 + bd] = ss;
    __syncthreads();
    const bool need = (l == 0) || (c >= 2);
    if (need) {
        const float rn = rsqrtf((ssq[tok * 2] + ssq[tok * 2 + 1]) * (1.f / 64.f) + EPS);
        bf16* CAT = (bf16*)(p.ws + WS_CAT);
        const float* gg = p.in[15] + l * 64;
        f32x4 ggv[4];
#pragma unroll
        for (int a = 0; a < 4; ++a) { ggv[a] = (f32x4){1.f, 1.f, 1.f, 1.f}; if (type == 1) ggv[a] = *(const f32x4*)(gg + bd * 32 + 8 * a + 4 * hi); }
        __builtin_amdgcn_sched_barrier(0);
#pragma unroll
        for (int a = 0; a < 4; ++a) {
            const int dv = bd * 32 + 8 * a + 4 * hi;
            const u32x2 gt = gpre[a];
            const f32x4 g4 = ggv[a];
            u32x2 ov; ov.x = pk2(o[4 * a] * rn * g4.x * bflo(gt.x), o[4 * a + 1] * rn * g4.y * bfhi(gt.x));
            ov.y = pk2(o[4 * a + 2] * rn * g4.z * bflo(gt.y), o[4 * a + 3] * rn * g4.w * bfhi(gt.y));
            *(u32x2*)(CAT + (size_t)(r0 + tok) * D + cf.ocol + dv) = ov;
        }
    }
    __syncthreads();
    GSTAMP(24);
}

constexpr int AT_STAGE = 32768, AT_K0 = 0, AT_K1 = 8192, AT_V = 16384, AT_X = 0;
#ifndef ATT_SETPRIO
#define ATT_SETPRIO 0
#endif
#define AT_PRIO(x) do { if (ATT_SETPRIO) __builtin_amdgcn_s_setprio(x); } while (0)
#define AT_SB() __builtin_amdgcn_sched_barrier(0)
#define AT_LDK(kfv, Kl) do { _Pragma("unroll") for (int kb = 0; kb < 2; ++kb) _Pragma("unroll") for (int s_ = 0; s_ < 4; ++s_) { const int krow = kb * 32 + qi; \
        kfv[kb][s_] = *(const bf16x8*)((Kl) + krow * 128 + (((2 * s_ + hi) ^ ((krow >> 1) & 7)) << 4)); } } while (0)
#define AT_LDV(vfv, Vl, t) do { const int vrow = 32 * (t) + qi; _Pragma("unroll") for (int c_ = 0; c_ < 4; ++c_) \
        vfv[c_] = *(const bf16x8*)((Vl) + vrow * 128 + (((2 * c_ + hi) ^ ((vrow >> 1) & 7)) << 4)); } while (0)
#define AT_QKM(sTv, kfv) do { AT_PRIO(1); \
        sTv[0] = __builtin_amdgcn_mfma_f32_32x32x16_bf16(kfv[0][0], qf[0], negm, 0, 0, 0); sTv[1] = __builtin_amdgcn_mfma_f32_32x32x16_bf16(kfv[1][0], qf[0], negm, 0, 0, 0); \
        _Pragma("unroll") for (int s_ = 1; s_ < 4; ++s_) { sTv[0] = __builtin_amdgcn_mfma_f32_32x32x16_bf16(kfv[0][s_], qf[s_], sTv[0], 0, 0, 0); \
            sTv[1] = __builtin_amdgcn_mfma_f32_32x32x16_bf16(kfv[1][s_], qf[s_], sTv[1], 0, 0, 0); } \
        AT_PRIO(0); } while (0)
#define AT_SOFTMAX(sTv, pfv) do { float _ls = 0.f; \
        _Pragma("unroll") for (int kb = 0; kb < 2; ++kb) _Pragma("unroll") for (int r = 0; r < 16; ++r) { const float pv = __builtin_amdgcn_exp2f(sTv[kb][r]); sTv[kb][r] = pv; _ls += pv; } \
        lrun += _ls; \
        _Pragma("unroll") for (int kb = 0; kb < 2; ++kb) _Pragma("unroll") for (int ks = 0; ks < 2; ++ks) { \
            u32x4 w; w.x = pk2(sTv[kb][8 * ks + 0], sTv[kb][8 * ks + 1]); w.y = pk2(sTv[kb][8 * ks + 2], sTv[kb][8 * ks + 3]); \
            w.z = pk2(sTv[kb][8 * ks + 4], sTv[kb][8 * ks + 5]); w.w = pk2(sTv[kb][8 * ks + 6], sTv[kb][8 * ks + 7]); pfv[kb][ks] = __builtin_bit_cast(bf16x8, w); } } while (0)
#define AT_PVM(pfv, vfv, t) do { AT_PRIO(1); \
        _Pragma("unroll") for (int c_ = 0; c_ < 4; ++c_) oacc[t] = __builtin_amdgcn_mfma_f32_32x32x16_bf16(vfv[c_], pfv[c_ >> 1][c_ & 1], oacc[t], 0, 0, 0); \
        AT_PRIO(0); } while (0)
__device__ __forceinline__ void attn_finish(PRef p, int l, int b, int h, int qpos0, char* lds, f32x16 (&oacc)[4], const float inv);
#ifndef AT_HALFPRIO
#define AT_HALFPRIO 1
#endif
__device__ __forceinline__ void attn_unit(PRef p, int l, int b, int h, int qpos0, int nkeys, char* lds) {
    unsigned long long g_t0 = PROBE_SUB ? __builtin_amdgcn_s_memrealtime() : 0ull;
    const int tid = tid_now(), lane = tid & 63, wid = __builtin_amdgcn_readfirstlane(tid >> 6), m = wid >> 2, qr = (wid & 3) * 32, qi = lane & 31, hi = lane >> 5;
    const bf16* P = (const bf16*)(p.ws + WS_P); const bf16* VT = (const bf16*)(p.ws + WS_VT);
    const size_t rowb = (size_t)b * POSB;
    LAS unsigned char* l3 = (LAS unsigned char*)lds;
    const bf16* gbase = wid < 4 ? P + rowb * NP + 2048 + h * 128 : VT + (size_t)(b * 4 + h) * 128 * POSB;
    const unsigned ginc = wid < 4 ? 64u * NP : 64u;
    unsigned go[4]; unsigned ldst[4];
#pragma unroll
    for (int j = 0; j < 4; ++j) {
        const int g = wid * 4 + j;
        const int r = 8 * (g & 7) + (g >= 16 ? 64 * ((g >> 3) & 1) : 0) + (lane >> 3);
        const int c = (lane & 7) ^ ((r >> 1) & 7);
        if (g < 16) { go[j] = (unsigned)r * NP + (g >> 3) * 64 + c * 8; ldst[j] = (g < 8 ? AT_K0 : AT_K1) + (8 * (g & 7)) * 128; }
        else { go[j] = (unsigned)r * POSB + c * 8; ldst[j] = AT_V + (8 * (g & 7) + 64 * ((g >> 3) & 1)) * 128; }
    }
#define AT_ISSUE(stage, kt) do { const bf16* _gb = gbase + (size_t)(kt) * ginc; _Pragma("unroll") for (int _j = 0; _j < 4; ++_j) \
        __builtin_amdgcn_global_load_lds((const unsigned*)(_gb + go[_j]), (LAS unsigned*)(l3 + (stage) * AT_STAGE + ldst[_j]), 16, 0, 0); } while (0)
    const int nt = nkeys >> 6;
    AT_ISSUE(0, 0);
    if (nt > 1) AT_ISSUE(1, 1);
    bf16x8 qf[4]; float q2 = 0.f;
    { const bf16* qp = P + (rowb + qpos0 + qr + qi) * NP + 1536 + h * 128 + m * 64 + 8 * hi;
#pragma unroll
      for (int s = 0; s < 4; ++s) { const u32x4 w = *(const u32x4*)(qp + 16 * s); qf[s] = __builtin_bit_cast(bf16x8, w);
          q2 += bflo(w.x) * bflo(w.x) + bfhi(w.x) * bfhi(w.x) + bflo(w.y) * bflo(w.y) + bfhi(w.y) * bfhi(w.y) + bflo(w.z) * bflo(w.z) + bfhi(w.z) * bfhi(w.z) + bflo(w.w) * bflo(w.w) + bfhi(w.w) * bfhi(w.w); } }
    q2 += __shfl_xor(q2, 32);
    const float k2 = __builtin_bit_cast(float, __hip_atomic_load((const unsigned*)(p.ws + WS_CTL) + CW_KMAX + (((l * 2 + b) * 4 + h) * 2 + m) * 64, __ATOMIC_RELAXED, __HIP_MEMORY_SCOPE_AGENT));
    const float mq = sqrtf(q2 * k2) * 1.002f + 1e-6f;
    f32x16 negm;
#pragma unroll
    for (int r = 0; r < 16; ++r) negm[r] = -mq;
    asm volatile("" : "+v"(negm));
    f32x16 oacc[4];
#pragma unroll
    for (int t = 0; t < 4; ++t) oacc[t] = (f32x16){0};
    float lrun = 0.f;
    bf16x8 pf[2][2];
#pragma unroll
    for (int i = 0; i < 2; ++i)
#pragma unroll
        for (int j = 0; j < 2; ++j) pf[i][j] = (bf16x8){0, 0, 0, 0, 0, 0, 0, 0};
    int stage = 0;
    GSTAMP(51);
    if (AT_HALFPRIO && m) __builtin_amdgcn_s_setprio(1);
#pragma unroll 1
    for (int kt = 0; kt < nt; ++kt) {
        if (kt + 1 < nt) asm volatile("s_waitcnt vmcnt(4)" ::: "memory"); else asm volatile("s_waitcnt vmcnt(0)" ::: "memory");
        __builtin_amdgcn_s_barrier();
        if (kt + 2 < nt) AT_ISSUE((stage + 2) & 3, kt + 2);
        const char* Kl = lds + stage * AT_STAGE + (m ? AT_K1 : AT_K0);
        f32x16 sT[2]; bf16x8 kf[2][4];
        {
            const char* Vc = lds + stage * AT_STAGE + AT_V;
            bf16x8 va[4], vb[4];
            AT_LDK(kf, Kl); AT_SB();
            AT_QKM(sT, kf); AT_SB();
            AT_LDV(va, Vc, 0); AT_LDV(vb, Vc, 1); AT_SB();
            AT_SOFTMAX(sT, pf); AT_SB();
            AT_PVM(pf, va, 0); AT_SB(); AT_LDV(va, Vc, 2); AT_SB(); AT_PVM(pf, vb, 1); AT_SB(); AT_LDV(vb, Vc, 3); AT_SB(); AT_PVM(pf, va, 2); AT_SB(); AT_PVM(pf, vb, 3); AT_SB();
        }
        stage = (stage + 1) & 3;
    }
    if (AT_HALFPRIO && m) __builtin_amdgcn_s_setprio(0);
    GSTAMP(52);
#undef AT_ISSUE
    const float ltot = lrun + __shfl_xor(lrun, 32);
    const float inv = 1.f / ltot;
    __syncthreads();
    return attn_finish(p, l, b, h, qpos0, lds, oacc, inv);
}
__device__ __forceinline__ void attn_finish(PRef p, int l, int b, int h, int qpos0, char* lds, f32x16 (&oacc)[4], const float inv) {
    const int tid = tid_now(), lane = tid & 63, wid = __builtin_amdgcn_readfirstlane(tid >> 6), m = wid >> 2, qr = (wid & 3) * 32, qi = lane & 31, hi = lane >> 5;
    const size_t rowb = (size_t)b * POSB;
    float* X = (float*)(lds + AT_X) + (wid & 3) * 4096;
    if (m == 1) {
#pragma unroll
        for (int t = 0; t < 4; ++t)
#pragma unroll
            for (int r = 0; r < 16; ++r) X[(t * 16 + r) * 64 + lane] = oacc[t][r] * inv;
    }
    __syncthreads();
    if (m == 0) {
        const float* sc = (const float*)(p.ws + WS_SCAL) + l * 16;
        const float lam = sc[0], post = 1.f - sc[1];
        float ss = 0.f;
#pragma unroll
        for (int t = 0; t < 4; ++t)
#pragma unroll
            for (int r = 0; r < 16; ++r) { const float v = oacc[t][r] * inv - lam * X[(t * 16 + r) * 64 + lane]; oacc[t][r] = v; ss += v * v; }
        ss += __shfl_xor(ss, 32);
        const float rn = rsqrtf(ss * (1.f / 128.f) + EPS) * post;
        bf16* CAT = (bf16*)(p.ws + WS_CAT) + (rowb + qpos0 + qr + qi) * D + 512 + h * 128;
        const float* dg = p.in[17] + l * 128;
        f32x4 g4v[16];
#pragma unroll
        for (int q = 0; q < 16; ++q) g4v[q] = *(const f32x4*)(dg + 32 * (q >> 2) + 8 * (q & 3) + 4 * hi);
        __builtin_amdgcn_sched_barrier(0);
#pragma unroll
        for (int t = 0; t < 4; ++t)
#pragma unroll
            for (int a = 0; a < 4; ++a) {
                const int dv = 32 * t + 8 * a + 4 * hi;
                const f32x4 g4 = g4v[4 * t + a];
                u32x2 ov; ov.x = pk2(oacc[t][4 * a] * rn * g4.x, oacc[t][4 * a + 1] * rn * g4.y); ov.y = pk2(oacc[t][4 * a + 2] * rn * g4.z, oacc[t][4 * a + 3] * rn * g4.w);
                *(u32x2*)(CAT + dv) = ov;
            }
    }
    __syncthreads();
}

__device__ __forceinline__ void phase_e(PRef p, int l, char* lds) {
    const int n_att = 512 + (l == 0 ? 16 : 0);
    const int n_lin = NCH * 16;
    unsigned* sdone = (unsigned*)(p.ws + WS_CTL) + CW_SCAN + l * 64;
    const int scan0 = (int)gridDim.x - SCAN_WGS;
    if ((int)blockIdx.x >= scan0) {
        scan_part(p, l, (int)blockIdx.x - scan0, true);
        asm volatile("s_waitcnt vmcnt(0)" ::: "memory");
        __syncthreads();
        if (threadIdx.x == 0) { __builtin_amdgcn_fence(__ATOMIC_RELEASE, "agent"); asm volatile("s_waitcnt vmcnt(0)" ::: "memory"); (void)xb_add(sdone, 1u); }
    }
    int it = blockIdx.x;
#pragma unroll 1
    for (; it < n_att; it += gridDim.x) {
        if (it < 512) { const int bh = it & 7, qb = it >> 3; attn_unit(p, l, bh >> 2, bh & 3, CTX + qb * 128, POSB, lds); }
        else { const int u = it - 512, bh = u & 7, qb = u >> 3; attn_unit(p, l, bh >> 2, bh & 3, qb * 128, CTX, lds); }
    }
#define OUT_ITEM_OF(it_) (l == 0 ? ((((it_) - n_att) % NCH) << 4 | (((it_) - n_att) / NCH)) \
                                 : (((2 + (((it_) - n_att) & 63)) << 4) | (((((it_) - n_att) >> 6) & 3) << 2) | (((it_) - n_att) >> 8)))
    const int n_out = (l == 0) ? n_lin : 64 * 16;
    if (it < n_att + n_out) {
        if (threadIdx.x == 0) { unsigned sp = 0; while (xb_ld(sdone) < (unsigned)SCAN_WGS && ++sp < (1u << 22)) __builtin_amdgcn_s_sleep(2);
            __builtin_amdgcn_fence(__ATOMIC_ACQUIRE, "agent"); asm volatile("s_waitcnt vmcnt(0)" ::: "memory"); }
        __syncthreads();
        OPre cur = out_load(p, OUT_ITEM_OF(it));
#pragma unroll 1
        while (it < n_att + n_out) {
            const int nx = it + (int)gridDim.x;
            const OPre nxt = out_load(p, OUT_ITEM_OF(nx < n_att + n_out ? nx : it));
            __builtin_amdgcn_sched_barrier(0);
            lin_out_item(p, l, OUT_ITEM_OF(it), cur, lds);
            cur = nxt; it = nx;
        }
    }
#undef OUT_ITEM_OF
}

__device__ __forceinline__ void phase_f(PRef p, int l, char* lds) {
    DenseSched S{(l == 0) ? 66 : 64, 4, ((l == 0) ? 66 : 64) * 4, l != 0};
    EpiBf16 E{(bf16*)(p.ws + WS_MO), D};
    pg8::gemm_phase<EpiBf16, DenseSched, false>((LAS unsigned char*)lds, (const bf16*)(p.ws + WS_CAT), (const bf16*)(p.ws + WS_WOUT), D, S, E);
    if (l == 0) {
        const int rem = (66 * 4) % (int)gridDim.x;
        mods_items(p, lds, 192, 384, (int)blockIdx.x - rem, (int)gridDim.x - rem);
        cv_pool_idle(p, lds, CP_B0, CP_F0, rem);
    }
}

__device__ __forceinline__ int ffn_row(int l, int idx) {
    if (l == 0) return idx;
    const int b = idx >> 13, t = idx & 8191; return b * POSB + CTX + t;
}
constexpr int GR_STRIDE = 2064, GR_HI = 0, GR_LO = 32 * GR_STRIDE, GR_LG = 64 * GR_STRIDE;
constexpr int GR_HIST = GR_LG + 8192, GR_BASE = GR_HIST + 256, GR_PAIR = GR_BASE + 256;
static_assert(GR_PAIR + 2048 <= LDS_MISC, "router LDS");
#ifndef RT_BATCH
#define RT_BATCH 16
#endif
#ifndef G_DEPHASE
#define G_DEPHASE 1
#endif
__device__ __forceinline__ void phase_g(PRef p, int l, char* lds, const bool st) {
    unsigned long long g_t0 = PROBE_SUB ? __builtin_amdgcn_s_memrealtime() : 0ull;
    const int tid = tid_now(), lane = tid & 63, wave = __builtin_amdgcn_readfirstlane(tid >> 6);
    const int ntok = (l == 0) ? R : BATCH * SEQ;
    const float* mods = (const float*)(p.ws + WS_MODS) + (size_t)l * 3 * 6144;
    const float* gpost = p.in[7] + l * D; const float* gpre = p.in[8] + l * D;
    const float bias = p.in[19][l * NEXP + lane];
    const bf16* MO = (const bf16*)(p.ws + WS_MO); bf16* HL = (bf16*)(p.ws + WS_HL);
    const bf16* WRH = (const bf16*)(p.ws + WS_WRH); const bf16* WRL = (const bf16*)(p.ws + WS_WRL);
    float* LG = (float*)(lds + GR_LG);
    unsigned* cnt = (unsigned*)(p.ws + WS_CTL) + CW_CNT + l * 4096;
    int* rowtok = (int*)(p.ws + WS_ROWTOK); int* pslot = (int*)(p.ws + WS_PSLOT); float* pw = (float*)(p.ws + WS_PW);
    int* hist = (int*)(lds + GR_HIST); int* base = (int*)(lds + GR_BASE); int* pair_i = (int*)(lds + GR_PAIR); float* pair_w = (float*)(lds + GR_PAIR + 1024);
    int bres = 0, pend_g0 = -1;
#define G_SCATTER(g0_) do { if (st && tid < 192) { const int lr = tid / 6, k = tid - lr * 6; const int row = ffn_row(l, (g0_) + lr); \
            const int pi = pair_i[lr * 8 + k], e = pi >> 16, rk = base[e] + (pi & 0xffff); \
            rowtok[e * CAP + rk] = row; pslot[row * 8 + k] = (e << 16) | rk; pw[row * 8 + k] = pair_w[lr * 8 + k]; } } while (0)
    const bool pool_first = G_DEPHASE && (((int)blockIdx.x >> 3) & 1);
    if (pool_first) { if (st) { if (l == 0) cv_pool_idle(p, lds, CP_F0, CP_G0, (R / 32) % (int)gridDim.x); else cv_pool(p, lds, CP_B1, CQ_END, (int)blockIdx.x, (int)gridDim.x); } __syncthreads(); }
    for (int g0 = blockIdx.x * 32; g0 < ntok; g0 += gridDim.x * 32) {
#pragma unroll 1
        for (int hf = 0; hf < 2; ++hf) {
            const float* gpost_ = gpost; const float* gpre_ = gpre; asm volatile("" : "+s"(gpost_), "+s"(gpre_));
            f32x4 mv[2][4], xv[2][4];
            int rowv[2]; const float* mdv[2];
#pragma unroll
            for (int rr = 0; rr < 2; ++rr) {
                const int row = ffn_row(l, g0 + 4 * wave + 2 * hf + rr); rowv[rr] = row;
                const int b = row_b(row), pos = row - b * POSB, rt = pos < CTX ? 2 : b; mdv[rr] = mods + rt * 6144;
                const float* xr = resid_row_ptr(p, l, row); const bf16* mr = MO + (size_t)row * D;
#pragma unroll
                for (int j = 0; j < 4; ++j) { const u32x2 mb = *(const u32x2*)(mr + 4 * lane + 256 * j); mv[rr][j] = (f32x4){bflo(mb.x), bfhi(mb.x), bflo(mb.y), bfhi(mb.y)}; if (l == 0) xv[rr][j] = *(const f32x4*)(xr + 4 * lane + 256 * j);
                    else { const u32x2 xb = *(const u32x2*)((const bf16*)xr + 4 * lane + 256 * j); xv[rr][j] = (f32x4){bflo(xb.x), bfhi(xb.x), bflo(xb.y), bfhi(xb.y)}; } }
            }
            f32x4 gp4[4], gq4[4];
#pragma unroll
            for (int j = 0; j < 4; ++j) { gp4[j] = *(const f32x4*)(gpost_ + 4 * lane + 256 * j); gq4[j] = *(const f32x4*)(gpre_ + 4 * lane + 256 * j); }
            f32x4 gtv[2][4];
#pragma unroll
            for (int rr = 0; rr < 2; ++rr)
#pragma unroll
                for (int j = 0; j < 4; ++j) gtv[rr][j] = *(const f32x4*)(mdv[rr] + 2 * D + 4 * lane + 256 * j);
            __builtin_amdgcn_sched_barrier(0);
            float ss[2], ss2[2];
#pragma unroll
            for (int rr = 0; rr < 2; ++rr) { ss[rr] = 0.f;
#pragma unroll
                for (int j = 0; j < 4; ++j) ss[rr] += mv[rr][j].x * mv[rr][j].x + mv[rr][j].y * mv[rr][j].y + mv[rr][j].z * mv[rr][j].z + mv[rr][j].w * mv[rr][j].w; }
#pragma unroll
            for (int rr = 0; rr < 2; ++rr) ss[rr] = wave_sum_u(ss[rr]);
#pragma unroll
            for (int rr = 0; rr < 2; ++rr) {
                const float* md = mdv[rr];
                const float r1 = rsqrtf(ss[rr] * (1.f / D) + EPS);
                ss2[rr] = 0.f;
#pragma unroll
                for (int j = 0; j < 4; ++j) {
                    const f32x4 gt = gtv[rr][j];
                    xv[rr][j] = xv[rr][j] + gt * (mv[rr][j] * r1 * gp4[j]);
                    ss2[rr] += xv[rr][j].x * xv[rr][j].x + xv[rr][j].y * xv[rr][j].y + xv[rr][j].z * xv[rr][j].z + xv[rr][j].w * xv[rr][j].w; }
                (void)md;
            }
            f32x4 s1v[2][4], s0v[2][4];
#pragma unroll
            for (int rr = 0; rr < 2; ++rr)
#pragma unroll
                for (int j = 0; j < 4; ++j) { s1v[rr][j] = *(const f32x4*)(mdv[rr] + 4 * D + 4 * lane + 256 * j); s0v[rr][j] = *(const f32x4*)(mdv[rr] + 3 * D + 4 * lane + 256 * j); }
            __builtin_amdgcn_sched_barrier(0);
#pragma unroll
            for (int rr = 0; rr < 2; ++rr) ss2[rr] = wave_sum_u(ss2[rr]);
#pragma unroll
            for (int rr = 0; rr < 2; ++rr) {
                const int lr = 4 * wave + 2 * hf + rr;
                const int row = rowv[rr];
                const float* md = mdv[rr];
                const float r2 = rsqrtf(ss2[rr] * (1.f / D) + EPS);
#pragma unroll
                for (int j = 0; j < 4; ++j) { const int k0 = 4 * lane + 256 * j;
                    const f32x4 s1 = s1v[rr][j], s0 = s0v[rr][j];
                    const f32x4 hv = xv[rr][j] * r2 * gq4[j] * (s1 + 1.f) + s0;
                    if (st) { u32x2 xb; xb.x = pk2(xv[rr][j].x, xv[rr][j].y); xb.y = pk2(xv[rr][j].z, xv[rr][j].w);
                        *(u32x2*)((bf16*)(p.ws + WS_MO) + (size_t)row * D + k0) = xb; }
                    unsigned hb[4], lb[4];
#pragma unroll
                    for (int i = 0; i < 4; ++i) { hb[i] = f2bf(hv[i]); lb[i] = f2bf(hv[i] - __builtin_bit_cast(float, hb[i] << 16)); }
                    u32x2 oh; oh.x = hb[0] | (hb[1] << 16); oh.y = hb[2] | (hb[3] << 16);
                    u32x2 ol; ol.x = lb[0] | (lb[1] << 16); ol.y = lb[2] | (lb[3] << 16);
                    if (st) *(u32x2*)(HL + (size_t)row * D + k0) = oh;
                    *(u32x2*)(lds + GR_HI + lr * GR_STRIDE + 2 * k0) = oh;
                    *(u32x2*)(lds + GR_LO + lr * GR_STRIDE + 2 * k0) = ol; }
            }
        }
        if (tid < 64) { hist[tid] = 0; if (st && pend_g0 >= 0) base[tid] = bres; }
        *(f32x4*)(LG + 4 * tid) = (f32x4){0.f, 0.f, 0.f, 0.f};
        __syncthreads();
        if (pend_g0 >= 0) G_SCATTER(pend_g0);
        GSTAMP(1);
        {
            const int et = wave & 3, kh = wave >> 2, fr = lane & 15, fq = lane >> 4;
            const bf16* wh = WRH + (size_t)(et * 16 + fr) * D + kh * 512 + 8 * fq; const bf16* wl = WRL + (size_t)(et * 16 + fr) * D + kh * 512 + 8 * fq;
            const char* hh = lds + GR_HI + fr * GR_STRIDE + kh * 1024 + 16 * fq; const char* hl2 = lds + GR_LO + fr * GR_STRIDE + kh * 1024 + 16 * fq;
            f32x4 acc0 = {0.f, 0.f, 0.f, 0.f}, acc1 = acc0;
#pragma unroll 1
            for (int s0 = 0; s0 < 16; s0 += RT_BATCH) {
                bf16x8 whi[RT_BATCH], wlo[RT_BATCH];
#pragma unroll
                for (int i = 0; i < RT_BATCH; ++i) { whi[i] = *(const bf16x8*)(wh + 32 * (s0 + i)); wlo[i] = *(const bf16x8*)(wl + 32 * (s0 + i)); }
                __builtin_amdgcn_sched_barrier(0);
#pragma unroll
                for (int i = 0; i < RT_BATCH; ++i) {
                    const bf16x8 hhi0 = *(const bf16x8*)(hh + 64 * (s0 + i)), hlo0 = *(const bf16x8*)(hl2 + 64 * (s0 + i));
                    const bf16x8 hhi1 = *(const bf16x8*)(hh + 16 * GR_STRIDE + 64 * (s0 + i)), hlo1 = *(const bf16x8*)(hl2 + 16 * GR_STRIDE + 64 * (s0 + i));
                    acc0 = __builtin_amdgcn_mfma_f32_16x16x32_bf16(whi[i], hhi0, acc0, 0, 0, 0);
                    acc1 = __builtin_amdgcn_mfma_f32_16x16x32_bf16(whi[i], hhi1, acc1, 0, 0, 0);
                    acc0 = __builtin_amdgcn_mfma_f32_16x16x32_bf16(whi[i], hlo0, acc0, 0, 0, 0);
                    acc1 = __builtin_amdgcn_mfma_f32_16x16x32_bf16(whi[i], hlo1, acc1, 0, 0, 0);
                    acc0 = __builtin_amdgcn_mfma_f32_16x16x32_bf16(wlo[i], hhi0, acc0, 0, 0, 0);
                    acc1 = __builtin_amdgcn_mfma_f32_16x16x32_bf16(wlo[i], hhi1, acc1, 0, 0, 0);
                }
                __builtin_amdgcn_sched_barrier(0);
            }
            LAS float* l0 = (LAS float*)(LG + fr * 64 + et * 16 + 4 * fq);
#pragma unroll
            for (int i = 0; i < 4; ++i) { (void)__hip_atomic_fetch_add(l0 + i, acc0[i], __ATOMIC_RELAXED, __HIP_MEMORY_SCOPE_WORKGROUP); (void)__hip_atomic_fetch_add(l0 + 16 * 64 + i, acc1[i], __ATOMIC_RELAXED, __HIP_MEMORY_SCOPE_WORKGROUP); }
        }
        __syncthreads();
        GSTAMP(2);
#pragma unroll
        for (int rr = 0; rr < 4; ++rr) {
            const int lr = 4 * wave + rr;
            const int row = ffn_row(l, g0 + lr);
            const float score = 1.f / (1.f + __expf(-LG[lr * 64 + lane]));
            const float sel = score + bias;
            const int grp = lane >> 3;
            const float m1 = grp8_max(sel);
            const unsigned long long bm = __ballot(sel == m1);
            const int first = __builtin_ctz((unsigned)((bm >> (8 * grp)) & 0xffull)) + 8 * grp;
            const float m2 = grp8_max((lane == first) ? -INFINITY : sel);
            const float gs = m1 + m2;
            int rank = 0;
#pragma unroll
            for (int g2 = 0; g2 < 8; ++g2) { const float o = lane_bcast(gs, 8 * g2); rank += (o > gs || (o == gs && g2 < grp)) ? 1 : 0; }
            float mv = rank < 4 ? sel : -INFINITY;
            float wsum = 0.f; float myw = 0.f; int mye = 0;
#pragma unroll
            for (int k = 0; k < 6; ++k) {
                const float mx = wave_max_u(mv);
                const unsigned long long b2 = __ballot(mv == mx);
                const int e = __builtin_ctzll(b2);
                const float sce = lane_bcast(score, e);
                wsum += sce;
                if (lane == k) { myw = sce; mye = e; }
                if (lane == e) mv = -INFINITY;
            }
            if (lane < 6) { const int lrk = atomicAdd(hist + mye, 1); pair_i[lr * 8 + lane] = (mye << 16) | lrk; pair_w[lr * 8 + lane] = myw / wsum * 2.5f; }
        }
        __syncthreads();
        GSTAMP(3);
        if (st && tid < 64) { const int hc = hist[tid]; bres = 0; if (hc > 0) bres = (int)atomicAdd(cnt + tid * 64, (unsigned)hc); }
        pend_g0 = g0;
        GSTAMP(4);
    }
    if (pend_g0 >= 0) {
        if (st && tid < 64) base[tid] = bres;
        __syncthreads();
        G_SCATTER(pend_g0);
        __syncthreads();
    }
#define G_POOL() do { if (st) { if (l == 0) cv_pool_idle(p, lds, CP_F0, CP_G0, (R / 32) % (int)gridDim.x); else cv_pool(p, lds, CP_B1, CQ_END, (int)blockIdx.x, (int)gridDim.x); } } while (0)
    if (!pool_first) G_POOL();
}

constexpr int M_TBL = 133120;
__device__ __forceinline__ void moe_table(PRef p, int l, char* lds) {
    int* tb = (int*)(lds + M_TBL);
    const unsigned* cnt = (const unsigned*)(p.ws + WS_CTL) + CW_CNT + l * 4096;
    const int t = tid_now();
    if (t < 65) tb[128 + t] = t < 64 ? (int)__hip_atomic_load(cnt + t * 64, __ATOMIC_RELAXED, __HIP_MEMORY_SCOPE_AGENT) : (l == 0 ? R : BATCH * SEQ);
    __syncthreads();
    if (t < 64) {
        const int tiles = (tb[128 + t] + 255) >> 8;
        int incl = tiles;
#pragma unroll
        for (int o = 1; o < 64; o <<= 1) { const int v = __shfl_up(incl, o); if (t >= o) incl += v; }
        tb[t] = incl - tiles;
        if (t == 63) { tb[64] = incl; tb[65] = incl + ((tb[128 + 64] + 255) >> 8); }
    }
    __syncthreads();
    if (t < 65) { unsigned char* te = (unsigned char*)(tb + 512); for (int i = tb[t]; i < tb[t + 1]; ++i) te[i] = (unsigned char)t; }
    __syncthreads();
}
__device__ __forceinline__ int moe_find(const int* tb, int tile) { return ((const unsigned char*)(tb + 512))[tile]; }

struct MoeSched {
    const int* tb; const int* rowtok; int nsub, nunits, l;
    __device__ __forceinline__ bool next(int i, pg8::Unit& u) const {
        const int L = i * (int)gridDim.x + virt_block(); if (L >= nunits) return false;
        const int tile = L / nsub, sub = L - tile * nsub, e = moe_find(tb, tile);
        u.pm = tile; u.pn = e * nsub + sub; u.e = e; u.ti = tile - tb[e]; return true;
    }
    __device__ __forceinline__ int src_row(const pg8::Unit& u, int r) const {
        const int idx = u.ti * 256 + r; if (idx >= tb[128 + u.e]) return 0;
        return u.e < 64 ? rowtok[u.e * CAP + idx] : ffn_row(l, idx);
    }
};
__device__ __forceinline__ void phase_h(PRef p, int l, char* lds) {
    moe_table(p, l, lds);
    const int* tb = (const int*)(lds + M_TBL);
    MoeSched S{tb, (const int*)(p.ws + WS_ROWTOK), 2, tb[65] * 2, l};
    EpiGateUp E{(bf16*)(p.ws + WS_HB)};
    pg8::gemm_phase<EpiGateUp, MoeSched, true>((LAS unsigned char*)lds, (const bf16*)(p.ws + WS_HL), (const bf16*)(p.ws + WS_WGU), D, S, E);
}
__device__ __forceinline__ void phase_i(PRef p, int l, char* lds) {
    if (MK_LAUNCHES != 1) moe_table(p, l, lds);
    const int* tb = (const int*)(lds + M_TBL);
    MoeSched S{tb, (const int*)(p.ws + WS_ROWTOK), 4, tb[65] * 4, l};
    EpiFp8 E{(unsigned char*)(p.ws + WS_Y)};
    pg8::gemm_phase<EpiFp8, MoeSched, false>((LAS unsigned char*)lds, (const bf16*)(p.ws + WS_HB), (const bf16*)(p.ws + (l ? WS_WD1 : WS_WD)), DEXP, S, E);
}
__device__ __forceinline__ void phase_j(PRef p, int l, char* lds, const bool st) {
    if (MK_LAUNCHES != 1) moe_table(p, l, lds);
    const int* tb = (const int*)(lds + M_TBL);
    const int tid = tid_now(), lane = tid & 63, wave = tid >> 6;
    const int ntok = (l == 0) ? R : BATCH * SEQ;
    const float* mods = (const float*)(p.ws + WS_MODS) + (size_t)l * 3 * 6144;
    const float* gpost = p.in[9] + l * D;
    const unsigned char* Y = (const unsigned char*)(p.ws + WS_Y);
    const int* pslot = (const int*)(p.ws + WS_PSLOT); const float* pw = (const float*)(p.ws + WS_PW);
    const int wstride = (int)gridDim.x * NWAVE;
    int nps[2][6]; float npw[2][6];
    { const int b0 = blockIdx.x * NWAVE + wave;
#pragma unroll
      for (int tk = 0; tk < 2; ++tk) { int i0 = b0 + tk * wstride; if (i0 >= ntok) i0 = b0 < ntok ? b0 : 0; const int r_ = ffn_row(l, i0);
#pragma unroll
          for (int k = 0; k < 6; ++k) { nps[tk][k] = pslot[r_ * 8 + k]; npw[tk][k] = pw[r_ * 8 + k]; } } }
    for (int base = blockIdx.x * NWAVE + wave; base < ntok; base += 2 * wstride) {
        int idx[2]; bool ok[2]; idx[0] = base; idx[1] = base + wstride; ok[0] = true; ok[1] = idx[1] < ntok; if (!ok[1]) idx[1] = idx[0];
        int ps[2][6]; float pwv[2][6]; int rowv[2];
#pragma unroll
        for (int tk = 0; tk < 2; ++tk) { rowv[tk] = ffn_row(l, idx[tk]);
#pragma unroll
            for (int k = 0; k < 6; ++k) { ps[tk][k] = nps[tk][k]; pwv[tk][k] = npw[tk][k]; } }
        { const int nb = base + 2 * wstride;
#pragma unroll
          for (int tk = 0; tk < 2; ++tk) { int i0 = nb + tk * wstride; if (i0 >= ntok) i0 = base; const int r_ = ffn_row(l, i0);
#pragma unroll
              for (int k = 0; k < 6; ++k) { nps[tk][k] = pslot[r_ * 8 + k]; npw[tk][k] = pw[r_ * 8 + k]; } } }
        f32x4 f[2][4];
#pragma unroll
        for (int tk = 0; tk < 2; ++tk) { const unsigned char* yr = Y + ((size_t)tb[64] * 256 + idx[tk]) * D;
#pragma unroll
            for (int j = 0; j < 4; ++j) { const int v = *(const int*)(yr + 4 * lane + 256 * j);
                const f32x2_t lo = __builtin_amdgcn_cvt_pk_f32_fp8(v, false), hi2 = __builtin_amdgcn_cvt_pk_f32_fp8(v, true);
                f[tk][j] = (f32x4){lo.x, lo.y, hi2.x, hi2.y} * 0.03125f; } }
#pragma unroll
        for (int k = 0; k < 6; ++k) {
#pragma unroll
            for (int tk = 0; tk < 2; ++tk) {
                const int e = ps[tk][k] >> 16, rk = ps[tk][k] & 0xffff; const float w = pwv[tk][k] * 0.03125f;
                const unsigned char* yr = Y + ((size_t)tb[e] * 256 + rk) * D;
#pragma unroll
                for (int j = 0; j < 4; ++j) { const int v = *(const int*)(yr + 4 * lane + 256 * j);
                    const f32x2_t lo = __builtin_amdgcn_cvt_pk_f32_fp8(v, false), hi2 = __builtin_amdgcn_cvt_pk_f32_fp8(v, true);
                    f[tk][j].x += w * lo.x; f[tk][j].y += w * lo.y; f[tk][j].z += w * hi2.x; f[tk][j].w += w * hi2.y; }
            }
        }
        float ss[2];
#pragma unroll
        for (int tk = 0; tk < 2; ++tk) { ss[tk] = 0.f;
#pragma unroll
            for (int j = 0; j < 4; ++j) ss[tk] += f[tk][j].x * f[tk][j].x + f[tk][j].y * f[tk][j].y + f[tk][j].z * f[tk][j].z + f[tk][j].w * f[tk][j].w; }
        u32x2 xbv[2][4]; f32x4 gtv[2][4], gpv[4];
#pragma unroll
        for (int j = 0; j < 4; ++j) gpv[j] = *(const f32x4*)(gpost + 4 * lane + 256 * j);
#pragma unroll
        for (int tk = 0; tk < 2; ++tk) { const int row = rowv[tk]; const int b = row_b(row), pos = row - b * POSB, rt = pos < CTX ? 2 : b; const float* md = mods + rt * 6144;
#pragma unroll
            for (int j = 0; j < 4; ++j) { const int k0 = 4 * lane + 256 * j;
                xbv[tk][j] = *(const u32x2*)((const bf16*)(p.ws + WS_MO) + (size_t)row * D + k0);
                gtv[tk][j] = *(const f32x4*)(md + 5 * D + k0); } }
        __builtin_amdgcn_sched_barrier(0);
        ss[0] = wave_sum_u(ss[0]); ss[1] = wave_sum_u(ss[1]);
        float s2[2];
#pragma unroll
        for (int tk = 0; tk < 2; ++tk) {
            const int row = rowv[tk];
            float* xo = resid_row_out(p, row);
            const float rn = rsqrtf(ss[tk] * (1.f / D) + EPS);
            s2[tk] = 0.f;
#pragma unroll
            for (int j = 0; j < 4; ++j) { const int k0 = 4 * lane + 256 * j;
                const f32x4 gp = gpv[j], gt = gtv[tk][j];
                const u32x2 xb = xbv[tk][j];
                const f32x4 xv = {bflo(xb.x), bfhi(xb.x), bflo(xb.y), bfhi(xb.y)};
                f[tk][j] = xv + gt * (f[tk][j] * rn * gp);
                if (st && ok[tk]) { if (l == 0) { u32x2 xb; xb.x = pk2(f[tk][j].x, f[tk][j].y); xb.y = pk2(f[tk][j].z, f[tk][j].w); *(u32x2*)((bf16*)xo + k0) = xb; }
                                    else *(f32x4*)(xo + k0) = f[tk][j]; }
                s2[tk] += f[tk][j].x * f[tk][j].x + f[tk][j].y * f[tk][j].y + f[tk][j].z * f[tk][j].z + f[tk][j].w * f[tk][j].w; }
        }
        if (l == 0) {
            const float* gpre1 = p.in[6] + D; bf16* HL = (bf16*)(p.ws + WS_HL); asm volatile("" : "+s"(gpre1), "+s"(HL));
            f32x4 gv[4], s1v[2][4], s0v[2][4];
#pragma unroll
            for (int j = 0; j < 4; ++j) gv[j] = *(const f32x4*)(gpre1 + 4 * lane + 256 * j);
#pragma unroll
            for (int tk = 0; tk < 2; ++tk) { const int row = rowv[tk]; const int b = row_b(row), pos = row - b * POSB, rt = pos < CTX ? 2 : b; const float* md1 = mods + rt * 6144 + 3 * 6144;
#pragma unroll
                for (int j = 0; j < 4; ++j) { const int k0 = 4 * lane + 256 * j; s1v[tk][j] = *(const f32x4*)(md1 + D + k0); s0v[tk][j] = *(const f32x4*)(md1 + k0); } }
            __builtin_amdgcn_sched_barrier(0);
            s2[0] = wave_sum_u(s2[0]); s2[1] = wave_sum_u(s2[1]);
#pragma unroll
            for (int tk = 0; tk < 2; ++tk) {
                const int row = rowv[tk];
                const float rs = rsqrtf(s2[tk] * (1.f / D) + EPS);
#pragma unroll
                for (int j = 0; j < 4; ++j) { const int k0 = 4 * lane + 256 * j;
                    const f32x4 g = gv[j], s1 = s1v[tk][j], s0 = s0v[tk][j];
                    const f32x4 h = f[tk][j] * rs * g * (s1 + 1.f) + s0;
                    u32x2 o; o.x = pk2(h.x, h.y); o.y = pk2(h.z, h.w);
                    if (st && ok[tk]) *(u32x2*)(HL + (size_t)row * D + k0) = o; }
            }
        }
    }
    if (st && l == 0) convert_small(p, 1);
}

__global__ void __launch_bounds__(NTHR, 2) mk_fwd(Params p_arg) {
    extern __shared__ __attribute__((aligned(16))) unsigned char lds_raw[];
    char* lds = (char*)lds_raw;
    volatile unsigned* misc = (volatile unsigned*)(lds + LDS_MISC);
    if (threadIdx.x < 64) misc[threadIdx.x] = 0u;
    __syncthreads();
    XcdBarrier bar; bar.bar = (unsigned*)(p_arg.ws + WS_CTL) + CW_BAR; bar.x = 0; bar.st = misc;
    const int ph_lo = p_arg.ph_lo, ph_hi = p_arg.ph_hi;
    if (ph_hi - ph_lo > 1) bar = xcd_barrier_post((unsigned*)(p_arg.ws + WS_CTL) + CW_BAR, misc);
#ifndef PROBE_MASK
#define PROBE_MASK 0
#endif
#ifndef XTRA_BAR
#define XTRA_BAR 0
#endif
#define PROBE_MULT 2
#ifndef ONLY_PHASE
#define ONLY_PHASE -1
#endif
#define PH_ON(k) (ONLY_PHASE < 0 || ((ONLY_PHASE >> (k)) & 1))
#ifndef DBL_MASK
#define DBL_MASK 0
#endif
    unsigned long long t_prev = PROBE_MASK ? __builtin_amdgcn_s_memrealtime() : 0ull, t_acc = 0ull;
#define KARGS() const __attribute__((address_space(4))) Params* pk = (const __attribute__((address_space(4))) Params*)__builtin_amdgcn_kernarg_segment_ptr(); \
        asm volatile("" : "+s"(pk) :: "memory"); PRef p = *pk
#define RUN(ph, ty, call) do { if (ph_lo <= (ph) && (ph) < ph_hi) { { KARGS(); call; } if ((ph) + 1 < ph_hi) { xcd_barrier(bar); for (int xb_ = 0; xb_ < XTRA_BAR; ++xb_) xcd_barrier(bar); } \
        if (PROBE_MASK) { const unsigned long long t_now = __builtin_amdgcn_s_memrealtime(); if ((PROBE_MASK >> (ty)) & 1) t_acc += t_now - t_prev; t_prev = t_now; } } } while (0)
    RUN(0, 10, if (PH_ON(0)) phase_p0(p, lds));
    RUN(1, 0, if (PH_ON(1)) phase_a(p, 0, lds, true));
    RUN(2, 1, if (PH_ON(2)) phase_b(p, 0, lds));
    RUN(3, 2, if (PH_ON(3)) phase_c(p, 0, lds, true));
    RUN(5, 4, if (PH_ON(5)) phase_e(p, 0, lds));
    RUN(6, 5, if (PH_ON(6)) phase_f(p, 0, lds));
    RUN(7, 6, if (PH_ON(7)) phase_g(p, 0, lds, true));
    RUN(8, 7, if (PH_ON(8)) phase_h(p, 0, lds));
    RUN(9, 8, if (PH_ON(9)) phase_i(p, 0, lds));
    RUN(10, 9, if (PH_ON(10)) phase_j(p, 0, lds, true));
    RUN(12, 1, if (PH_ON(2)) phase_b(p, 1, lds));
    RUN(13, 2, if (PH_ON(3)) phase_c(p, 1, lds, true));
    RUN(15, 4, if (PH_ON(5)) phase_e(p, 1, lds));
    RUN(16, 5, if (PH_ON(6)) phase_f(p, 1, lds));
    RUN(17, 6, if (PH_ON(7)) phase_g(p, 1, lds, true));
    RUN(18, 7, if (PH_ON(8)) phase_h(p, 1, lds));
    RUN(19, 8, if (PH_ON(9)) phase_i(p, 1, lds));
    RUN(20, 9, if (PH_ON(10)) phase_j(p, 1, lds, true));
    if (PROBE_SUB && blockIdx.x == 0) { const unsigned long long acc2 = *(volatile unsigned long long*)(lds + LDS_MISC + 128); const unsigned long long t0 = __builtin_amdgcn_s_memrealtime(); while (__builtin_amdgcn_s_memrealtime() - t0 < 4ull * acc2) __builtin_amdgcn_s_sleep(8); }
    if (PROBE_MASK && blockIdx.x == 0) { const unsigned long long t0 = __builtin_amdgcn_s_memrealtime(); while (__builtin_amdgcn_s_memrealtime() - t0 < PROBE_MULT * t_acc) __builtin_amdgcn_s_sleep(8); }
}
}

extern "C" void kernel_launch(void* const* d_in, const int* in_sizes, int n_in, void* d_out, int out_size, void* d_ws, size_t ws_size, hipStream_t stream) {
    static int grid = 0;
    if (grid == 0) {
        if (n_in != 26 || ws_size < WS_END) { fprintf(stderr, "kernel_launch: unexpected n_in %d / ws_size %zu\n", n_in, ws_size); grid = -1; return; }
        int dev = 0, cus = 0, per_cu = 0;
        (void)hipGetDevice(&dev); (void)hipDeviceGetAttribute(&cus, hipDeviceAttributeMultiprocessorCount, dev);
        (void)hipFuncSetAttribute((const void*)mk_fwd, hipFuncAttributeMaxDynamicSharedMemorySize, LDS_BYTES);
        (void)hipOccupancyMaxActiveBlocksPerMultiprocessor(&per_cu, (const void*)mk_fwd, NTHR, LDS_BYTES);
        (void)hipGetLastError();
        if (per_cu < 1) fprintf(stderr, "kernel_launch: occupancy query says %d blocks per CU\n", per_cu);
        if (cus < 136) { fprintf(stderr, "kernel_launch: %d CUs, the phase program needs more than 128 workgroups\n", cus); grid = -1; return; }
        grid = cus;
    }
    if (grid < 0) return;
    (void)hipMemsetAsync((char*)d_ws + WS_CTL, 0, 1 * MiB, stream);
    Params p{};
    for (int i = 0; i < 26; ++i) p.in[i] = (const float*)d_in[i];
    p.out = (float*)d_out; p.ws = (unsigned char*)d_ws;
#if MK_LAUNCHES == 1
    p.ph_lo = 0; p.ph_hi = NPHASE;
    hipLaunchKernelGGL(mk_fwd, dim3(grid), dim3(NTHR), LDS_BYTES, stream, p);
#else
    for (int ph = 0; ph < NPHASE; ++ph) { p.ph_lo = ph; p.ph_hi = ph + 1; hipLaunchKernelGGL(mk_fwd, dim3(grid), dim3(NTHR), LDS_BYTES, stream, p); }
#endif
}
```
